# Optimizing an MI355X kernel written in HIP

```python
import math
import jax, jax.numpy as jnp
from jax import lax
import numpy as np

D_MODEL = 1024
BATCH = 8
SEQ = 2048
DEPTH = 4
DEC_BATCH = 32
DEC_SEQ = 4
PAST_LEN = 8192
PAGE_SIZE = 128

N_META = 16
N_EVEN = (DEPTH + 1) // 2
N_ODD = DEPTH // 2
A_HEADS = 8
A_HEAD_DIM = D_MODEL // 16
A_KV_HEADS = 2
A_GROUP = A_HEADS // A_KV_HEADS
A_WIDTH = A_HEADS * A_HEAD_DIM
IDX_HEADS = 8
IDX_DIM = 64
TOPK_MAX = 256
Q_BLOCK = 128
POOL_WINDOWS = (2, 4, 8, 16)
POOL_GROUPS = 4
POOL_WIDTH = D_MODEL // 2
POOL_GROUP_DIM = POOL_WIDTH // POOL_GROUPS
POOL_BUF = 15
EVEN_SIZES = (A_WIDTH, A_KV_HEADS * A_HEAD_DIM, A_KV_HEADS * A_HEAD_DIM, IDX_HEADS * IDX_DIM, IDX_DIM, IDX_HEADS, POOL_WIDTH)
EVEN_IN = A_WIDTH + 2 * A_KV_HEADS * A_HEAD_DIM + IDX_HEADS * IDX_DIM + IDX_DIM + IDX_HEADS + POOL_WIDTH
EVEN_MIX = A_WIDTH + POOL_WIDTH
GLA_HEADS = 4
GLA_DK = D_MODEL // 2 // GLA_HEADS
GLA_DV = D_MODEL // GLA_HEADS
GLA_GATE_RANK = 16
GLA_GATE_NORM = 16.0
GLA_CHUNK = 64
ODD_SIZES = (GLA_HEADS * GLA_DK, GLA_HEADS * GLA_DK, GLA_HEADS * GLA_DV, GLA_HEADS * GLA_DV, GLA_GATE_RANK)
ODD_IN = 2 * GLA_HEADS * GLA_DK + 2 * GLA_HEADS * GLA_DV + GLA_GATE_RANK
ODD_MIX = GLA_HEADS * GLA_DV
D_FF = ((8 * D_MODEL + 3 * 256 - 1) // (3 * 256)) * 256
NORM_EPS = 1e-6

kernel_name = 'dsa_pool_gla_meta_hybrid_step'


def rmsnorm(x, g):
    xf = x.astype(jnp.float32)
    y = xf * lax.rsqrt(jnp.mean(xf * xf, axis=-1, keepdims=True) + NORM_EPS)
    return (y * g.astype(jnp.float32)).astype(x.dtype)


def split_cols(p, sizes):
    out, off = [], 0
    for s in sizes:
        out.append(p[..., off:off + s])
        off += s
    return out


def swiglu(h, wg, wu, wd):
    return (jax.nn.silu(h @ wg) * (h @ wu)) @ wd


def dsa_core(q, qi, wi, qpos, kidx, gather_kv, topk):
    B, T = q.shape[:2]
    Lk = kidx.shape[1]
    s = jnp.einsum('bthd,bsd->bths', qi.astype(jnp.float32), kidx.astype(jnp.float32))
    score = jnp.einsum('bths,bth->bts', jax.nn.relu(s), wi.astype(jnp.float32))
    vis = jnp.arange(Lk)[None, :] <= qpos[:, None]
    score = jnp.where(vis[None], score, -jnp.inf)
    _, idx = lax.top_k(score, topk)
    valid = idx <= qpos[None, :, None]
    k_sel, v_sel = gather_kv(idx)
    qg = q.reshape(B, T, A_KV_HEADS, A_GROUP, A_HEAD_DIM)
    logits = jnp.einsum('btkgd,btjkd->btkgj', qg, k_sel).astype(jnp.float32) * (A_HEAD_DIM ** -0.5)
    logits = jnp.where(valid[:, :, None, None, :], logits, -jnp.inf)
    p = jax.nn.softmax(logits, axis=-1).astype(v_sel.dtype)
    o = jnp.einsum('btkgj,btjkd->btkgd', p, v_sel)
    return o.reshape(B, T, A_WIDTH)


def rows_gather(src, idx):
    return jax.vmap(lambda sb, ib: sb[ib])(src, idx)


def dsa_prompt(q, k, v, qi, ki, wi):
    B, L = q.shape[:2]
    topk = min(TOPK_MAX, L // 4)
    nb = -(-L // Q_BLOCK)
    Lpad = nb * Q_BLOCK
    pad = lambda t: jnp.pad(t, [(0, 0), (0, Lpad - L)] + [(0, 0)] * (t.ndim - 2))
    qp, qip, wip = pad(q), pad(qi), pad(wi)
    gather = lambda idx: (rows_gather(k, idx), rows_gather(v, idx))

    def block(start):
        sl = lambda t: lax.dynamic_slice_in_dim(t, start, Q_BLOCK, axis=1)
        qpos = start + jnp.arange(Q_BLOCK)
        return dsa_core(sl(qp), sl(qip), sl(wip), qpos, ki, gather, topk)

    out = lax.map(block, jnp.arange(nb) * Q_BLOCK)
    return jnp.moveaxis(out, 0, 1).reshape(B, Lpad, A_WIDTH)[:, :L]


def dsa_sample(q, k_new, v_new, qi, ki_new, wi, pool_k, pool_v, pool_ki, page_table):
    DB, T = q.shape[:2]
    past = page_table.shape[1] * PAGE_SIZE
    topk = min(TOPK_MAX, (past + T) // 4)
    ki_past = pool_ki[page_table].reshape(DB, past, IDX_DIM)
    ki_all = jnp.concatenate([ki_past.astype(ki_new.dtype), ki_new], axis=1)
    kflat = pool_k.reshape(-1, A_KV_HEADS, A_HEAD_DIM)
    vflat = pool_v.reshape(-1, A_KV_HEADS, A_HEAD_DIM)

    def gather(idx):
        ip = jnp.minimum(idx, past - 1)
        page = jax.vmap(lambda pt, i: pt[i])(page_table, ip // PAGE_SIZE)
        phys = page * PAGE_SIZE + ip % PAGE_SIZE
        inew = jnp.clip(idx - past, 0, T - 1)
        is_new = (idx >= past)[..., None, None]
        k_sel = jnp.where(is_new, rows_gather(k_new, inew), kflat[phys].astype(k_new.dtype))
        v_sel = jnp.where(is_new, rows_gather(v_new, inew), vflat[phys].astype(v_new.dtype))
        return k_sel, v_sel

    qpos = past + jnp.arange(T)
    return dsa_core(q, qi, wi, qpos, ki_all, gather, topk)


def multiscale_pool(u, prefix, pos, w_grp, scale):
    B, T, C = u.shape
    ext = jnp.concatenate([prefix, u], axis=1)
    extf = ext.astype(jnp.float32)
    cs = jnp.pad(jnp.cumsum(extf, axis=1), ((0, 0), (1, 0), (0, 0)))
    end = cs[:, POOL_BUF + 1:]
    outs = []
    for g, w in enumerate(POOL_WINDOWS):
        sl = slice(g * POOL_GROUP_DIM, (g + 1) * POOL_GROUP_DIM)
        start = cs[:, POOL_BUF + 1 - w:POOL_BUF + 1 - w + T, sl]
        cnt = jnp.minimum(w, pos + 1).astype(jnp.float32)[None, :, None]
        outs.append((end[..., sl] - start) / cnt - extf[:, POOL_BUF:, sl])
    d = jnp.stack(outs, axis=2).astype(u.dtype)
    y = jnp.einsum('btgc,gce->btge', d, w_grp).reshape(B, T, C)
    return y * scale, ext[:, -POOL_BUF:]


def even_project(h, w_in):
    B, T, _ = h.shape
    q, k, v, qi, ki, wi, u = split_cols(h @ w_in, EVEN_SIZES)
    return (q.reshape(B, T, A_HEADS, A_HEAD_DIM), k.reshape(B, T, A_KV_HEADS, A_HEAD_DIM),
            v.reshape(B, T, A_KV_HEADS, A_HEAD_DIM), qi.reshape(B, T, IDX_HEADS, IDX_DIM), ki, wi, u)


def even_prompt(h, w_in, w_out, pw, ps):
    B, L, _ = h.shape
    q, k, v, qi, ki, wi, u = even_project(h, w_in)
    oa = dsa_prompt(q, k, v, qi, ki, wi)
    prefix = jnp.zeros((B, POOL_BUF, POOL_WIDTH), u.dtype)
    ob, buf = multiscale_pool(u, prefix, jnp.arange(L), pw, ps)
    y = jnp.concatenate([oa.astype(h.dtype), ob], axis=-1) @ w_out
    return y, k, v, ki, buf


def even_sample(h, pool_k, pool_v, pool_ki, buf0, page_table, w_in, w_out, pw, ps):
    T = h.shape[1]
    q, k, v, qi, ki, wi, u = even_project(h, w_in)
    past = page_table.shape[1] * PAGE_SIZE
    oa = dsa_sample(q, k, v, qi, ki, wi, pool_k, pool_v, pool_ki, page_table)
    ob, buf = multiscale_pool(u, buf0.astype(u.dtype), past + jnp.arange(T), pw, ps)
    y = jnp.concatenate([oa.astype(h.dtype), ob], axis=-1) @ w_out
    return y, k, v, ki, buf


def gla_scan(q, k, v, loga, S, chunk):
    B, T, H, DK = q.shape
    DV = v.shape[-1]
    n = T // chunk
    to_chunks = lambda t: jnp.moveaxis(t.astype(jnp.float32).reshape(B, n, chunk, H, t.shape[-1]), 1, 0)
    causal = jnp.tril(jnp.ones((chunk, chunk), bool))[None, :, :, None, None]

    def step(S, xs):
        qc, kc, vc, gc = xs
        b = jnp.cumsum(gc, axis=1)
        o_inter = jnp.einsum('bthd,bhde->bthe', qc * jnp.exp(b), S)
        diff = b[:, :, None] - b[:, None, :]
        decay = jnp.exp(jnp.where(causal, diff, -jnp.inf))
        att = jnp.einsum('bthd,bshd,btshd->bths', qc, kc, decay)
        o_intra = jnp.einsum('bths,bshe->bthe', att, vc)
        bl = b[:, -1]
        S = jnp.exp(bl)[..., None] * S + jnp.einsum('bshd,bshe->bhde', kc * jnp.exp(bl[:, None] - b), vc)
        return S, o_inter + o_intra

    S, o = lax.scan(step, S.astype(jnp.float32), (to_chunks(q), to_chunks(k), to_chunks(v), to_chunks(loga)))
    return jnp.moveaxis(o, 0, 1).reshape(B, T, H, DV), S


def gla_project(h, w_in, wgu, bg):
    B, T, _ = h.shape
    q, k, v, g, gd = split_cols(h @ w_in, ODD_SIZES)
    q = q.reshape(B, T, GLA_HEADS, GLA_DK) * (GLA_DK ** -0.5)
    k = k.reshape(B, T, GLA_HEADS, GLA_DK)
    v = v.reshape(B, T, GLA_HEADS, GLA_DV)
    loga = jax.nn.log_sigmoid((gd @ wgu + bg).astype(jnp.float32)) / GLA_GATE_NORM
    return q, k, v, g, loga.reshape(B, T, GLA_HEADS, GLA_DK)


def gla_output(o, g, gn, w_out, dtype):
    B, T = o.shape[:2]
    on = rmsnorm(o, gn).astype(dtype)
    on = on * jax.nn.silu(g.reshape(B, T, GLA_HEADS, GLA_DV))
    return on.reshape(B, T, ODD_MIX) @ w_out


def odd_prompt(h, w_in, wgu, bg, gn, w_out):
    B, L, _ = h.shape
    q, k, v, g, la = gla_project(h, w_in, wgu, bg)
    S0 = jnp.zeros((B, GLA_HEADS, GLA_DK, GLA_DV), jnp.float32)
    head = lambda t: t[:, :N_META]
    tail = lambda t: t[:, N_META:]
    o_m, S = gla_scan(head(q), head(k), head(v), head(la), S0, N_META)
    o_r, S = gla_scan(tail(q), tail(k), tail(v), tail(la), S, math.gcd(GLA_CHUNK, L - N_META))
    o = jnp.concatenate([o_m, o_r], axis=1)
    return gla_output(o, g, gn, w_out, h.dtype), S.astype(h.dtype)


def odd_sample(h, S0, w_in, wgu, bg, gn, w_out):
    T = h.shape[1]
    q, k, v, g, la = gla_project(h, w_in, wgu, bg)
    o, S = gla_scan(q, k, v, la, S0, math.gcd(GLA_CHUNK, T))
    return gla_output(o, g, gn, w_out, h.dtype), S.astype(h.dtype)


def setup_inputs(seed: int = 0) -> dict:
    key = jax.random.key(seed)
    ks = jax.random.split(key, 26)
    nrm = lambda k, shape, s: jax.random.normal(k, shape, jnp.float32) * s
    n_pages = PAST_LEN // PAGE_SIZE
    n_used = DEC_BATCH * n_pages
    n_pool = n_used + max(1, n_used // 4)
    page_table = jax.random.permutation(ks[0], n_pool)[:n_used].reshape(DEC_BATCH, n_pages).astype(jnp.int32)
    out_s = (2 * DEPTH) ** -0.5
    return {
        'x_prompt': nrm(ks[1], (BATCH, SEQ, D_MODEL), 1.0),
        'x_sample': nrm(ks[2], (DEC_BATCH, DEC_SEQ, D_MODEL), 1.0),
        'cache_k': nrm(ks[3], (N_EVEN, n_pool, PAGE_SIZE, A_KV_HEADS, A_HEAD_DIM), 1.0),
        'cache_v': nrm(ks[4], (N_EVEN, n_pool, PAGE_SIZE, A_KV_HEADS, A_HEAD_DIM), 1.0),
        'cache_kidx': nrm(ks[5], (N_EVEN, n_pool, PAGE_SIZE, IDX_DIM), 1.0),
        'state_pool': nrm(ks[6], (N_EVEN, DEC_BATCH, POOL_BUF, POOL_WIDTH), 1.0),
        'state_gla': nrm(ks[7], (N_ODD, DEC_BATCH, GLA_HEADS, GLA_DK, GLA_DV), 1.0),
        'page_table': page_table,
        'meta_tokens': nrm(ks[8], (N_META, D_MODEL), 1.0),
        'norm_mix': 1.0 + nrm(ks[9], (DEPTH, D_MODEL), 0.05),
        'norm_ffn': 1.0 + nrm(ks[10], (DEPTH, D_MODEL), 0.05),
        'norm_final': 1.0 + nrm(ks[11], (D_MODEL,), 0.05),
        'w_in_even': nrm(ks[12], (N_EVEN, D_MODEL, EVEN_IN), D_MODEL ** -0.5),
        'w_out_even': nrm(ks[13], (N_EVEN, EVEN_MIX, D_MODEL), EVEN_MIX ** -0.5 * out_s),
        'pool_w': nrm(ks[14], (N_EVEN, POOL_GROUPS, POOL_GROUP_DIM, POOL_GROUP_DIM), POOL_GROUP_DIM ** -0.5),
        'pool_scale': 1.0 + nrm(ks[15], (N_EVEN, POOL_WIDTH), 0.1),
        'w_in_odd': nrm(ks[16], (N_ODD, D_MODEL, ODD_IN), D_MODEL ** -0.5),
        'gla_w_gate_up': nrm(ks[17], (N_ODD, GLA_GATE_RANK, GLA_HEADS * GLA_DK), GLA_GATE_RANK ** -0.5),
        'gla_b_gate': nrm(ks[18], (N_ODD, GLA_HEADS * GLA_DK), 0.1),
        'gla_norm': 1.0 + nrm(ks[19], (N_ODD, GLA_DV), 0.05),
        'w_out_odd': nrm(ks[20], (N_ODD, ODD_MIX, D_MODEL), ODD_MIX ** -0.5 * out_s),
        'ffn_w_gate': nrm(ks[21], (DEPTH, D_MODEL, D_FF), D_MODEL ** -0.5),
        'ffn_w_up': nrm(ks[22], (DEPTH, D_MODEL, D_FF), D_MODEL ** -0.5),
        'ffn_w_down': nrm(ks[23], (DEPTH, D_FF, D_MODEL), D_FF ** -0.5 * out_s),
    }


def reference(x_prompt, x_sample, cache_k, cache_v, cache_kidx, state_pool, state_gla, page_table,
              meta_tokens, norm_mix, norm_ffn, norm_final, w_in_even, w_out_even, pool_w, pool_scale,
              w_in_odd, gla_w_gate_up, gla_b_gate, gla_norm, w_out_odd, ffn_w_gate, ffn_w_up, ffn_w_down):
    B = x_prompt.shape[0]
    meta = jnp.broadcast_to(meta_tokens.astype(x_prompt.dtype)[None], (B, N_META, D_MODEL))
    xp = jnp.concatenate([meta, x_prompt], axis=1)
    xs = x_sample
    kp_l, vp_l, kip_l, bp_l, ks_l, vs_l, kis_l, bs_l, Sp_l, Ss_l = [], [], [], [], [], [], [], [], [], []
    for l in range(DEPTH):
        hp = rmsnorm(xp, norm_mix[l])
        hs = rmsnorm(xs, norm_mix[l])
        if l % 2 == 0:
            e = l // 2
            yp, kp, vp, kip, bp = even_prompt(hp, w_in_even[e], w_out_even[e], pool_w[e], pool_scale[e])
            ys, kss, vss, kis, bs = even_sample(hs, cache_k[e], cache_v[e], cache_kidx[e], state_pool[e], page_table,
                                                w_in_even[e], w_out_even[e], pool_w[e], pool_scale[e])
            kp_l.append(kp); vp_l.append(vp); kip_l.append(kip); bp_l.append(bp)
            ks_l.append(kss); vs_l.append(vss); kis_l.append(kis); bs_l.append(bs)
        else:
            o = l // 2
            yp, Sp = odd_prompt(hp, w_in_odd[o], gla_w_gate_up[o], gla_b_gate[o], gla_norm[o], w_out_odd[o])
            ys, Ss = odd_sample(hs, state_gla[o], w_in_odd[o], gla_w_gate_up[o], gla_b_gate[o], gla_norm[o], w_out_odd[o])
            Sp_l.append(Sp); Ss_l.append(Ss)
        xp = xp + yp
        xs = xs + ys
        xp = xp + swiglu(rmsnorm(xp, norm_ffn[l]), ffn_w_gate[l], ffn_w_up[l], ffn_w_down[l])
        xs = xs + swiglu(rmsnorm(xs, norm_ffn[l]), ffn_w_gate[l], ffn_w_up[l], ffn_w_down[l])
    y_prompt = rmsnorm(xp, norm_final)[:, N_META:]
    y_sample = rmsnorm(xs, norm_final)
    return (y_prompt, y_sample,
            jnp.stack(kp_l), jnp.stack(vp_l), jnp.stack(kip_l),
            jnp.stack(ks_l), jnp.stack(vs_l), jnp.stack(kis_l),
            jnp.stack(bp_l), jnp.stack(bs_l),
            jnp.stack(Sp_l), jnp.stack(Ss_l))
```

```cpp
#include <hip/hip_runtime.h>
#include <stdint.h>

#define LAS __attribute__((address_space(3)))
#define GAS __attribute__((address_space(1)))
typedef unsigned short u16;
typedef unsigned short bf16_t;
typedef short bf16x8 __attribute__((ext_vector_type(8)));
typedef _Float16 f16x8 __attribute__((ext_vector_type(8)));
typedef _Float16 f16x4 __attribute__((ext_vector_type(4)));
typedef float f32x2 __attribute__((ext_vector_type(2)));
typedef float f32x4 __attribute__((ext_vector_type(4)));
typedef float f32x16 __attribute__((ext_vector_type(16)));
typedef unsigned u32x2 __attribute__((ext_vector_type(2)));
typedef unsigned u32x4 __attribute__((ext_vector_type(4)));

constexpr int DM = 1024, NBATCH = 8, SEQ = 2048, NMETA = 16, LP = 2064, DBATCH = 32, DSEQ = 4, PAST = 8192, PAGE = 128, NPAGES = 64, NPOOLPG = 2560;
constexpr int ROW_META = 16384, ROW_SAMP = 16400, MREAL = 16528, MP = 16640;
constexpr int NE = 2048, NO = 3328, NGU = 5632, DFF = 2816, PLD = 3328;
constexpr int EIN = 1864, OIN = 3088;
constexpr int EQ = 0, EQI = 512, EU = 1024, EK = 1536, EV = 1664, EKI = 1792, EWI = 1856;
constexpr int OQ = 0, OKK = 512, OV = 1024, OG = 2048, OGD = 3072;
constexpr int PLB = 3072;
constexpr int NCHUNK = 289;
constexpr float EPS = 1e-6f;

constexpr size_t MiB = 1u << 20;
constexpr size_t WS_CTL = 0, CTL_BYTES = 4 * MiB;
constexpr size_t WS_WINE = 4 * MiB, WS_WOUTE = 12 * MiB, WS_WINO = 16 * MiB, WS_WOUTO = 29 * MiB, WS_WGU = 33 * MiB, WS_WDN = 77 * MiB;
constexpr size_t WS_X = 100 * MiB, WS_XB = 166 * MiB, WS_PROJ = 199 * MiB, WS_ACT = 411 * MiB, WS_HFF = 444 * MiB, WS_KVB = 534 * MiB, WS_KIH = 543 * MiB;
constexpr size_t WS_QE = 546 * MiB, WS_KET = 563 * MiB, WS_VT = 582 * MiB, WS_ATT = 619 * MiB, WS_EBL = 629 * MiB, WS_O = 630 * MiB, WS_SSP = 696 * MiB, WS_KEB = 706 * MiB, WS_SST = 723 * MiB, WS_END = 724 * MiB;
static_assert(WS_X + (size_t)MP * DM * 4 <= WS_XB && WS_XB + (size_t)MP * DM * 2 <= WS_PROJ && WS_PROJ + (size_t)MP * PLD * 4 <= WS_ACT, "ws map");
static_assert(WS_ACT + (size_t)MP * DM * 2 <= WS_HFF && WS_HFF + (size_t)MP * DFF * 2 <= WS_KVB && WS_KVB + (size_t)MP * 256 * 2 <= WS_KIH && WS_KIH + (size_t)MP * 64 * 2 <= WS_QE, "ws map");
static_assert(WS_QE + (size_t)MP * 512 * 2 <= WS_KET && WS_KET + (size_t)NCHUNK * 4 * 128 * 64 * 2 <= WS_VT && WS_VT + (size_t)NCHUNK * 4 * 256 * 64 * 2 <= WS_ATT, "ws map");
static_assert(WS_ATT + (size_t)NCHUNK * 4 * 64 * 64 * 2 <= WS_EBL && WS_EBL + (size_t)NCHUNK * 512 * 4 <= WS_O && WS_O + (size_t)MP * DM * 4 <= WS_SSP && WS_SSP + (size_t)9 * MP * 16 * 4 <= WS_KEB && WS_KEB + (size_t)MP * 512 * 2 <= WS_SST && WS_SST + (size_t)9 * 160 * 64 * 4 <= WS_END, "ws map");
static_assert(WS_WINE + 2 * (size_t)NE * DM * 2 <= WS_WOUTE && WS_WINO + 2 * (size_t)NO * DM * 2 <= WS_WOUTO && WS_WGU + 4 * (size_t)NGU * DM * 2 <= WS_WDN && WS_WDN + 4 * (size_t)DM * DFF * 2 <= WS_X, "ws map");
constexpr int CW_BAR = 1024;
constexpr int CW_QUEUE = 8192;
constexpr int CW_SS = 16384;
static_assert((CW_SS + 9 * MP) * 4 <= (int)CTL_BYTES, "ctl");

constexpr size_t O_YP = 0, O_YS = O_YP + (size_t)NBATCH * SEQ * DM, O_KP = O_YS + (size_t)DBATCH * DSEQ * DM, O_VP = O_KP + (size_t)2 * NBATCH * LP * 128,
                 O_KIP = O_VP + (size_t)2 * NBATCH * LP * 128, O_KS = O_KIP + (size_t)2 * NBATCH * LP * 64, O_VS = O_KS + (size_t)2 * DBATCH * DSEQ * 128,
                 O_KIS = O_VS + (size_t)2 * DBATCH * DSEQ * 128, O_PP = O_KIS + (size_t)2 * DBATCH * DSEQ * 64, O_PS = O_PP + (size_t)2 * NBATCH * 15 * 512,
                 O_GP = O_PS + (size_t)2 * DBATCH * 15 * 512, O_GS = O_GP + (size_t)2 * NBATCH * 4 * 128 * 256, O_END = O_GS + (size_t)2 * DBATCH * 4 * 128 * 256;

constexpr int LDS_MISC = 159744, LDS_BYTES = 160000;

__device__ __forceinline__ unsigned cvt_pk_bf16(float lo, float hi) { unsigned r; asm volatile("v_cvt_pk_bf16_f32 %0, %1, %2" : "=v"(r) : "v"(lo), "v"(hi)); return r; }
__device__ __forceinline__ float bf_lo(unsigned u) { return __builtin_bit_cast(float, u << 16); }
__device__ __forceinline__ float bf_hi(unsigned u) { return __builtin_bit_cast(float, u & 0xffff0000u); }
__device__ __forceinline__ float wave_sum(float v) {
#pragma unroll
    for (int o = 1; o < 64; o <<= 1) v += __shfl_xor(v, o);
    return v;
}
__device__ __forceinline__ int prow(int b, int p) { return p < NMETA ? ROW_META + p : b * SEQ + p - NMETA; }
__device__ __forceinline__ unsigned mbcnt64(unsigned long long m) { return __builtin_amdgcn_mbcnt_hi((unsigned)(m >> 32), __builtin_amdgcn_mbcnt_lo((unsigned)m, 0u)); }
__device__ __forceinline__ float row_rstd(const float* ssp, int row) {
    const f32x4 a = *(const f32x4*)(ssp + (size_t)row * 16), b = *(const f32x4*)(ssp + (size_t)row * 16 + 4), c = *(const f32x4*)(ssp + (size_t)row * 16 + 8), d = *(const f32x4*)(ssp + (size_t)row * 16 + 12);
    const float s = (((a[0] + a[1]) + (a[2] + a[3])) + ((b[0] + b[1]) + (b[2] + b[3]))) + (((c[0] + c[1]) + (c[2] + c[3])) + ((d[0] + d[1]) + (d[2] + d[3])));
    return rsqrtf(s * (1.f / DM) + EPS);
}
__device__ __forceinline__ float tail_rstd(const float* sst, int trow) {
    const float* p = sst + (size_t)trow * 64; float s = 0.f;
#pragma unroll
    for (int i = 0; i < 16; ++i) { const f32x4 a = *(const f32x4*)(p + 4 * i); s += (a[0] + a[1]) + (a[2] + a[3]); }
    return rsqrtf(s * (1.f / DM) + EPS);
}
__device__ __forceinline__ float tail_rstd_batched(const float* sst, int trow) {
    const float* p = sst + (size_t)trow * 64; float s = 0.f; f32x4 a[16];
#pragma unroll
    for (int i = 0; i < 16; ++i) a[i] = *(const f32x4*)(p + 4 * i);
    __builtin_amdgcn_sched_barrier(0);
#pragma unroll
    for (int i = 0; i < 16; ++i) s += (a[i][0] + a[i][1]) + (a[i][2] + a[i][3]);
    return rsqrtf(s * (1.f / DM) + EPS);
}
__device__ __forceinline__ float silu_f(float x) { return x * __builtin_amdgcn_rcpf(1.f + __expf(-x)); }

#define XB_TMO      128
#define XB_XCNT(j)  (256  + 64 * (j))
#define XB_XSUB(j)  (1280 + 64 * (j))
#define XB_XGEN(j)  (2304 + 64 * (j))
#define XB_TOP      3328
#define XB_TOPGEN   3392
#define XCD_BAR_WORDS 3456
#define XB_SPIN_CAP (1u << 18)
__device__ __forceinline__ unsigned xb_ld(unsigned* p)              { return __hip_atomic_load(p, __ATOMIC_RELAXED, __HIP_MEMORY_SCOPE_AGENT); }
__device__ __forceinline__ unsigned xb_add(unsigned* p, unsigned v) { return __hip_atomic_fetch_add(p, v, __ATOMIC_RELAXED, __HIP_MEMORY_SCOPE_AGENT); }
__device__ __forceinline__ unsigned xb_xcc_id() { return (unsigned)__builtin_amdgcn_s_getreg((3 << 11) | 20) & 0xFu; }
#define XB_SPIN(cond, bar) do { unsigned _sp = 0; while (cond) { __builtin_amdgcn_s_sleep(1); \
    if ((++_sp & 255u) == 0u) { if (xb_ld(&(bar)[XB_TMO])) break; if (_sp > XB_SPIN_CAP) { atomicAdd(&(bar)[XB_TMO], 1u); break; } } } } while (0)
struct XcdBarrier { unsigned* bar; unsigned x; volatile LAS unsigned* st; };
__device__ __forceinline__ XcdBarrier xcd_barrier_post(unsigned* bar, volatile LAS unsigned* st) {
    XcdBarrier b; b.bar = bar; b.x = xb_xcc_id(); b.st = st;
    if (threadIdx.x == 0) (void)xb_add(&bar[XB_XCNT(b.x)], 1u);
    return b;
}
__device__ __forceinline__ void xcd_barrier_complete(unsigned* bar, unsigned x, unsigned& nloc, unsigned& nx) {
    const unsigned G = gridDim.x * gridDim.y * gridDim.z;
    unsigned sum, cnt, mine, sp = 0u;
    for (;;) {
        sum = 0u; cnt = 0u; mine = 0u;
#pragma unroll
        for (unsigned j = 0; j < 16; ++j) { const unsigned c = xb_ld(&bar[XB_XCNT(j)]); sum += c; cnt += (c > 0u) ? 1u : 0u; mine = (j == x) ? c : mine; }
        if (sum == G) break;
        __builtin_amdgcn_s_sleep(1);
        if ((++sp & 255u) == 0u) { if (xb_ld(&bar[XB_TMO])) break; if (sp > XB_SPIN_CAP) { atomicAdd(&bar[XB_TMO], 1u); break; } }
    }
    nloc = mine > 0u ? mine : 1u; nx = cnt > 0u ? cnt : 1u;
}
__device__ __forceinline__ void xcd_barrier(const XcdBarrier& b) {
    asm volatile("s_waitcnt vmcnt(0)" ::: "memory");
    __syncthreads();
    if (threadIdx.x == 0) {
        unsigned* bar = b.bar;
        __builtin_amdgcn_s_waitcnt(0);
        unsigned nloc = b.st[0], nx = b.st[1];
        if (nloc == 0u) { xcd_barrier_complete(bar, b.x, nloc, nx); b.st[0] = nloc; b.st[1] = nx; }
        const unsigned old = xb_add(&bar[XB_XSUB(b.x)], 1u);
        const unsigned gen = old / nloc;
        if (old + 1u == (gen + 1u) * nloc) {
            __builtin_amdgcn_fence(__ATOMIC_RELEASE, "agent");
            asm volatile("s_waitcnt vmcnt(0)" ::: "memory");
            const unsigned og = xb_add(&bar[XB_TOP], 1u);
            const unsigned tg = og / nx;
            if (og + 1u == (tg + 1u) * nx) xb_add(&bar[XB_TOPGEN], 1u);
            else XB_SPIN(xb_ld(&bar[XB_TOPGEN]) == tg, bar);
            __builtin_amdgcn_fence(__ATOMIC_ACQUIRE, "agent");
            xb_add(&bar[XB_XGEN(b.x)], 1u);
            asm volatile("s_waitcnt vmcnt(0)" ::: "memory");
        } else {
            XB_SPIN(xb_ld(&bar[XB_XGEN(b.x)]) == gen, bar);
            __builtin_amdgcn_fence(__ATOMIC_ACQUIRE, "agent");
            asm volatile("s_waitcnt vmcnt(0)" ::: "memory");
        }
    }
    __syncthreads();
}

__device__ __forceinline__ void proj_even_extras(int row, int col, const f32x4 v, bf16_t* kvb, _Float16* kih, float* out, int eidx) {
    size_t ooff; int width, oc;
    if (col < EV) { ooff = O_KP; width = 128; oc = col - EK; } else if (col < EKI) { ooff = O_VP; width = 128; oc = col - EV; } else { ooff = O_KIP; width = 64; oc = col - EKI; }
    if (col < EKI) { u32x2 w; w.x = cvt_pk_bf16(v[0], v[1]); w.y = cvt_pk_bf16(v[2], v[3]); *(u32x2*)(kvb + (size_t)row * 256 + (col - EK)) = w; }
    else { f16x4 h; h[0] = (_Float16)v[0]; h[1] = (_Float16)v[1]; h[2] = (_Float16)v[2]; h[3] = (_Float16)v[3]; *(f16x4*)(kih + (size_t)row * 64 + (col - EKI)) = h; }
    if (row < ROW_META) *(f32x4*)(out + ooff + ((size_t)(eidx * NBATCH + (row >> 11)) * LP + NMETA + (row & 2047)) * width + oc) = v;
    else if (row < ROW_SAMP) { for (int bb = 0; bb < NBATCH; ++bb) *(f32x4*)(out + ooff + ((size_t)(eidx * NBATCH + bb) * LP + (row - ROW_META)) * width + oc) = v; }
    else if (row < MREAL) { const size_t so = col < EV ? O_KS : col < EKI ? O_VS : O_KIS; *(f32x4*)(out + so + ((size_t)eidx * DBATCH * DSEQ + (row - ROW_SAMP)) * width + oc) = v; }
}

namespace pg8 {
constexpr int BM = 256, BK = 64, HALF = 128, HTB = HALF * BK * 2, STAGE_BYTES = 8 * HTB, NXCD = 8, WGM = 8;
__host__ __device__ __forceinline__ int lds_byte(int r, int c) { const int st = (r >> 4) * 2 + (c >> 5), rr = r & 15, cc = c & 31, ob = rr * 64 + cc * 2; return st * 1024 + (ob ^ (((ob >> 9) & 1) << 5)); }
__host__ __device__ __forceinline__ void stage_rc(int b, int& R, int& C) { const int st = b / 1024, sb = b % 1024, swz = sb ^ (((sb >> 9) & 1) << 5); R = (st >> 1) * 16 + swz / 64; C = (st & 1) * 32 + (swz % 64) / 2; }
__host__ __device__ __forceinline__ int perm32(int rho) { const int n = rho >> 4, i = rho & 15; return 8 * (i >> 2) + 4 * n + (i & 3); }
struct Unit { int pm, pn; };
struct Gemm { const bf16_t* A; const bf16_t* Bt; int M, N, K; };
struct StaticOrder {
    int nM, nN, nwg, G, c;
    __host__ __device__ void init(int M, int N, int G_, int c_) { nM = M / BM; nN = N / BM; nwg = nM * nN; G = G_; c = c_; }
    __host__ __device__ bool next(int i, Unit& u) const {
        const long L = (long)i * G + c; if (L >= nwg) return false;
        int wgid = (int)L; { const int q = nwg / NXCD, r = nwg % NXCD, xcd = wgid % NXCD, off = wgid / NXCD; wgid = (xcd < r ? xcd * (q + 1) : r * (q + 1) + (xcd - r) * q) + off; }
        const int nig = WGM * nN, gid = wgid / nig, fm = gid * WGM, gsz = (nM - fm) < WGM ? (nM - fm) : WGM;
        u.pm = fm + ((wgid % nig) % gsz); u.pn = (wgid % nig) / gsz; return true;
    }
    __device__ __forceinline__ void a_ready(const Unit&) const {}
    __device__ __forceinline__ void done(const Unit&) const {}
};

struct EpiProj {
    static constexpr bool PERM = true, AFTER_DRAIN = false;
    float* C; int ldc; const float* ss; int even; bf16_t* kvb; _Float16* kih; float* out; int eidx; const LAS float* rsl; int pm0; bf16_t* qb16; _Float16* qih;
    __device__ __forceinline__ void operator()(const f32x4 (&acc)[2][2][4][2], const Unit& u, int wr, int wc, int fr, int fq) const {
        const int row0 = u.pm * BM + wr * 64 + fr, col0 = u.pn * BM + wc * 32 + 8 * fq;
#pragma unroll
        for (int ai = 0; ai < 2; ++ai)
#pragma unroll
            for (int m = 0; m < 4; ++m) {
                const int row = row0 + ai * HALF + m * 16;
                const float rs = u.pm == pm0 ? rsl[row - pm0 * BM] : row_rstd(ss, row);
#pragma unroll
                for (int bj = 0; bj < 2; ++bj) {
                    const f32x4 v0 = acc[ai][bj][m][0] * rs, v1 = acc[ai][bj][m][1] * rs;
                    const int col = col0 + bj * HALF;
                    if (!even) { u32x4 w; w.x = cvt_pk_bf16(v0[0], v0[1]); w.y = cvt_pk_bf16(v0[2], v0[3]); w.z = cvt_pk_bf16(v1[0], v1[1]); w.w = cvt_pk_bf16(v1[2], v1[3]); *(u32x4*)((bf16_t*)C + (size_t)row * PLB + col) = w; }
                    else if (col < EQI) { u32x4 w; w.x = cvt_pk_bf16(v0[0], v0[1]); w.y = cvt_pk_bf16(v0[2], v0[3]); w.z = cvt_pk_bf16(v1[0], v1[1]); w.w = cvt_pk_bf16(v1[2], v1[3]); *(u32x4*)(qb16 + (size_t)row * 512 + col) = w; }
                    else if (col < EU) { f16x8 h; h[0] = (_Float16)v0[0]; h[1] = (_Float16)v0[1]; h[2] = (_Float16)v0[2]; h[3] = (_Float16)v0[3]; h[4] = (_Float16)v1[0]; h[5] = (_Float16)v1[1]; h[6] = (_Float16)v1[2]; h[7] = (_Float16)v1[3];
                        *(f16x8*)(qih + (size_t)row * 512 + (col - EQI)) = h; }
                    else {
                        float* rowp = C + (size_t)row * ldc + col;
                        *(f32x4*)rowp = v0; *(f32x4*)(rowp + 4) = v1;
                        if (col >= EK && col < EKI + 64) { proj_even_extras(row, col, v0, kvb, kih, out, eidx); proj_even_extras(row, col + 4, v1, kvb, kih, out, eidx); }
                    }
                }
            }
    }
};
struct EpiRes {
    static constexpr bool PERM = true, AFTER_DRAIN = false;
    bf16_t* XB; float* ssn; const float* Xf32;
    __device__ __forceinline__ void operator()(const f32x4 (&acc)[2][2][4][2], const Unit& u, int wr, int wc, int fr, int fq) const {
        const int row0 = u.pm * BM + wr * 64 + fr, col0 = u.pn * BM + wc * 32 + 8 * fq;
#pragma unroll
        for (int ai = 0; ai < 2; ++ai) {
            f32x4 xv[4][2][2];
            if (Xf32) {
#pragma unroll
                for (int m = 0; m < 4; ++m) { const float* rowp = Xf32 + (size_t)(row0 + ai * HALF + m * 16) * DM + col0;
#pragma unroll
                    for (int bj = 0; bj < 2; ++bj) { xv[m][bj][0] = *(const f32x4*)(rowp + bj * HALF); xv[m][bj][1] = *(const f32x4*)(rowp + bj * HALF + 4); } }
            } else {
                u32x4 xb[4][2];
#pragma unroll
                for (int m = 0; m < 4; ++m) { const bf16_t* rowb = XB + (size_t)(row0 + ai * HALF + m * 16) * DM + col0;
#pragma unroll
                    for (int bj = 0; bj < 2; ++bj) xb[m][bj] = *(const u32x4*)(rowb + bj * HALF); }
#pragma unroll
                for (int m = 0; m < 4; ++m)
#pragma unroll
                    for (int bj = 0; bj < 2; ++bj) { xv[m][bj][0] = (f32x4){bf_lo(xb[m][bj].x), bf_hi(xb[m][bj].x), bf_lo(xb[m][bj].y), bf_hi(xb[m][bj].y)};
                                                     xv[m][bj][1] = (f32x4){bf_lo(xb[m][bj].z), bf_hi(xb[m][bj].z), bf_lo(xb[m][bj].w), bf_hi(xb[m][bj].w)}; }
            }
#pragma unroll
            for (int m = 0; m < 4; ++m) {
                const int row = row0 + ai * HALF + m * 16;
                bf16_t* rowb = XB + (size_t)row * DM + col0;
                float sq = 0.f;
#pragma unroll
                for (int bj = 0; bj < 2; ++bj) {
                    const f32x4 x0 = xv[m][bj][0] + acc[ai][bj][m][0], x1 = xv[m][bj][1] + acc[ai][bj][m][1];
                    u32x4 w; w.x = cvt_pk_bf16(x0[0], x0[1]); w.y = cvt_pk_bf16(x0[2], x0[3]); w.z = cvt_pk_bf16(x1[0], x1[1]); w.w = cvt_pk_bf16(x1[2], x1[3]);
                    *(u32x4*)(rowb + bj * HALF) = w;
                    const float r0 = bf_lo(w.x), r1 = bf_hi(w.x), r2 = bf_lo(w.y), r3 = bf_hi(w.y), r4 = bf_lo(w.z), r5 = bf_hi(w.z), r6 = bf_lo(w.w), r7 = bf_hi(w.w);
                    sq += ((r0 * r0 + r1 * r1) + (r2 * r2 + r3 * r3)) + ((r4 * r4 + r5 * r5) + (r6 * r6 + r7 * r7));
                }
                sq += __shfl_xor(sq, 16); sq += __shfl_xor(sq, 32);
                if (fq == 0) ssn[(size_t)row * 16 + u.pn * 4 + wc] = sq;
            }
        }
    }
};
struct EpiGU {
    static constexpr bool PERM = true, AFTER_DRAIN = false;
    bf16_t* H; const float* ss; const LAS float* rsl; int pm0;
    __device__ __forceinline__ void operator()(const f32x4 (&acc)[2][2][4][2], const Unit& u, int wr, int wc, int fr, int fq) const {
        const int row0 = u.pm * BM + wr * 64 + fr, col0 = u.pn * HALF + wc * 32 + 8 * fq;
#pragma unroll
        for (int ai = 0; ai < 2; ++ai)
#pragma unroll
            for (int m = 0; m < 4; ++m) {
                const int row = row0 + ai * HALF + m * 16;
                const float rs = u.pm == pm0 ? rsl[row - pm0 * BM] : row_rstd(ss, row);
                float h[8];
#pragma unroll
                for (int n = 0; n < 2; ++n)
#pragma unroll
                    for (int i = 0; i < 4; ++i) { const float g = acc[ai][0][m][n][i] * rs, uu = acc[ai][1][m][n][i] * rs; h[n * 4 + i] = silu_f(g) * uu; }
                u32x4 w; w.x = cvt_pk_bf16(h[0], h[1]); w.y = cvt_pk_bf16(h[2], h[3]); w.z = cvt_pk_bf16(h[4], h[5]); w.w = cvt_pk_bf16(h[6], h[7]);
                *(u32x4*)(H + (size_t)row * DFF + col0) = w;
            }
    }
};

template <class Epi, class Sched>
__device__ __forceinline__ void gemm_phase(LAS unsigned char* lds, const Gemm g, const Sched& S, const Epi& E, const int tid) {
    const int wid = __builtin_amdgcn_readfirstlane(tid >> 6), lane = tid & 63, wr = wid >> 2, wc = wid & 3, fr = lane & 15, fq = lane >> 4;
    const int K = g.K, nt = K / BK;
    unsigned voffA[2], voffB[2];
#pragma unroll
    for (int i = 0; i < 2; ++i) { int R, C; stage_rc(tid * 16 + i * 8192, R, C); const int Rb = Epi::PERM ? ((R & ~31) + perm32(R & 31)) : R;
        voffA[i] = (unsigned)(R * K + C) * 2u; voffB[i] = (unsigned)(Rb * K + C) * 2u; }
    const size_t kstep = (size_t)(BK * 2);
    const size_t hstep = (size_t)HALF * K * 2;
    const size_t tstep = 2 * hstep;
    const unsigned ldsw = (unsigned)wid * 1024u;
    const int aoff = lds_byte(wr * 64 + fr, fq * 8), boff = lds_byte(wc * 32 + fr, fq * 8);
#define PG8_SA(b, h) (((b) * 2 + (h)) * HTB)
#define PG8_SB(b, h) ((4 + (b) * 2 + (h)) * HTB)
#define PG8_STAGE(bufoff, gbase, voff) do { _Pragma("unroll") for (int _i = 0; _i < 2; ++_i) \
        __builtin_amdgcn_global_load_lds((const unsigned*)((const char*)(gbase) + (voff)[_i]), (LAS unsigned*)(lds + (bufoff) + ldsw + _i * 8192), 16, 0, 0); } while (0)
#define PG8_LDA(dst, b, h) do { _Pragma("unroll") for (int m = 0; m < 4; ++m) _Pragma("unroll") for (int k = 0; k < 2; ++k) dst[m][k] = *(const LAS bf16x8*)(lds + PG8_SA(b, h) + aoff + m * 2048 + k * 1024); } while (0)
#define PG8_LDB(dst, b, h) do { _Pragma("unroll") for (int n = 0; n < 2; ++n) _Pragma("unroll") for (int k = 0; k < 2; ++k) dst[n][k] = *(const LAS bf16x8*)(lds + PG8_SB(b, h) + boff + n * 2048 + k * 1024); } while (0)
#define PG8_MMA(ai, bj, At, Bt) do { __builtin_amdgcn_s_setprio(1); _Pragma("unroll") for (int m = 0; m < 4; ++m) _Pragma("unroll") for (int n = 0; n < 2; ++n) _Pragma("unroll") for (int k = 0; k < 2; ++k) \
        acc[ai][bj][m][n] = __builtin_amdgcn_mfma_f32_16x16x32_bf16(Bt[n][k], At[m][k], acc[ai][bj][m][n], 0, 0, 0); __builtin_amdgcn_s_setprio(0); } while (0)
#define PG8_WAIT_V(n) asm volatile("s_waitcnt vmcnt(" #n ")" ::: "memory")
#define PG8_WAIT_L(n) asm volatile("s_waitcnt lgkmcnt(" #n ")" ::: "memory")
#define PG8_BAR __builtin_amdgcn_s_barrier()
#define PG8_SCHED __builtin_amdgcn_sched_barrier(0)
    Unit cur, nxt; int ui = 0;
    if (!S.next(0, cur)) return;
    f32x4 acc[2][2][4][2];
#pragma unroll
    for (int a = 0; a < 2; ++a)
#pragma unroll
        for (int b = 0; b < 2; ++b)
#pragma unroll
            for (int m = 0; m < 4; ++m)
#pragma unroll
                for (int n = 0; n < 2; ++n) acc[a][b][m][n] = (f32x4){0.f, 0.f, 0.f, 0.f};
    bf16x8 At[4][2], B0[2][2], B1[2][2];
    const char* cA = (const char*)g.A + (size_t)cur.pm * tstep; const char* cB = (const char*)g.Bt + (size_t)cur.pn * tstep;
    S.a_ready(cur);
    PG8_STAGE(PG8_SB(0, 0), cB, voffB); PG8_STAGE(PG8_SA(0, 0), cA, voffA); PG8_STAGE(PG8_SB(0, 1), cB + hstep, voffB); PG8_STAGE(PG8_SA(0, 1), cA + hstep, voffA);
    if (wr == 1) PG8_BAR;
    PG8_WAIT_V(4); PG8_BAR;
    PG8_STAGE(PG8_SB(1, 0), cB + kstep, voffB); PG8_STAGE(PG8_SA(1, 0), cA + kstep, voffA); PG8_STAGE(PG8_SB(1, 1), cB + hstep + kstep, voffB);
    PG8_WAIT_V(6); PG8_BAR;
    for (;;) {
        const bool has_next = S.next(ui + 1, nxt);
        const char* nA = has_next ? (const char*)g.A + (size_t)nxt.pm * tstep : cA; const char* nB = has_next ? (const char*)g.Bt + (size_t)nxt.pn * tstep : cB;
        for (int t = 0; t < nt; t += 2) {
            const bool last = (t == nt - 2);
            const char* a1 = cA + (size_t)(t + 1) * kstep;
            const char* a2 = last ? nA : cA + (size_t)(t + 2) * kstep; const char* b2 = last ? nB : cB + (size_t)(t + 2) * kstep;
            const char* a3 = a2 + kstep; const char* b3 = b2 + kstep;
            if (last && has_next) S.a_ready(nxt);
            PG8_LDB(B0, 0, 0); PG8_SCHED; PG8_LDA(At, 0, 0); PG8_STAGE(PG8_SA(1, 1), a1 + hstep, voffA);
            PG8_WAIT_L(8); PG8_BAR; PG8_WAIT_L(0); PG8_MMA(0, 0, At, B0); PG8_BAR; PG8_SCHED;
            PG8_LDB(B1, 0, 1); PG8_STAGE(PG8_SB(0, 0), b2, voffB);
            PG8_BAR; PG8_WAIT_L(0); PG8_MMA(0, 1, At, B1); PG8_BAR;
            PG8_LDA(At, 0, 1); PG8_STAGE(PG8_SA(0, 0), a2, voffA);
            PG8_BAR; PG8_WAIT_L(0); PG8_MMA(1, 0, At, B0); PG8_BAR; PG8_SCHED;
            PG8_STAGE(PG8_SB(0, 1), b2 + hstep, voffB);
            PG8_WAIT_V(6); PG8_BAR; PG8_MMA(1, 1, At, B1); PG8_BAR;
            PG8_LDB(B0, 1, 0); PG8_SCHED; PG8_LDA(At, 1, 0); PG8_STAGE(PG8_SA(0, 1), a2 + hstep, voffA);
            PG8_WAIT_L(8); PG8_BAR; PG8_WAIT_L(0); PG8_MMA(0, 0, At, B0); PG8_BAR; PG8_SCHED;
            PG8_LDB(B1, 1, 1); PG8_STAGE(PG8_SB(1, 0), b3, voffB);
            PG8_BAR; PG8_WAIT_L(0); PG8_MMA(0, 1, At, B1); PG8_BAR;
            PG8_LDA(At, 1, 1); PG8_STAGE(PG8_SA(1, 0), a3, voffA);
            PG8_BAR; PG8_WAIT_L(0); PG8_MMA(1, 0, At, B0); PG8_BAR; PG8_SCHED;
            PG8_STAGE(PG8_SB(1, 1), b3 + hstep, voffB);
            PG8_WAIT_V(6); PG8_BAR; PG8_MMA(1, 1, At, B1); PG8_BAR;
        }
        E(acc, cur, wr, wc, fr, fq); S.done(cur);
        if (!has_next) break;
#pragma unroll
        for (int a = 0; a < 2; ++a)
#pragma unroll
            for (int b = 0; b < 2; ++b)
#pragma unroll
                for (int m = 0; m < 4; ++m)
#pragma unroll
                    for (int n = 0; n < 2; ++n) acc[a][b][m][n] = (f32x4){0.f, 0.f, 0.f, 0.f};
        cur = nxt; cA = nA; cB = nB; ++ui;
    }
    PG8_WAIT_V(0);
    if (wr == 0) PG8_BAR;
    PG8_BAR;
#undef PG8_SA
#undef PG8_SB
#undef PG8_STAGE
#undef PG8_LDA
#undef PG8_LDB
#undef PG8_MMA
#undef PG8_WAIT_V
#undef PG8_WAIT_L
#undef PG8_BAR
#undef PG8_SCHED
}
}

struct Args { const float* in[24]; float* out; unsigned char* ws; int ph_lo, ph_hi; };
struct Frame {
    LAS unsigned char* lds;
    int tid, lane, wave, G, blk;
    const float* const* in;
    float* out; unsigned char* ws;
    unsigned* ctl;
};
#define IN_XP 0
#define IN_XS 1
#define IN_CK 2
#define IN_CV 3
#define IN_CKI 4
#define IN_SPOOL 5
#define IN_SGLA 6
#define IN_PT 7
#define IN_META 8
#define IN_NMIX 9
#define IN_NFFN 10
#define IN_NFIN 11
#define IN_WINE 12
#define IN_WOUTE 13
#define IN_POOLW 14
#define IN_POOLS 15
#define IN_WINO 16
#define IN_WGATE 17
#define IN_BGATE 18
#define IN_GNORM 19
#define IN_WOUTO 20
#define IN_FG 21
#define IN_FU 22
#define IN_FD 23

constexpr int TR0 = 16384, NTM = 10, TROWS = 160;
constexpr int SKL_PART = 0, SKL_GATE = 81920, SKL_RS = SKL_GATE + 10240, SKL_SQ = SKL_RS + 640, SKL_END = SKL_SQ + 2560;
static_assert(SKL_END <= LDS_MISC, "skinny lds");
enum { SKM_PROJ = 0, SKM_RES = 1, SKM_GU = 2 };
struct SkinnyEpi { float* C; int ldc; int even; bf16_t* kvb; _Float16* kih; float* out; int eidx; bf16_t* qb16; _Float16* qih;
                   bf16_t* XB; float* sst_next;
                   bf16_t* H; };
__device__ __forceinline__ void skinny_rstd_to_lds(const float* sst, LAS float* rs_l, int tid) {
    if (tid < TROWS) {
        const float* p = sst + (size_t)tid * 64; float s = 0.f;
#pragma unroll
        for (int i = 0; i < 16; ++i) { const f32x4 a = *(const f32x4*)(p + 4 * i); s += (a[0] + a[1]) + (a[2] + a[3]); }
        rs_l[tid] = rsqrtf(s * (1.f / DM) + EPS);
    }
}
template <int MT, int NS>
__device__ __forceinline__ void skinny_load(const bf16_t* ap, const bf16_t* bp, int K, const int (&n0)[NS], int ks, bf16x8 (&Af)[MT], bf16x8 (&Bf)[NS]) {
#pragma unroll
    for (int ns = 0; ns < NS; ++ns) Bf[ns] = *(const bf16x8*)(bp + (size_t)n0[ns] * K + 32 * ks);
#pragma unroll
    for (int mt = 0; mt < MT; ++mt) Af[mt] = *(const bf16x8*)(ap + (size_t)(16 * mt) * K + 32 * ks);
}
template <int MT, int NS>
__device__ __forceinline__ void skinny_mma(const bf16x8 (&Af)[MT], const bf16x8 (&Bf)[NS], f32x4 (&acc)[MT][NS]) {
#pragma unroll
    for (int mt = 0; mt < MT; ++mt)
#pragma unroll
        for (int ns = 0; ns < NS; ++ns) acc[mt][ns] = __builtin_amdgcn_mfma_f32_16x16x32_bf16(Bf[ns], Af[mt], acc[mt][ns], 0, 0, 0);
}
template <int MT, int NS>
__device__ __forceinline__ void skinny_kloop(const bf16_t* A, const bf16_t* Bt, int K, int mt0, const int (&n0)[NS], int ks0, int ks1, int lane, f32x4 (&acc)[MT][NS]) {
    const int fr = lane & 15, fq = lane >> 4;
    const bf16_t* ap = A + (size_t)(TR0 + 16 * mt0 + fr) * K + 8 * fq; const bf16_t* bp = Bt + (size_t)fr * K + 8 * fq;
    bf16x8 A0[MT], B0[NS], A1[MT], B1[NS];
    skinny_load<MT, NS>(ap, bp, K, n0, ks0, A0, B0);
    for (int ks = ks0; ks < ks1; ks += 2) {
        skinny_load<MT, NS>(ap, bp, K, n0, ks + 1 < ks1 ? ks + 1 : ks, A1, B1);
        skinny_mma<MT, NS>(A0, B0, acc);
        skinny_load<MT, NS>(ap, bp, K, n0, ks + 2 < ks1 ? ks + 2 : ks, A0, B0);
        if (ks + 1 < ks1) skinny_mma<MT, NS>(A1, B1, acc);
    }
}
template <int MODE, int MT, int NS>
__device__ __forceinline__ void skinny_phase(Frame& F, const bf16_t* A, const bf16_t* Bt, int K, int nslices, const float* sst_in, const SkinnyEpi& E, int wg0 = 0) {
    static_assert(NTM % MT == 0 && MT * 64 <= 512 && 8 * MT * NS * 1024 <= SKL_GATE, "skinny tile");
    const int tid = F.tid, lane = F.lane, w = F.wave;
    LAS float* part = (LAS float*)(F.lds + SKL_PART); LAS float* rs_l = (LAS float*)(F.lds + SKL_RS); LAS float* sq_l = (LAS float*)(F.lds + SKL_SQ);
    __syncthreads();
    if (MODE != SKM_RES) skinny_rstd_to_lds(sst_in, rs_l, tid);
    const int ksteps = K / 32, kw = ksteps / 8, ks0 = w * kw, ks1 = ks0 + kw;
    constexpr int NMG = NTM / MT;
    const int nng = MODE == SKM_GU ? nslices : (nslices + NS - 1) / NS, nunits = nng * NMG;
    for (int u = F.blk - wg0; u >= 0 && u < nunits; u += F.G - wg0) {
        const int mg = u % NMG, ng = u / NMG, mt0 = mg * MT;
        int n0[NS]; int sl[NS];
#pragma unroll
        for (int ns = 0; ns < NS; ++ns) {
            if (MODE == SKM_GU) { sl[ns] = ng; n0[ns] = 256 * (ng >> 3) + 16 * (ng & 7) + 128 * ns; }
            else { const int sraw = ng * NS + ns; sl[ns] = sraw < nslices ? sraw : nslices - 1; n0[ns] = 16 * sl[ns]; }
        }
        f32x4 acc[MT][NS];
#pragma unroll
        for (int mt = 0; mt < MT; ++mt)
#pragma unroll
            for (int ns = 0; ns < NS; ++ns) acc[mt][ns] = (f32x4){0.f, 0.f, 0.f, 0.f};
        skinny_kloop<MT, NS>(A, Bt, K, mt0, n0, ks0, ks1, lane, acc);
        __syncthreads();
#pragma unroll
        for (int mt = 0; mt < MT; ++mt)
#pragma unroll
            for (int ns = 0; ns < NS; ++ns) *(LAS f32x4*)(part + (((w * MT + mt) * NS + ns) * 64 + lane) * 4) = acc[mt][ns];
        __syncthreads();
        if (tid < MT * 64) {
            const int mt = tid >> 6, ln = tid & 63, fr = ln & 15, fq = ln >> 4, trow = 16 * (mt0 + mt) + fr, row = TR0 + trow;
            f32x4 red[NS];
#pragma unroll
            for (int ns = 0; ns < NS; ++ns) {
                f32x4 sum = *(const LAS f32x4*)(part + (((0 * MT + mt) * NS + ns) * 64 + ln) * 4);
#pragma unroll
                for (int ww = 1; ww < 8; ++ww) sum += *(const LAS f32x4*)(part + (((ww * MT + mt) * NS + ns) * 64 + ln) * 4);
                red[ns] = sum;
            }
            if (MODE == SKM_PROJ) {
                const float rs = rs_l[trow];
#pragma unroll
                for (int ns = 0; ns < NS; ++ns) {
                    const int col = 16 * sl[ns] + 4 * fq; const f32x4 v = red[ns] * rs;
                    if (!E.even) { u32x2 wv; wv.x = cvt_pk_bf16(v[0], v[1]); wv.y = cvt_pk_bf16(v[2], v[3]); *(u32x2*)((bf16_t*)E.C + (size_t)row * PLB + col) = wv; }
                    else if (col < EQI) { u32x2 wv; wv.x = cvt_pk_bf16(v[0], v[1]); wv.y = cvt_pk_bf16(v[2], v[3]); *(u32x2*)(E.qb16 + (size_t)row * 512 + col) = wv; }
                    else if (col < EU) { f16x4 hq; hq[0] = (_Float16)v[0]; hq[1] = (_Float16)v[1]; hq[2] = (_Float16)v[2]; hq[3] = (_Float16)v[3]; *(f16x4*)(E.qih + (size_t)row * 512 + (col - EQI)) = hq; }
                    else *(f32x4*)(E.C + (size_t)row * E.ldc + col) = v;
                    if (E.even && col >= EK && col < EKI + 64) proj_even_extras(row, col, v, E.kvb, E.kih, E.out, E.eidx);
                }
            } else if (MODE == SKM_RES) {
#pragma unroll
                for (int ns = 0; ns < NS; ++ns) {
                    const int col = 16 * sl[ns] + 4 * fq;
                    const bool dup = (ng * NS + ns) >= nslices;
                    if (!dup) {
                        const u32x2 xb = *(const u32x2*)(E.XB + (size_t)row * DM + col);
                        const f32x4 x = (f32x4){bf_lo(xb.x), bf_hi(xb.x), bf_lo(xb.y), bf_hi(xb.y)} + red[ns];
                        u32x2 wv; wv.x = cvt_pk_bf16(x[0], x[1]); wv.y = cvt_pk_bf16(x[2], x[3]); *(u32x2*)(E.XB + (size_t)row * DM + col) = wv;
                        const float r0 = bf_lo(wv.x), r1 = bf_hi(wv.x), r2 = bf_lo(wv.y), r3 = bf_hi(wv.y);
                        sq_l[(ns * MT * 16 + mt * 16 + fr) * 4 + fq] = (r0 * r0 + r1 * r1) + (r2 * r2 + r3 * r3);
                    }
                }
            } else {
                const float rs = rs_l[trow]; const f32x4 g = red[0] * rs, uu = red[NS - 1] * rs;
                u32x2 wv; wv.x = cvt_pk_bf16(silu_f(g[0]) * uu[0], silu_f(g[1]) * uu[1]); wv.y = cvt_pk_bf16(silu_f(g[2]) * uu[2], silu_f(g[3]) * uu[3]);
                *(u32x2*)(E.H + (size_t)row * DFF + 16 * ng + 4 * fq) = wv;
            }
        }
        if (MODE == SKM_RES) {
            __syncthreads();
            if (tid < NS * MT * 16) {
                const int ns = tid / (MT * 16), r = tid % (MT * 16), sraw = ng * NS + ns;
                if (sraw < nslices) E.sst_next[(size_t)(16 * mt0 + r) * 64 + sraw] = (sq_l[tid * 4] + sq_l[tid * 4 + 1]) + (sq_l[tid * 4 + 2] + sq_l[tid * 4 + 3]);
            }
        }
    }
    __syncthreads();
}

constexpr int LDS_RSL = 131072;
static_assert(LDS_RSL + 1024 <= LDS_MISC, "gemm lds");
__device__ __forceinline__ int panel_rstd_to_lds(Frame& F, const float* ss, int M, int N) {
    pg8::StaticOrder S; S.init(M, N, F.G, F.blk); pg8::Unit u;
    int pm0 = -1;
    if (S.next(0, u)) pm0 = u.pm;
    __syncthreads();
    if (pm0 >= 0 && F.tid < 256) ((LAS float*)(F.lds + LDS_RSL))[F.tid] = row_rstd(ss, pm0 * 256 + F.tid);
    __syncthreads();
    return pm0;
}

__device__ __forceinline__ void tr_item(const float* W, int Nsrc, int c0, int nvalid, bf16_t* dst, int K, int k0, const float* gain, float scale, LAS float* scr, int lane) {
    const int nn = lane & 31, hi = lane >> 5, c = lane & 7;
    const float* wp = W + (size_t)(k0 + hi) * Nsrc + c0 + (nn < nvalid ? nn : 0);
    float v[32];
#pragma unroll
    for (int i = 0; i < 32; ++i) v[i] = wp[(size_t)(2 * i) * Nsrc];
    f32x4 g0 = (f32x4){1.f, 1.f, 1.f, 1.f}, g1 = g0;
    if (gain) { g0 = *(const f32x4*)(gain + k0 + 8 * c); g1 = *(const f32x4*)(gain + k0 + 8 * c + 4); }
    __builtin_amdgcn_sched_barrier(0);
#pragma unroll
    for (int i = 0; i < 32; ++i) scr[(2 * i + hi) * 33 + nn] = nn < nvalid ? v[i] * scale : 0.f;
    asm volatile("s_waitcnt lgkmcnt(0)" ::: "memory");
#pragma unroll
    for (int j = 0; j < 4; ++j) {
        const int n = (lane >> 3) + 8 * j; const LAS float* s = scr + (8 * c) * 33 + n;
        u32x4 o; o.x = cvt_pk_bf16(s[0 * 33] * g0[0], s[1 * 33] * g0[1]); o.y = cvt_pk_bf16(s[2 * 33] * g0[2], s[3 * 33] * g0[3]); o.z = cvt_pk_bf16(s[4 * 33] * g1[0], s[5 * 33] * g1[1]); o.w = cvt_pk_bf16(s[6 * 33] * g1[2], s[7 * 33] * g1[3]);
        *(u32x4*)(dst + (size_t)n * K + k0 + 8 * c) = o;
    }
    asm volatile("s_waitcnt lgkmcnt(0)" ::: "memory");
}

__device__ __forceinline__ void convert_weights(Frame& F, int part, int gw, int NGW, int fb, int nfb) {
    LAS float* scr = (LAS float*)(F.lds + F.wave * 16384);
    const int lane = F.lane;
    unsigned char* ws = F.ws;
    constexpr int I_WINE = (NE / 32) * 16, I_WINO = (NO / 32) * 16, I_WOE = 32 * 8, I_WOO = 32 * 16, I_GU = (NGU / 32) * 16, I_DN = 32 * (DFF / 64);
    constexpr int NITEMS = 2 * I_WINE + 2 * I_WINO + 2 * I_WOE + 2 * I_WOO + 4 * I_GU + 4 * I_DN;
#define CW_WANT(early) (part == 2 || (part == 0) == (early))
    for (int it = gw; it < NITEMS; it += NGW) {
        int r = it;
        if (r < 2 * I_WINE) {
            const int e = r / I_WINE; r %= I_WINE; if (!CW_WANT(e == 0)) continue; const int ch = r / 16, kb = r % 16, n0 = ch * 32;
            int src, nv = 32; float sc = 1.f;
            if (n0 < 512) { src = n0; sc = 0.125f; }
            else if (n0 < 1024) src = 768 + (n0 - 512);
            else if (n0 < 1536) src = 1352 + (n0 - 1024);
            else if (n0 < 1664) src = 512 + (n0 - 1536);
            else if (n0 < 1792) src = 640 + (n0 - 1664);
            else if (n0 < 1856) src = 1280 + (n0 - 1792);
            else if (n0 == 1856) { src = 1344; nv = 8; }
            else { src = 0; nv = 0; }
            tr_item(F.in[IN_WINE] + (size_t)e * DM * EIN, EIN, src, nv, (bf16_t*)(ws + WS_WINE) + ((size_t)e * NE + n0) * DM, DM, kb * 64, F.in[IN_NMIX] + (2 * e) * DM, sc, scr, lane);
            continue;
        }
        r -= 2 * I_WINE;
        if (r < 2 * I_WINO) {
            const int o = r / I_WINO; r %= I_WINO; if (!CW_WANT(o == 0)) continue; const int ch = r / 16, kb = r % 16, n0 = ch * 32;
            int nv = 32; float sc = 1.f;
            if (n0 < 512) sc = 0.08838834764831845f;
            if (n0 == 3072) nv = 16; else if (n0 > 3072) nv = 0;
            tr_item(F.in[IN_WINO] + (size_t)o * DM * OIN, OIN, nv ? n0 : 0, nv, (bf16_t*)(ws + WS_WINO) + ((size_t)o * NO + n0) * DM, DM, kb * 64, F.in[IN_NMIX] + (2 * o + 1) * DM, sc, scr, lane);
            continue;
        }
        r -= 2 * I_WINO;
        if (r < 2 * I_WOE) {
            const int e = r / I_WOE; r %= I_WOE; if (!CW_WANT(e == 0)) continue; const int ch = r / 8, kb = r % 8, n0 = ch * 32;
            tr_item(F.in[IN_WOUTE] + (size_t)e * DM * DM, DM, n0, 32, (bf16_t*)(ws + WS_WOUTE) + ((size_t)e * DM + n0) * DM, DM, kb * 64, nullptr, 1.f, scr, lane);
            continue;
        }
        r -= 2 * I_WOE;
        if (r < 2 * I_WOO) {
            const int o = r / I_WOO; r %= I_WOO; if (!CW_WANT(false)) continue; const int ch = r / 16, kb = r % 16, n0 = ch * 32;
            tr_item(F.in[IN_WOUTO] + (size_t)o * DM * DM, DM, n0, 32, (bf16_t*)(ws + WS_WOUTO) + ((size_t)o * DM + n0) * DM, DM, kb * 64, nullptr, 1.f, scr, lane);
            continue;
        }
        r -= 2 * I_WOO;
        if (r < 4 * I_GU) {
            const int l = r / I_GU; r %= I_GU; if (!CW_WANT(l == 0)) continue; const int ch = r / 16, kb = r % 16, n0 = ch * 32, tile = n0 >> 8, within = n0 & 255;
            const float* W = (within < 128 ? F.in[IN_FG] : F.in[IN_FU]) + (size_t)l * DM * DFF;
            tr_item(W, DFF, tile * 128 + (within & 127), 32, (bf16_t*)(ws + WS_WGU) + ((size_t)l * NGU + n0) * DM, DM, kb * 64, F.in[IN_NFFN] + l * DM, 1.f, scr, lane);
            continue;
        }
        r -= 4 * I_GU;
        {
            const int l = r / I_DN; r %= I_DN; if (!CW_WANT(l == 0)) continue; const int ch = r / (DFF / 64), kb = r % (DFF / 64), n0 = ch * 32;
            tr_item(F.in[IN_FD] + (size_t)l * DFF * DM, DM, n0, 32, (bf16_t*)(ws + WS_WDN) + ((size_t)l * DM + n0) * DFF, DFF, kb * 64, nullptr, 1.f, scr, lane);
        }
    }
    LAS float* pwl = (LAS float*)(F.lds + 131072); LAS float* psl = pwl + 1024;
    for (int it = fb; it < 256; it += nfb) {
        const int e = it >> 7, g = (it >> 5) & 3, cb = (it >> 1) & 15, nb = it & 1, n = nb * 512 + F.tid;
        if (!CW_WANT(e == 0)) continue;
        const float* pw = F.in[IN_POOLW] + ((size_t)(e * 4 + g) * 128 + cb * 8) * 128;
        const float* ps = F.in[IN_POOLS] + e * 512 + g * 128;
        const float* wo = F.in[IN_WOUTE] + ((size_t)e * DM + 512 + g * 128) * DM + n;
        __syncthreads();
        pwl[F.tid] = pw[F.tid]; pwl[512 + F.tid] = pw[512 + F.tid]; if (F.tid < 128) psl[F.tid] = ps[F.tid];
        __syncthreads();
        float a[8];
#pragma unroll
        for (int c = 0; c < 8; ++c) a[c] = 0.f;
#pragma unroll 1
        for (int j0 = 0; j0 < 128; j0 += 32) {
            float wv[32];
#pragma unroll
            for (int jj = 0; jj < 32; ++jj) wv[jj] = wo[(size_t)(j0 + jj) * DM];
            __builtin_amdgcn_sched_barrier(0);
#pragma unroll
            for (int jj = 0; jj < 32; ++jj) {
                const float x = wv[jj] * psl[j0 + jj];
#pragma unroll
                for (int c = 0; c < 8; ++c) a[c] += pwl[c * 128 + j0 + jj] * x;
            }
        }
        u32x4 o; o.x = cvt_pk_bf16(a[0], a[1]); o.y = cvt_pk_bf16(a[2], a[3]); o.z = cvt_pk_bf16(a[4], a[5]); o.w = cvt_pk_bf16(a[6], a[7]);
        *(u32x4*)((bf16_t*)(ws + WS_WOUTE) + ((size_t)e * DM + n) * DM + 512 + g * 128 + cb * 8) = o;
    }
#undef CW_WANT
}
__device__ __forceinline__ void p0_prologue(Frame& F) {
    const int gw = F.blk * 8 + F.wave, NGW = F.G * 8, lane = F.lane;
    unsigned char* ws = F.ws;
    convert_weights(F, F.G > 128 ? 0 : 2, gw, NGW, F.blk, F.G);
    bf16_t* XB = (bf16_t*)(ws + WS_XB); float* ss0 = (float*)(ws + WS_SSP); float* sst0 = (float*)(ws + WS_SST);
    bf16_t* ACT = (bf16_t*)(ws + WS_ACT);
    for (int row0 = gw; row0 < MP; row0 += 4 * NGW) {
        f32x4 v[4][4];
#pragma unroll
        for (int i = 0; i < 4; ++i) {
            const int row = row0 + i * NGW;
            const float* src = nullptr;
            if (row < ROW_META) src = F.in[IN_XP] + (size_t)row * DM;
            else if (row < ROW_SAMP) src = F.in[IN_META] + (size_t)(row - ROW_META) * DM;
            else if (row < MREAL) src = F.in[IN_XS] + (size_t)(row - ROW_SAMP) * DM;
#pragma unroll
            for (int j = 0; j < 4; ++j) { v[i][j] = (f32x4){0.f, 0.f, 0.f, 0.f}; if (src) v[i][j] = *(const f32x4*)(src + 256 * j + 4 * lane); }
        }
        __builtin_amdgcn_sched_barrier(0);
#pragma unroll
        for (int i = 0; i < 4; ++i) {
            const int row = row0 + i * NGW;
            if (row >= MP) continue;
            float sq = 0.f;
#pragma unroll
            for (int j = 0; j < 4; ++j) {
                u32x2 w; w.x = cvt_pk_bf16(v[i][j][0], v[i][j][1]); w.y = cvt_pk_bf16(v[i][j][2], v[i][j][3]);
                *(u32x2*)(XB + (size_t)row * DM + 256 * j + 4 * lane) = w;
                if (row >= MREAL) *(u32x2*)(ACT + (size_t)row * DM + 256 * j + 4 * lane) = (u32x2){0u, 0u};
                sq += (v[i][j][0] * v[i][j][0] + v[i][j][1] * v[i][j][1]) + (v[i][j][2] * v[i][j][2] + v[i][j][3] * v[i][j][3]);
            }
            sq = wave_sum(sq);
            if (row < TR0) { if (lane < 16) ss0[(size_t)row * 16 + lane] = lane == 0 ? sq : 0.f; }
            else if (row < TR0 + TROWS) sst0[(size_t)(row - TR0) * 64 + lane] = lane == 0 ? sq : 0.f;
        }
    }
}

__device__ __forceinline__ unsigned f2key(float s) {
    const _Float16 h = (_Float16)s; const unsigned b = __builtin_bit_cast(unsigned short, h);
    return (b & 0x8000u) ? (~b & 0xffffu) : (b | 0x8000u);
}
template <int NREG>
__device__ __forceinline__ int select_topk(const LAS u16* row, int nvis, LAS u16* list, int lane) {
    if (nvis <= 256) { for (int j = lane; j < nvis; j += 64) list[j] = (u16)j; return nvis; }
    const LAS unsigned* r32 = (const LAS unsigned*)row;
    const int nsteps = (nvis + 127) >> 7;
    unsigned T = 0u; int cgt = 0;
    if constexpr (NREG > 0) {
        unsigned kr[NREG];
#pragma unroll
        for (int s = 0; s < NREG; ++s) kr[s] = s < nsteps ? r32[s * 64 + lane] : 0u;
        for (int bit = 15; bit >= 0; --bit) {
            const unsigned cand = T | (1u << bit), ch = cand << 16;
            int cnt = 0;
#pragma unroll
            for (int s = 0; s < NREG; ++s) cnt += __popcll(__ballot((kr[s] << 16) >= ch)) + __popcll(__ballot(kr[s] >= ch));
            if (cnt >= 256) T = cand;
        }
        { const unsigned ch = (T << 16) | 0xffffu;
#pragma unroll
          for (int s = 0; s < NREG; ++s) cgt += __popcll(__ballot(((kr[s] << 16) | 0xffffu) > ch)) + __popcll(__ballot((kr[s] | 0xffffu) > ch)); }
        const int need = 256 - cgt;
        int base = 0, tbase = 0;
#pragma unroll
        for (int s = 0; s < NREG; ++s) {
            const unsigned k2 = kr[s]; const unsigned lo = k2 & 0xffffu, hi = k2 >> 16;
            const bool tl = (lo == T), th = (hi == T);
            const unsigned long long btl = __ballot(tl), bth = __ballot(th);
            const int rl = tbase + (int)mbcnt64(btl) + (int)mbcnt64(bth), rh = rl + (tl ? 1 : 0);
            const bool sl = (lo > T) || (tl && rl < need), sh = (hi > T) || (th && rh < need);
            const unsigned long long bsl = __ballot(sl), bsh = __ballot(sh);
            const int ol = base + (int)mbcnt64(bsl) + (int)mbcnt64(bsh), oh = ol + (sl ? 1 : 0);
            const int pos = 2 * (s * 64 + lane);
            if (sl && ol < 256) list[ol] = (u16)pos;
            if (sh && oh < 256) list[oh] = (u16)(pos + 1);
            base += __popcll(bsl) + __popcll(bsh); tbase += __popcll(btl) + __popcll(bth);
        }
        return base < 256 ? base : 256;
    } else {
        for (int bit = 15; bit >= 0; --bit) {
            const unsigned cand = T | (1u << bit), ch = cand << 16;
            int cnt = 0;
#pragma unroll 5
            for (int s = 0; s < nsteps; ++s) { const unsigned k2 = r32[s * 64 + lane]; cnt += __popcll(__ballot((k2 << 16) >= ch)) + __popcll(__ballot(k2 >= ch)); }
            if (cnt >= 256) T = cand;
        }
#pragma unroll 5
        for (int s = 0; s < nsteps; ++s) { const unsigned k2 = r32[s * 64 + lane]; cgt += __popcll(__ballot((k2 & 0xffffu) > T)) + __popcll(__ballot((k2 >> 16) > T)); }
        const int need = 256 - cgt;
        int base = 0, tbase = 0;
#pragma unroll 5
        for (int s = 0; s < nsteps; ++s) {
            const unsigned k2 = r32[s * 64 + lane]; const unsigned lo = k2 & 0xffffu, hi = k2 >> 16;
            const bool tl = (lo == T), th = (hi == T);
            const unsigned long long btl = __ballot(tl), bth = __ballot(th);
            const int rl = tbase + (int)mbcnt64(btl) + (int)mbcnt64(bth), rh = rl + (tl ? 1 : 0);
            const bool sl = (lo > T) || (tl && rl < need), sh = (hi > T) || (th && rh < need);
            const unsigned long long bsl = __ballot(sl), bsh = __ballot(sh);
            const int ol = base + (int)mbcnt64(bsl) + (int)mbcnt64(bsh), oh = ol + (sl ? 1 : 0);
            const int pos = 2 * (s * 64 + lane);
            if (sl && ol < 256) list[ol] = (u16)pos;
            if (sh && oh < 256) list[oh] = (u16)(pos + 1);
            base += __popcll(bsl) + __popcll(bsh); tbase += __popcll(btl) + __popcll(bth);
        }
        return base < 256 ? base : 256;
    }
}

constexpr int MASK_WORDS = 68;
template <int NREG>
__device__ __forceinline__ void select_mask(const LAS u16* row, int nvis, LAS unsigned* mask, int lane) {
    if (nvis <= 256) {
        for (int j = lane; j < MASK_WORDS; j += 64) mask[j] = (32 * j + 32 <= nvis) ? 0xffffffffu : (32 * j < nvis ? ((1u << (nvis - 32 * j)) - 1u) : 0u);
        return;
    }
    for (int j = lane; j < MASK_WORDS; j += 64) mask[j] = 0u;
    const LAS unsigned* r32 = (const LAS unsigned*)row;
    const int nsteps = (nvis + 127) >> 7;
    unsigned T = 0u; int cgt = 0;
    unsigned kr[NREG];
#pragma unroll
    for (int s = 0; s < NREG; ++s) kr[s] = s < nsteps ? r32[s * 64 + lane] : 0u;
    for (int bit = 15; bit >= 0; --bit) {
        const unsigned cand = T | (1u << bit), ch = cand << 16;
        int cnt = 0;
#pragma unroll
        for (int s = 0; s < NREG; ++s) cnt += __popcll(__ballot((kr[s] << 16) >= ch)) + __popcll(__ballot(kr[s] >= ch));
        if (cnt >= 256) T = cand;
    }
    { const unsigned ch = (T << 16) | 0xffffu;
#pragma unroll
      for (int s = 0; s < NREG; ++s) cgt += __popcll(__ballot(((kr[s] << 16) | 0xffffu) > ch)) + __popcll(__ballot((kr[s] | 0xffffu) > ch)); }
    const int need = 256 - cgt;
    int tbase = 0;
#pragma unroll
    for (int s = 0; s < NREG; ++s) {
        const unsigned k2 = kr[s]; const unsigned lo = k2 & 0xffffu, hi = k2 >> 16;
        const bool tl = (lo == T), th = (hi == T);
        const unsigned long long btl = __ballot(tl), bth = __ballot(th);
        const int rl = tbase + (int)mbcnt64(btl) + (int)mbcnt64(bth), rh = rl + (tl ? 1 : 0);
        const bool sl = (lo > T) || (tl && rl < need), sh = (hi > T) || (th && rh < need);
        const int pos = 2 * (s * 64 + lane);
        const unsigned bits = (sl ? 1u : 0u) | (sh ? 2u : 0u);
        if (bits) (void)__hip_atomic_fetch_or(mask + (pos >> 5), bits << (pos & 31), __ATOMIC_RELAXED, __HIP_MEMORY_SCOPE_WORKGROUP);
        tbase += __popcll(btl) + __popcll(bth);
    }
}

template <int NR>
__device__ __forceinline__ void select_topk_pair(const LAS u16* row, int nvis, LAS u16* list, volatile LAS int* xch, int lane, int w) {
    const int half = w & 1, s0 = NR * half;
    const LAS unsigned* r32 = (const LAS unsigned*)row + s0 * 64 + lane;
    unsigned T = 0u;
    for (int bit = 15; bit >= 0; --bit) {
        const unsigned cand = T | (1u << bit), ch = cand << 16;
        int cnt = 0;
#pragma unroll 11
        for (int s = 0; s < NR; ++s) { const unsigned kv = r32[s * 64]; cnt += __popcll(__ballot((kv << 16) >= ch)) + __popcll(__ballot(kv >= ch)); }
        if (lane == 0) xch[(bit & 1) * 8 + w] = cnt;
        __syncthreads();
        if (cnt + xch[(bit & 1) * 8 + (w ^ 1)] >= 256) T = cand;
    }
    int cgt = 0, cti = 0;
#pragma unroll 11
    for (int s = 0; s < NR; ++s) { const unsigned kv = r32[s * 64]; const unsigned lo = kv & 0xffffu, hi = kv >> 16;
        cgt += __popcll(__ballot(lo > T)) + __popcll(__ballot(hi > T)); cti += __popcll(__ballot(lo == T)) + __popcll(__ballot(hi == T)); }
    if (lane == 0) { xch[16 + 2 * w] = cgt; xch[16 + 2 * w + 1] = cti; }
    __syncthreads();
    const int cgt_p = xch[16 + 2 * (w ^ 1)], cti_p = xch[16 + 2 * (w ^ 1) + 1];
    const int need = 256 - (cgt + cgt_p);
    int base = half ? cgt_p + (cti_p < need ? cti_p : need) : 0, tbase = half ? cti_p : 0;
#pragma unroll 3
    for (int s = 0; s < NR; ++s) {
        const unsigned k2 = r32[s * 64]; const unsigned lo = k2 & 0xffffu, hi = k2 >> 16;
        const bool tl = (lo == T), th = (hi == T);
        const unsigned long long btl = __ballot(tl), bth = __ballot(th);
        const int rl = tbase + (int)mbcnt64(btl) + (int)mbcnt64(bth), rh = rl + (tl ? 1 : 0);
        const bool sl = (lo > T) || (tl && rl < need), sh = (hi > T) || (th && rh < need);
        const unsigned long long bsl = __ballot(sl), bsh = __ballot(sh);
        const int ol = base + (int)mbcnt64(bsl) + (int)mbcnt64(bsh), oh = ol + (sl ? 1 : 0);
        const int pos = 2 * ((s0 + s) * 64 + lane);
        if (sl && ol < 256) list[ol] = (u16)pos;
        if (sh && oh < 256) list[oh] = (u16)(pos + 1);
        base += __popcll(bsl) + __popcll(bsh); tbase += __popcll(btl) + __popcll(bth);
    }
}

struct SrcPrompt {
    const bf16_t* kvb; int b;
    __device__ __forceinline__ void kfrag(int pos, int kq, bf16x8 (&B)[4]) const {
        const bf16_t* p = kvb + (size_t)prow(b, pos) * 256 + 32 * kq;
#pragma unroll
        for (int s = 0; s < 4; ++s) B[s] = *(const bf16x8*)(p + 8 * s);
    }
    typedef unsigned vraw;
    __device__ __forceinline__ vraw vload(int pos, int lane) const { return *(const unsigned*)(kvb + (size_t)prow(b, pos) * 256 + 128 + 2 * lane); }
    __device__ __forceinline__ f32x2 vcvt(vraw u) const { return (f32x2){bf_lo(u), bf_hi(u)}; }
};
struct SrcSample {
    const float* ck; const float* cv; const LAS int* pt; const float* proj; int db;
    __device__ __forceinline__ const float* krow(int pos) const { return pos < PAST ? ck + ((size_t)pt[pos >> 7] * PAGE + (pos & 127)) * 128 : proj + (size_t)(ROW_SAMP + db * DSEQ + (pos - PAST)) * PLD + EK; }
    __device__ __forceinline__ const float* vrow(int pos) const { return pos < PAST ? cv + ((size_t)pt[pos >> 7] * PAGE + (pos & 127)) * 128 : proj + (size_t)(ROW_SAMP + db * DSEQ + (pos - PAST)) * PLD + EV; }
    __device__ __forceinline__ void kfrag(int pos, int kq, bf16x8 (&B)[4]) const {
        const float* p = krow(pos) + 32 * kq;
        f32x4 a[8];
#pragma unroll
        for (int s = 0; s < 8; ++s) a[s] = *(const f32x4*)(p + 4 * s);
#pragma unroll
        for (int s = 0; s < 4; ++s) {
            u32x4 w; w.x = cvt_pk_bf16(a[2 * s][0], a[2 * s][1]); w.y = cvt_pk_bf16(a[2 * s][2], a[2 * s][3]); w.z = cvt_pk_bf16(a[2 * s + 1][0], a[2 * s + 1][1]); w.w = cvt_pk_bf16(a[2 * s + 1][2], a[2 * s + 1][3]);
            B[s] = __builtin_bit_cast(bf16x8, w);
        }
    }
    typedef f32x2 vraw;
    __device__ __forceinline__ vraw vload(int pos, int lane) const { return *(const f32x2*)(vrow(pos) + 2 * lane); }
    __device__ __forceinline__ f32x2 vcvt(vraw u) const { return u; }
};

template <class Src, int QKB>
__device__ __forceinline__ void attn_half(const Src& S, const bf16_t* qb16, int qrow, const LAS u16* list, LAS float* pb, LAS float* stat, int lane, f32x2 (&o)[4]) {
    const int m = lane & 15, kq = lane >> 4;
    bf16x8 A[4];
    {
        const bool valid = (m < 8) && ((kq >> 1) == (m >> 2));
        const bf16_t* qp = qb16 + (size_t)qrow * 512 + (m & 7) * 64 + 32 * (kq & 1);
#pragma unroll
        for (int s = 0; s < 4; ++s) {
            u32x4 w = (u32x4){0u, 0u, 0u, 0u};
            if (valid) w = *(const u32x4*)(qp + 8 * s);
            A[s] = __builtin_bit_cast(bf16x8, w);
        }
    }
    f32x4 lg[8];
#pragma unroll
    for (int tb = 0; tb < 8; tb += QKB) {
        bf16x8 B[QKB][4];
#pragma unroll
        for (int t = 0; t < QKB; ++t) S.kfrag((int)list[16 * (tb + t) + m], kq, B[t]);
#pragma unroll
        for (int t = 0; t < QKB; ++t) {
            f32x4 acc = (f32x4){0.f, 0.f, 0.f, 0.f};
#pragma unroll
            for (int s = 0; s < 4; ++s) acc = __builtin_amdgcn_mfma_f32_16x16x32_bf16(A[s], B[t][s], acc, 0, 0, 0);
            lg[tb + t] = acc;
        }
    }
    f32x4 mx = lg[0];
#pragma unroll
    for (int t = 1; t < 8; ++t) { mx[0] = fmaxf(mx[0], lg[t][0]); mx[1] = fmaxf(mx[1], lg[t][1]); mx[2] = fmaxf(mx[2], lg[t][2]); mx[3] = fmaxf(mx[3], lg[t][3]); }
#pragma unroll
    for (int of = 1; of < 16; of <<= 1) {
#pragma unroll
        for (int r = 0; r < 4; ++r) mx[r] = fmaxf(mx[r], __shfl_xor(mx[r], of));
    }
    f32x4 sm = (f32x4){0.f, 0.f, 0.f, 0.f};
#pragma unroll
    for (int t = 0; t < 8; ++t) {
#pragma unroll
        for (int r = 0; r < 4; ++r) { const float e = __expf(lg[t][r] - mx[r]); lg[t][r] = e; sm[r] += e; }
    }
#pragma unroll
    for (int of = 1; of < 16; of <<= 1) {
#pragma unroll
        for (int r = 0; r < 4; ++r) sm[r] += __shfl_xor(sm[r], of);
    }
    f32x4 inv; inv[0] = 1.f / sm[0]; inv[1] = 1.f / sm[1]; inv[2] = 1.f / sm[2]; inv[3] = 1.f / sm[3];
    if (kq < 2) {
#pragma unroll
        for (int t = 0; t < 8; ++t) *(LAS f32x4*)(pb + (16 * t + m) * 8 + 4 * kq) = lg[t] * inv;
        if (m == 0) { *(LAS f32x4*)(stat + 4 * kq) = mx; *(LAS f32x4*)(stat + 8 + 4 * kq) = sm; }
    }
    asm volatile("s_waitcnt lgkmcnt(0)" ::: "memory");
    const int kvh = lane >> 5;
    o[0] = (f32x2){0.f, 0.f}; o[1] = o[0]; o[2] = o[0]; o[3] = o[0];
    const LAS u32x4* l4 = (const LAS u32x4*)list;
    for (int kb = 0; kb < 128; kb += 8) {
        const u32x4 pa = l4[(kb >> 3)];
        typename Src::vraw vr[8];
#pragma unroll
        for (int j = 0; j < 8; ++j) {
            const unsigned wv = pa[j >> 1];
            const int pos = (j & 1) ? (int)(wv >> 16) : (int)(wv & 0xffffu);
            vr[j] = S.vload(pos, lane);
        }
#pragma unroll
        for (int j = 0; j < 8; ++j) {
            const f32x4 p = *(const LAS f32x4*)(pb + (kb + j) * 8 + 4 * kvh);
            const f32x2 v = S.vcvt(vr[j]);
            o[0] += v * p[0]; o[1] += v * p[1]; o[2] += v * p[2]; o[3] += v * p[3];
        }
    }
}

constexpr int LDS_STG = 139264 + 8704;
static_assert(LDS_STG + 64 * 144 <= LDS_MISC, "dsa lds");
constexpr int SK_PITCH = 2176, SKS_PITCH = 8704, LDS_LIST = 139264, LDS_NSEL = LDS_LIST + 32 * 512, LDS_PBS = 4 * SKS_PITCH * 2;
static_assert(LDS_NSEL + 128 <= LDS_MISC && LDS_PBS + 4 * 8192 <= LDS_LIST, "dsa lds");

__device__ __forceinline__ void idx_afrag(const _Float16* qih, const int (&qrows)[4], int lane, f16x8 (&A)[4]) {
    const int m = lane & 31, hh = lane >> 5, q4 = 2 * (m >> 4) + ((m >> 2) & 1), head = 4 * ((m >> 3) & 1) + (m & 3);
    const int qr = q4 == 0 ? qrows[0] : q4 == 1 ? qrows[1] : q4 == 2 ? qrows[2] : qrows[3];
    const _Float16* p = qih + (size_t)qr * 512 + head * 64 + 32 * hh;
#pragma unroll
    for (int s = 0; s < 4; ++s) A[s] = *(const f16x8*)(p + 8 * s);
}
__device__ __forceinline__ void idx_score(const f32x16& acc, const float (&wa)[8], const float (&wb)[8], float& sa, float& sb) {
    sa = 0.f; sb = 0.f;
#pragma unroll
    for (int r = 0; r < 8; ++r) { sa += __builtin_amdgcn_fmed3f(acc[r], 0.f, __builtin_inff()) * wa[r]; sb += __builtin_amdgcn_fmed3f(acc[8 + r], 0.f, __builtin_inff()) * wb[r]; }
}

__device__ __forceinline__ void dsa_prompt_unit(Frame& F, int b, int p0, int nq) {
    const float* proj = (const float*)(F.ws + WS_PROJ);
    const _Float16* kih = (const _Float16*)(F.ws + WS_KIH);
    bf16_t* act = (bf16_t*)(F.ws + WS_ACT);
    LAS u16* sk = (LAS u16*)F.lds; LAS unsigned* masks = (LAS unsigned*)(F.lds + LDS_LIST);
    const int lane = F.lane, w = F.wave, Lk = p0 + nq, ntiles = (Lk + 31) >> 5;
    const bool active = 4 * w < nq;
    {
        LAS unsigned char* stg = F.lds + LDS_STG;
        const int hh = lane >> 5, n = lane & 31;
        const int skey = F.tid >> 3, schunk = F.tid & 7;
        const int nblocks = (Lk + 63) >> 6;
        f16x8 A[4]; float wa[8], wb[8];
        const int qpa = p0 + 4 * w + hh, qpb = qpa + 2;
        if (active) {
            int qrows[4];
#pragma unroll
            for (int i = 0; i < 4; ++i) qrows[i] = prow(b, p0 + 4 * w + i);
            idx_afrag((const _Float16*)(F.ws + WS_KEB), qrows, lane, A);
            const float* pa = proj + (size_t)prow(b, qpa) * PLD + EWI; const float* pbq = proj + (size_t)prow(b, qpb) * PLD + EWI;
#pragma unroll
            for (int r = 0; r < 8; ++r) { wa[r] = pa[r]; wb[r] = pbq[r]; }
        } else {
#pragma unroll
            for (int s = 0; s < 4; ++s) A[s] = (f16x8){0, 0, 0, 0, 0, 0, 0, 0};
#pragma unroll
            for (int r = 0; r < 8; ++r) { wa[r] = 0.f; wb[r] = 0.f; }
        }
        LAS u16* ra = sk + (4 * w + hh) * SK_PITCH; LAS u16* rb = sk + (4 * w + 2 + hh) * SK_PITCH;
#define SC_LOADBLK(g, i) do { const int pp_ = 64 * (i) + skey, pos_ = pp_ < LP ? pp_ : LP - 1; g = *(const u32x4*)(kih + (size_t)prow(b, pos_) * 64 + 8 * schunk); } while (0)
#define SC_STEP(g, i) do { if ((i) < nblocks) { \
            __syncthreads(); *(LAS u32x4*)(stg + skey * 144 + 16 * schunk) = g; __syncthreads(); \
            SC_LOADBLK(g, (i) + 3); \
            if (active) { _Pragma("unroll") for (int tl = 0; tl < 2; ++tl) { \
                const int pos = 64 * (i) + 32 * tl + n; f32x16 acc; \
                _Pragma("unroll") for (int r = 0; r < 16; ++r) acc[r] = 0.f; \
                _Pragma("unroll") for (int s2 = 0; s2 < 4; ++s2) acc = __builtin_amdgcn_mfma_f32_32x32x16_f16(A[s2], *(const LAS f16x8*)(stg + (32 * tl + n) * 144 + 64 * hh + 16 * s2), acc, 0, 0, 0); \
                float sa, sb; idx_score(acc, wa, wb, sa, sb); \
                if (pos < 32 * ntiles) { ra[pos] = (u16)(pos <= qpa ? f2key(sa) : 0u); rb[pos] = (u16)(pos <= qpb ? f2key(sb) : 0u); } } } } } while (0)
        u32x4 gk0, gk1, gk2;
        SC_LOADBLK(gk0, 0); SC_LOADBLK(gk1, 1); SC_LOADBLK(gk2, 2);
        for (int blkk = 0; blkk < nblocks; blkk += 3) { SC_STEP(gk0, blkk); SC_STEP(gk1, blkk + 1); SC_STEP(gk2, blkk + 2); }
#undef SC_STEP
#undef SC_LOADBLK
    }
    if (active) {
        for (int i = 0; i < 4; ++i) { LAS u16* r = sk + (4 * w + i) * SK_PITCH; for (int j = 32 * ntiles + lane; j < ((Lk + 127) & ~127); j += 64) r[j] = 0; }
        asm volatile("s_waitcnt lgkmcnt(0)" ::: "memory");
        for (int i = 0; i < 4; ++i) {
            const int q = 4 * w + i;
            { const int nv = p0 + q + 1, nst = (nv + 127) >> 7;
              if (nst <= 5) select_mask<5>(sk + q * SK_PITCH, nv, masks + q * MASK_WORDS, lane);
              else if (nst <= 9) select_mask<9>(sk + q * SK_PITCH, nv, masks + q * MASK_WORDS, lane);
              else if (nst <= 13) select_mask<13>(sk + q * SK_PITCH, nv, masks + q * MASK_WORDS, lane);
              else select_mask<17>(sk + q * SK_PITCH, nv, masks + q * MASK_WORDS, lane); }
        }
    }
    __syncthreads();
    {
        const bf16_t* kvb = (const bf16_t*)(F.ws + WS_KVB);
        const int kvh = w >> 2, rb = w & 3, n = lane & 31, hi = lane >> 5;
        const bool act_w = 8 * rb < nq;
        const int qpos = p0 + 8 * rb + (n >> 2), head = 4 * kvh + (n & 3);
        const int qrow = prow(b, act_w ? qpos : p0);
        bf16x8 qf[4];
        { const bf16_t* qp = (const bf16_t*)(F.ws + WS_QE) + (size_t)qrow * 512 + head * 64 + 32 * hi;
#pragma unroll
          for (int s = 0; s < 4; ++s) qf[s] = *(const bf16x8*)(qp + 8 * s); }
        const int skey = F.tid >> 4, sc = F.tid & 15;
        const unsigned kdst = (unsigned)((sc >> 3) * 4608 + skey * 144 + 16 * (sc & 7));
        const unsigned vdst = (unsigned)(9216 + (sc >> 3) * 4096 + ((sc & 7) >> 2) * 2048 + skey * 64 + 16 * (sc & 3));
        constexpr int KVBUF = 17408;
#define FL_COMPUTE \
            if (act_w) { \
                f32x16 sc16; \
_Pragma("unroll") \
                for (int r = 0; r < 16; ++r) sc16[r] = 0.f; \
_Pragma("unroll") \
                for (int s = 0; s < 4; ++s) sc16 = __builtin_amdgcn_mfma_f32_32x32x16_bf16(*(const LAS bf16x8*)(kbase + boff + 16 * s), qf[s], sc16, 0, 0, 0); \
                const unsigned mw = mrow[t] >> (4 * hi); \
                float tmax = -1e30f; \
_Pragma("unroll") \
                for (int r = 0; r < 16; ++r) { const bool on = (mw >> ((r & 3) + 8 * (r >> 2))) & 1u; sc16[r] = on ? sc16[r] : -1e30f; tmax = fmaxf(tmax, sc16[r]); } \
                { auto rr = __builtin_amdgcn_permlane32_swap(__float_as_uint(tmax), __float_as_uint(tmax), false, false); tmax = fmaxf(__uint_as_float(rr[0]), __uint_as_float(rr[1])); } \
                const float m_new = fmaxf(m_run, tmax), alpha = __expf(m_run - m_new); \
                m_run = m_new; \
                float psum = 0.f; \
_Pragma("unroll") \
                for (int r = 0; r < 16; ++r) { const bool on = (mw >> ((r & 3) + 8 * (r >> 2))) & 1u; const float p = on ? __expf(sc16[r] - m_new) : 0.f; sc16[r] = p; psum += p; } \
                l_run = l_run * alpha + psum; \
_Pragma("unroll") \
                for (int r = 0; r < 16; ++r) { o0[r] *= alpha; o1[r] *= alpha; } \
                bf16x8 pw[2]; \
_Pragma("unroll") \
                for (int ks = 0; ks < 2; ++ks) { u32x4 wv; wv.x = cvt_pk_bf16(sc16[8 * ks], sc16[8 * ks + 1]); wv.y = cvt_pk_bf16(sc16[8 * ks + 2], sc16[8 * ks + 3]); wv.z = cvt_pk_bf16(sc16[8 * ks + 4], sc16[8 * ks + 5]); wv.w = cvt_pk_bf16(sc16[8 * ks + 6], sc16[8 * ks + 7]); pw[ks] = __builtin_bit_cast(bf16x8, wv); } \
_Pragma("unroll") \
                for (int ks = 0; ks < 2; ++ks) { \
_Pragma("unroll") \
                    for (int dh = 0; dh < 2; ++dh) { \
                        typedef short v4i16_t __attribute__((ext_vector_type(4))); \
                        const LAS unsigned char* vp = vbase + boff + dh * 2048 + ks * 1024; \
                        const v4i16_t lo = __builtin_amdgcn_ds_read_tr16_b64_v4i16((LAS v4i16_t*)vp), hi4 = __builtin_amdgcn_ds_read_tr16_b64_v4i16((LAS v4i16_t*)(vp + 512)); \
                        const bf16x8 vf = (bf16x8){lo[0], lo[1], lo[2], lo[3], hi4[0], hi4[1], hi4[2], hi4[3]}; \
                        if (dh == 0) o0 = __builtin_amdgcn_mfma_f32_32x32x16_bf16(vf, pw[ks], o0, 0, 0, 0); else o1 = __builtin_amdgcn_mfma_f32_32x32x16_bf16(vf, pw[ks], o1, 0, 0, 0); \
                    } \
                } \
            }
#define FL_LOAD(gk_, gv_, i) do { const int pp_ = 32 * (i) + skey, pos_ = pp_ < LP ? pp_ : LP - 1; const bf16_t* src_ = kvb + (size_t)prow(b, pos_) * 256 + 8 * sc; gk_ = *(const u32x4*)src_; gv_ = *(const u32x4*)(src_ + 128); } while (0)
        u32x4 gkA, gvA, gkB, gvB, gkC, gvC;
        FL_LOAD(gkA, gvA, 0); FL_LOAD(gkB, gvB, 1); FL_LOAD(gkC, gvC, 2);
        *(LAS u32x4*)(F.lds + kdst) = gkA; *(LAS u32x4*)(F.lds + vdst) = gvA;
        FL_LOAD(gkA, gvA, 3);
        __syncthreads();
        const LAS unsigned char* kbase = F.lds + kvh * 4608 + n * 144 + 64 * hi;
        const LAS unsigned char* vbase = F.lds + 9216 + kvh * 4096 + (4 * hi + ((lane & 15) >> 2)) * 64 + ((lane >> 4) & 1) * 32 + (lane & 3) * 8;
        const LAS unsigned* mrow = masks + (8 * rb + (n >> 2)) * MASK_WORDS;
        float m_run = -1e30f, l_run = 0.f;
        f32x16 o0, o1;
#pragma unroll
        for (int r = 0; r < 16; ++r) { o0[r] = 0.f; o1[r] = 0.f; }
#define FL_STEP(tt_, gk_, gv_) do { if ((tt_) < ntiles) { const int t = (tt_); const int boff = (t & 1) * KVBUF; \
            FL_COMPUTE \
            if (t + 1 < ntiles) { const int nb = ((t + 1) & 1) * KVBUF; *(LAS u32x4*)(F.lds + nb + kdst) = gk_; *(LAS u32x4*)(F.lds + nb + vdst) = gv_; FL_LOAD(gk_, gv_, t + 4); } \
            __syncthreads(); } } while (0)
        for (int t3 = 0; t3 < ntiles; t3 += 3) { FL_STEP(t3, gkB, gvB); FL_STEP(t3 + 1, gkC, gvC); FL_STEP(t3 + 2, gkA, gvA); }
#undef FL_STEP
#undef FL_COMPUTE
#undef FL_LOAD
        if (act_w) {
            { auto rr = __builtin_amdgcn_permlane32_swap(__float_as_uint(l_run), __float_as_uint(l_run), false, false); l_run = __uint_as_float(rr[0]) + __uint_as_float(rr[1]); }
            const float inv = 1.f / l_run;
            bf16_t* ap = act + (size_t)qrow * DM + head * 64 + 4 * hi;
#pragma unroll
            for (int g4 = 0; g4 < 4; ++g4) {
                u32x2 w0; w0.x = cvt_pk_bf16(o0[4 * g4] * inv, o0[4 * g4 + 1] * inv); w0.y = cvt_pk_bf16(o0[4 * g4 + 2] * inv, o0[4 * g4 + 3] * inv);
                u32x2 w1; w1.x = cvt_pk_bf16(o1[4 * g4] * inv, o1[4 * g4 + 1] * inv); w1.y = cvt_pk_bf16(o1[4 * g4 + 2] * inv, o1[4 * g4 + 3] * inv);
                *(u32x2*)(ap + 8 * g4) = w0; *(u32x2*)(ap + 32 + 8 * g4) = w1;
            }
        }
    }
    __syncthreads();
}

constexpr int LDS_PTS = LDS_NSEL + 128;
constexpr int LDS_STAT = LDS_PBS + 8 * 4096, LDS_OPART = LDS_STAT + 512, LDS_XCH = LDS_OPART + 8192;
static_assert(LDS_XCH + 128 <= LDS_LIST, "dsa lds");
static_assert(LDS_PTS + 256 <= LDS_MISC, "dsa lds");
__device__ __forceinline__ const float* samp_kiptr(const float* cki, const LAS int* pts, const float* proj, int db, int pos, int hh) {
    const int posc = pos < PAST + DSEQ ? pos : PAST + DSEQ - 1;
    return posc < PAST ? cki + ((size_t)pts[posc >> 7] * PAGE + (posc & 127)) * 64 + 32 * hh
                       : proj + (size_t)(ROW_SAMP + db * DSEQ + (posc - PAST)) * PLD + EKI + 32 * hh;
}
__device__ __forceinline__ void dsa_sample_unit(Frame& F, int e, int db) {
    const float* proj = (const float*)(F.ws + WS_PROJ);
    bf16_t* act = (bf16_t*)(F.ws + WS_ACT);
    const float* cki = F.in[IN_CKI] + (size_t)e * NPOOLPG * PAGE * 64;
    LAS u16* sk = (LAS u16*)F.lds; LAS u16* lists = (LAS u16*)(F.lds + LDS_LIST); LAS int* pts = (LAS int*)(F.lds + LDS_PTS);
    const int lane = F.lane, w = F.wave, hh = lane >> 5, n = lane & 31;
    if (F.tid < NPAGES) pts[F.tid] = ((const int*)F.in[IN_PT])[db * NPAGES + F.tid];
    int qrows[4];
#pragma unroll
    for (int i = 0; i < 4; ++i) qrows[i] = ROW_SAMP + db * DSEQ + i;
    f16x8 A[4]; idx_afrag((const _Float16*)(F.ws + WS_KEB), qrows, lane, A);
    float wa[8], wb[8];
    const int qpa = PAST + hh, qpb = qpa + 2;
    { const float* pa = proj + (size_t)(ROW_SAMP + db * DSEQ + hh) * PLD + EWI; const float* pbq = proj + (size_t)(ROW_SAMP + db * DSEQ + 2 + hh) * PLD + EWI;
#pragma unroll
      for (int r = 0; r < 8; ++r) { wa[r] = pa[r]; wb[r] = pbq[r]; } }
    LAS u16* ra = sk + hh * SKS_PITCH; LAS u16* rb = sk + (2 + hh) * SKS_PITCH;
    constexpr int NT = (PAST + DSEQ + 31) / 32;
    for (int q = 0; q < 4; ++q) for (int c = 32 * NT + F.tid; c < SKS_PITCH; c += 512) sk[q * SKS_PITCH + c] = 0;
    __syncthreads();
#define SS_LOAD(buf_, t_) do { const float* kp_ = samp_kiptr(cki, pts, proj, db, 32 * (t_) + n, hh); _Pragma("unroll") for (int s2 = 0; s2 < 8; ++s2) buf_[s2] = *(const f32x4*)(kp_ + 4 * s2); } while (0)
#define SS_STEP(buf_, t_) do { if ((t_) < NT) { const int pos = 32 * (t_) + n; f32x16 acc; \
        _Pragma("unroll") for (int r = 0; r < 16; ++r) acc[r] = 0.f; \
        _Pragma("unroll") for (int s2 = 0; s2 < 4; ++s2) { const f32x4 a = buf_[2 * s2], c = buf_[2 * s2 + 1]; \
            f16x8 h; h[0] = (_Float16)a[0]; h[1] = (_Float16)a[1]; h[2] = (_Float16)a[2]; h[3] = (_Float16)a[3]; h[4] = (_Float16)c[0]; h[5] = (_Float16)c[1]; h[6] = (_Float16)c[2]; h[7] = (_Float16)c[3]; \
            acc = __builtin_amdgcn_mfma_f32_32x32x16_f16(A[s2], h, acc, 0, 0, 0); } \
        SS_LOAD(buf_, (t_) + 16); \
        float sa, sb; idx_score(acc, wa, wb, sa, sb); \
        ra[pos] = (u16)(pos <= qpa ? f2key(sa) : 0u); rb[pos] = (u16)(pos <= qpb ? f2key(sb) : 0u); } } while (0)
    f32x4 r0s[8], r1s[8];
    SS_LOAD(r0s, w); SS_LOAD(r1s, w + 8);
    for (int t = w; t < NT; t += 16) { SS_STEP(r0s, t); SS_STEP(r1s, t + 8); }
#undef SS_STEP
#undef SS_LOAD
    __syncthreads();
    {
        const int q = w >> 1, half = w & 1;
        volatile LAS int* xch = (volatile LAS int*)(F.lds + LDS_XCH);
        select_topk_pair<33>(sk + q * SKS_PITCH, PAST + q + 1, lists + q * 256, xch, lane, w);
        __syncthreads();
        SrcSample S; S.ck = F.in[IN_CK] + (size_t)e * NPOOLPG * PAGE * 128; S.cv = F.in[IN_CV] + (size_t)e * NPOOLPG * PAGE * 128; S.pt = pts; S.proj = proj; S.db = db;
        LAS float* stat = (LAS float*)(F.lds + LDS_STAT) + w * 16; LAS float* opart = (LAS float*)(F.lds + LDS_OPART) + q * 512;
        f32x2 o[4];
        const int qrow = ROW_SAMP + db * DSEQ + q;
        attn_half<SrcSample, 1>(S, (const bf16_t*)(F.ws + WS_QE), qrow, lists + q * 256 + 128 * half, (LAS float*)(F.lds + LDS_PBS + w * 4096), stat, lane, o);
        if (half) { *(LAS f32x4*)(opart + lane * 8) = (f32x4){o[0][0], o[0][1], o[1][0], o[1][1]}; *(LAS f32x4*)(opart + lane * 8 + 4) = (f32x4){o[2][0], o[2][1], o[3][0], o[3][1]}; }
        __syncthreads();
        if (!half) {
            const int kvh = lane >> 5;
            const LAS float* st0 = (const LAS float*)(F.lds + LDS_STAT) + w * 16; const LAS float* st1 = st0 + 16;
            const f32x4 m0 = *(const LAS f32x4*)(st0 + 4 * kvh), l0 = *(const LAS f32x4*)(st0 + 8 + 4 * kvh), m1 = *(const LAS f32x4*)(st1 + 4 * kvh), l1 = *(const LAS f32x4*)(st1 + 8 + 4 * kvh);
            const f32x4 pa = *(const LAS f32x4*)(opart + lane * 8), pc = *(const LAS f32x4*)(opart + lane * 8 + 4);
            const f32x2 op[4] = {(f32x2){pa[0], pa[1]}, (f32x2){pa[2], pa[3]}, (f32x2){pc[0], pc[1]}, (f32x2){pc[2], pc[3]}};
            bf16_t* ap = act + (size_t)qrow * DM + (4 * kvh) * 64 + 2 * (lane & 31);
#pragma unroll
            for (int j = 0; j < 4; ++j) {
                const float M = fmaxf(m0[j], m1[j]), w0 = l0[j] * __expf(m0[j] - M), w1 = l1[j] * __expf(m1[j] - M), inv = 1.f / (w0 + w1);
                const f32x2 r = (o[j] * w0 + op[j] * w1) * inv;
                *(unsigned*)(ap + 64 * j) = cvt_pk_bf16(r[0], r[1]);
            }
        }
    }
    __syncthreads();
}

template <int W>
__device__ __forceinline__ void pool_diff_group(Frame& F, const float* proj, const float* spool, bf16_t* act, int g) {
    const int gt = F.blk * 512 + F.tid, NT = F.G * 512;
    for (int idx = gt; idx < (MREAL - ROW_META) * 32; idx += NT) {
        const int row = ROW_META + (idx >> 5), c = 128 * g + 4 * (idx & 31);
        f32x4 v[W]; float cnt;
        if (row < ROW_SAMP) {
            int b = 0, p;
            if (row < ROW_META) { b = row >> 11; p = NMETA + (row & 2047); } else p = row - ROW_META;
            const int nw = W < p + 1 ? W : p + 1;
#pragma unroll
            for (int j = 0; j < W; ++j) { const int pj = p - j > 0 ? p - j : 0; v[j] = *(const f32x4*)(proj + (size_t)prow(b, pj) * PLD + EU + c); }
#pragma unroll
            for (int j = 1; j < W; ++j) if (j >= nw) v[j] = (f32x4){0.f, 0.f, 0.f, 0.f};
            cnt = (float)nw;
        } else {
            const int db = (row - ROW_SAMP) >> 2, t = (row - ROW_SAMP) & 3;
#pragma unroll
            for (int j = 0; j < W; ++j) {
                const int i = 15 + t - j;
                const float* src = i < 15 ? spool + ((size_t)db * 15 + i) * 512 + c : proj + (size_t)(ROW_SAMP + db * DSEQ + (i - 15)) * PLD + EU + c;
                v[j] = *(const f32x4*)src;
            }
            cnt = (float)W;
        }
        f32x4 sum = v[0];
#pragma unroll
        for (int j = 1; j < W; ++j) sum += v[j];
        const f32x4 d = sum / cnt - v[0];
        u32x2 wv; wv.x = cvt_pk_bf16(d[0], d[1]); wv.y = cvt_pk_bf16(d[2], d[3]);
        *(u32x2*)(act + (size_t)row * DM + 512 + c) = wv;
    }
}

template <int W>
__device__ __forceinline__ void pool_diff_item(const float* proj, bf16_t* act, int b, int blk16, int c) {
    const int p0 = NMETA + 16 * blk16;
    f32x4 v[16 + W - 1];
#pragma unroll
    for (int i = 0; i < 16 + W - 1; ++i) v[i] = *(const f32x4*)(proj + (size_t)prow(b, p0 - (W - 1) + i) * PLD + EU + c);
    const float inv = 1.f / (float)W;
#pragma unroll
    for (int r = 0; r < 16; ++r) {
        f32x4 sum = v[r + W - 1];
#pragma unroll
        for (int j = 1; j < W; ++j) sum += v[r + W - 1 - j];
        const f32x4 d = sum * inv - v[r + W - 1];
        u32x2 wv; wv.x = cvt_pk_bf16(d[0], d[1]); wv.y = cvt_pk_bf16(d[2], d[3]);
        *(u32x2*)(act + (size_t)(b * SEQ + 16 * blk16 + r) * DM + 512 + c) = wv;
    }
}
__device__ __forceinline__ void pool_diff_blocks(Frame& F, const float* proj, bf16_t* act) {
    const int gt = F.blk * 512 + F.tid, NT = F.G * 512;
    for (int idx = gt; idx < NBATCH * 128 * 128; idx += NT) {
        const int cq = idx & 31, g = (idx >> 6) & 3, blk16 = ((idx >> 8) & 63) * 2 + ((idx >> 5) & 1), b = idx >> 14, c = 128 * g + 4 * cq;
        if (g == 0) pool_diff_item<2>(proj, act, b, blk16, c); else if (g == 1) pool_diff_item<4>(proj, act, b, blk16, c);
        else if (g == 2) pool_diff_item<8>(proj, act, b, blk16, c); else pool_diff_item<16>(proj, act, b, blk16, c);
    }
}

__device__ __forceinline__ void even_mixer_phase(Frame& F, int e, int l) {
    const float* proj = (const float*)(F.ws + WS_PROJ);
    bf16_t* act = (bf16_t*)(F.ws + WS_ACT);
    const float* spool = F.in[IN_SPOOL] + (size_t)e * DBATCH * 15 * 512;
    const int gt = F.blk * 512 + F.tid, NT = F.G * 512;
    pool_diff_group<2>(F, proj, spool, act, 0); pool_diff_group<4>(F, proj, spool, act, 1); pool_diff_group<8>(F, proj, spool, act, 2); pool_diff_group<16>(F, proj, spool, act, 3);
    pool_diff_blocks(F, proj, act);
    float* out = F.out;
    for (int idx = gt; idx < NBATCH * 15 * 128; idx += NT) {
        const int bj = idx >> 7, cq = idx & 127, b = bj / 15, j = bj % 15;
        *(f32x4*)(out + O_PP + ((size_t)(e * NBATCH + b) * 15 + j) * 512 + 4 * cq) = *(const f32x4*)(proj + (size_t)prow(b, LP - 15 + j) * PLD + EU + 4 * cq);
    }
    for (int idx = gt; idx < DBATCH * 15 * 128; idx += NT) {
        const int bj = idx >> 7, cq = idx & 127, db = bj / 15, j = bj % 15, i = DSEQ + j;
        const f32x4 v = i < 15 ? *(const f32x4*)(spool + ((size_t)db * 15 + i) * 512 + 4 * cq) : *(const f32x4*)(proj + (size_t)(ROW_SAMP + db * DSEQ + (i - 15)) * PLD + EU + 4 * cq);
        *(f32x4*)(out + O_PS + ((size_t)(e * DBATCH + db) * 15 + j) * 512 + 4 * cq) = v;
    }
    volatile LAS int* bc = (volatile LAS int*)(F.lds + LDS_MISC + 16);
    unsigned* qh = F.ctl + CW_QUEUE + 64 * l;
    for (;;) {
        __syncthreads();
        if (F.tid == 0) *bc = (int)__hip_atomic_fetch_add(qh, 1u, __ATOMIC_RELAXED, __HIP_MEMORY_SCOPE_AGENT);
        __syncthreads();
        const int u = *bc;
        if (u >= 32 + 512 + 1) break;
#ifdef NO_SAMPLE
        if (u < 32) {}
#else
        if (u < 32) dsa_sample_unit(F, e, u);
#endif
#ifdef NO_PROMPT
        else {}
        if (0) {}
#endif
        else if (u < 544) { const int v = u - 32, qb = 63 - (v >> 3), b = v & 7; dsa_prompt_unit(F, b, NMETA + 32 * qb, 32); }
        else dsa_prompt_unit(F, 0, 0, 16);
    }
}

__device__ __forceinline__ void chunk_info(int ci, int& r0, int& T) {
    if (ci == 0) { r0 = ROW_META; T = NMETA; } else if (ci <= 256) { r0 = (ci - 1) * 64; T = 64; } else { r0 = ROW_SAMP + (ci - 257) * DSEQ; T = DSEQ; }
}
constexpr int QES_PITCH = 520;
__device__ __forceinline__ void gla_prep_unit(Frame& F, int o, int ci, const float* ssl, const float* sstl) {
    const float* proj = (const float*)(F.ws + WS_PROJ);
    bf16_t* QE = (bf16_t*)(F.ws + WS_QE); bf16_t* KET = (bf16_t*)(F.ws + WS_KET); bf16_t* VT = (bf16_t*)(F.ws + WS_VT); bf16_t* ATT = (bf16_t*)(F.ws + WS_ATT);
    float* EBL = (float*)(F.ws + WS_EBL); bf16_t* KEB = (bf16_t*)(F.ws + WS_KEB);
    LAS bf16_t* qes = (LAS bf16_t*)F.lds; LAS bf16_t* kes = (LAS bf16_t*)(F.lds + 64 * QES_PITCH * 2); LAS float* gds = (LAS float*)(F.lds + 2 * 64 * QES_PITCH * 2);
    int r0, T; chunk_info(ci, r0, T);
    const int tid = F.tid, col = tid, h = col >> 7, d = col & 127;
    __syncthreads();
    {
        const bf16_t* XBp = (const bf16_t*)(F.ws + WS_XB); const bf16_t* WGD = (const bf16_t*)(F.ws + WS_WINO) + ((size_t)o * NO + OGD) * DM;
        LAS float* part = (LAS float*)F.lds; LAS float* rsg = (LAS float*)(F.lds + 32768);
        const int lane = F.lane, w = F.wave, m = lane & 15, kq = lane >> 4;
        bf16x8 Af[4][4], Bf[4];
#pragma unroll
        for (int ks = 0; ks < 4; ++ks) Bf[ks] = *(const bf16x8*)(WGD + (size_t)m * DM + 128 * w + 32 * ks + 8 * kq);
#pragma unroll
        for (int tt = 0; tt < 4; ++tt)
#pragma unroll
            for (int ks = 0; ks < 4; ++ks) Af[tt][ks] = *(const bf16x8*)(XBp + (size_t)(r0 + (16 * tt < T ? 16 * tt : 0) + m) * DM + 128 * w + 32 * ks + 8 * kq);
        float rs_mine = 0.f;
        if (tid < 64) { const int row = r0 + (tid < T ? tid : T - 1); rs_mine = row < TR0 ? row_rstd(ssl, row) : tail_rstd_batched(sstl, row - TR0); }
        __builtin_amdgcn_sched_barrier(0);
#pragma unroll
        for (int tt = 0; tt < 4; ++tt) {
            f32x4 acc = (f32x4){0.f, 0.f, 0.f, 0.f};
#pragma unroll
            for (int ks = 0; ks < 4; ++ks) acc = __builtin_amdgcn_mfma_f32_16x16x32_bf16(Af[tt][ks], Bf[ks], acc, 0, 0, 0);
            *(LAS f32x4*)(part + ((w * 4 + tt) * 64 + lane) * 4) = acc;
        }
        if (tid < 64) rsg[tid] = rs_mine;
        __syncthreads();
        if (tid < 256) {
            const int tt = tid >> 6, ln = tid & 63, r = ln & 15, g = ln >> 4;
            f32x4 sum = *(const LAS f32x4*)(part + ((0 * 4 + tt) * 64 + ln) * 4);
#pragma unroll
            for (int ww = 1; ww < 8; ++ww) sum += *(const LAS f32x4*)(part + ((ww * 4 + tt) * 64 + ln) * 4);
#pragma unroll
            for (int j = 0; j < 4; ++j) {
                const int t = 16 * tt + 4 * g + j;
                gds[t * 16 + r] = t < T ? sum[j] * rsg[t] : 0.f;
            }
        }
    }
    float wg[16];
#pragma unroll
    for (int r = 0; r < 16; ++r) wg[r] = F.in[IN_WGATE][((size_t)o * 16 + r) * 512 + col];
    const float bgc = F.in[IN_BGATE][o * 512 + col];
    __syncthreads();
    float bcum = 0.f;
#define PREP_LOAD(qv, kv, va, vb, t0_) do { _Pragma("unroll") for (int u = 0; u < 8; ++u) { \
        const int tc = ((t0_) + u) < T ? ((t0_) + u) : (T - 1); const bf16_t* pr = (const bf16_t*)proj + (size_t)(r0 + tc) * PLB; \
        qv[u] = bf_lo((unsigned)pr[OQ + col]); kv[u] = bf_lo((unsigned)pr[OKK + col]); va[u] = bf_lo((unsigned)pr[OV + col]); vb[u] = bf_lo((unsigned)pr[OV + 512 + col]); } } while (0)
#define PREP_BLOCK(qv, kv, va, vb, t0_) do { const int tb0 = (t0_); unsigned kp[4], v0p[4], v1p[4], qkp[8]; \
        if (tb0 < T) { float ke8[8], v08[8], v18[8]; \
            _Pragma("unroll") for (int u = 0; u < 8; ++u) { const int t = tb0 + u; float qe = 0.f, ke = 0.f, v0 = 0.f, v1 = 0.f; \
                if (t < T) { \
                    const f32x4 g0 = *(const LAS f32x4*)(gds + t * 16), g1 = *(const LAS f32x4*)(gds + t * 16 + 4), g2 = *(const LAS f32x4*)(gds + t * 16 + 8), g3 = *(const LAS f32x4*)(gds + t * 16 + 12); \
                    float x = bgc; \
                    _Pragma("unroll") for (int r = 0; r < 4; ++r) { x += g0[r] * wg[r]; x += g1[r] * wg[4 + r]; x += g2[r] * wg[8 + r]; x += g3[r] * wg[12 + r]; } \
                    const float la = (fminf(x, 0.f) - __logf(1.f + __expf(-fabsf(x)))) * (1.f / 16.f); \
                    bcum += la; const float eb = __expf(bcum); \
                    qe = qv[u] * eb; ke = kv[u] * __builtin_amdgcn_rcpf(eb); v0 = va[u]; v1 = vb[u]; } \
                qkp[u] = cvt_pk_bf16(qe, ke); ke8[u] = ke; v08[u] = v0; v18[u] = v1; } \
            _Pragma("unroll") for (int u = 0; u < 4; ++u) { kp[u] = cvt_pk_bf16(ke8[2 * u], ke8[2 * u + 1]); v0p[u] = cvt_pk_bf16(v08[2 * u], v08[2 * u + 1]); v1p[u] = cvt_pk_bf16(v18[2 * u], v18[2 * u + 1]); } \
            _Pragma("unroll") for (int u = 0; u < 8; ++u) { if (tb0 + u < T) { QE[(size_t)(r0 + tb0 + u) * 512 + col] = (bf16_t)(qkp[u] & 0xffffu); KEB[(size_t)(r0 + tb0 + u) * 512 + col] = (bf16_t)(qkp[u] >> 16); } } \
        } else { _Pragma("unroll") for (int u = 0; u < 4; ++u) { kp[u] = 0u; v0p[u] = 0u; v1p[u] = 0u; } } \
        *(u32x4*)(KET + (((size_t)ci * 4 + h) * 128 + d) * 64 + tb0) = (u32x4){kp[0], kp[1], kp[2], kp[3]}; \
        *(u32x4*)(VT + (((size_t)ci * 4 + (col >> 8)) * 256 + (col & 255)) * 64 + tb0) = (u32x4){v0p[0], v0p[1], v0p[2], v0p[3]}; \
        *(u32x4*)(VT + (((size_t)ci * 4 + 2 + (col >> 8)) * 256 + (col & 255)) * 64 + tb0) = (u32x4){v1p[0], v1p[1], v1p[2], v1p[3]}; } while (0)
    {
        float qa[8], ka[8], vaa[8], vba[8], qb[8], kb[8], vab[8], vbb[8];
        PREP_LOAD(qa, ka, vaa, vba, 0);
        for (int t0 = 0; t0 < 64; t0 += 16) {
            if (t0 + 8 < T) PREP_LOAD(qb, kb, vab, vbb, t0 + 8);
            PREP_BLOCK(qa, ka, vaa, vba, t0);
            if (t0 + 16 < T) PREP_LOAD(qa, ka, vaa, vba, t0 + 16);
            PREP_BLOCK(qb, kb, vab, vbb, t0 + 8);
        }
    }
#undef PREP_BLOCK
#undef PREP_LOAD
    EBL[(size_t)ci * 512 + col] = __expf(bcum);
    __syncthreads();
    {
        const int w = F.wave, lane = F.lane, hd = w >> 1, th = w & 1, m = lane & 15, kq = lane >> 4;
        bf16x8 A[2][4], B[4][4];
        const bool live0 = 32 * th < T, live1 = 32 * th + 16 < T;
        if (live0) {
#pragma unroll
            for (int ks = 0; ks < 4; ++ks) A[0][ks] = *(const bf16x8*)(QE + (size_t)(r0 + 32 * th + m) * 512 + hd * 128 + 32 * ks + 8 * kq);
#pragma unroll
            for (int st = 0; st < 4; ++st)
#pragma unroll
                for (int ks = 0; ks < 4; ++ks) B[st][ks] = *(const bf16x8*)(KEB + (size_t)(r0 + 16 * st + m) * 512 + hd * 128 + 32 * ks + 8 * kq);
        }
        if (live1) {
#pragma unroll
            for (int ks = 0; ks < 4; ++ks) A[1][ks] = *(const bf16x8*)(QE + (size_t)(r0 + 32 * th + 16 + m) * 512 + hd * 128 + 32 * ks + 8 * kq);
        }
        f32x4 acc[2][4];
#pragma unroll
        for (int tt = 0; tt < 2; ++tt)
#pragma unroll
            for (int st = 0; st < 4; ++st) acc[tt][st] = (f32x4){0.f, 0.f, 0.f, 0.f};
        if (live0) {
#pragma unroll
            for (int st = 0; st < 4; ++st)
#pragma unroll
                for (int ks = 0; ks < 4; ++ks) acc[0][st] = __builtin_amdgcn_mfma_f32_16x16x32_bf16(A[0][ks], B[st][ks], acc[0][st], 0, 0, 0);
        }
        if (live1) {
#pragma unroll
            for (int st = 0; st < 4; ++st)
#pragma unroll
                for (int ks = 0; ks < 4; ++ks) acc[1][st] = __builtin_amdgcn_mfma_f32_16x16x32_bf16(A[1][ks], B[st][ks], acc[1][st], 0, 0, 0);
        }
#pragma unroll
        for (int tt = 0; tt < 2; ++tt) {
            const int trow = 16 * (2 * th + tt);
#pragma unroll
            for (int st = 0; st < 4; ++st) {
                const int s_ = 16 * st + m;
#pragma unroll
                for (int r = 0; r < 4; ++r) { const int t = trow + 4 * kq + r; const float v = (s_ <= t && t < T) ? acc[tt][st][r] : 0.f;
                    ATT[(((size_t)ci * 4 + hd) * 64 + t) * 64 + s_] = (bf16_t)(cvt_pk_bf16(v, 0.f) & 0xffffu); }
            }
        }
    }
}

__device__ __forceinline__ void gla_scan_chunk(Frame& F, int ci, int h, int et, f32x4 (&S)[8], int lane) {
    const bf16_t* QE = (const bf16_t*)(F.ws + WS_QE); const bf16_t* KET = (const bf16_t*)(F.ws + WS_KET); const bf16_t* VT = (const bf16_t*)(F.ws + WS_VT); const bf16_t* ATT = (const bf16_t*)(F.ws + WS_ATT);
    const float* EBL = (const float*)(F.ws + WS_EBL); bf16_t* O = (bf16_t*)(F.ws + WS_O);
    int r0, T; chunk_info(ci, r0, T);
    const int m = lane & 15, g = lane >> 4;
    bf16x8 Bv[2], At0[2], Ka[8][2]; u32x2 Q0[4][2];
#pragma unroll
    for (int ks = 0; ks < 2; ++ks) Bv[ks] = *(const bf16x8*)(VT + (((size_t)ci * 4 + h) * 256 + 16 * et + m) * 64 + 32 * ks + 8 * g);
#pragma unroll
    for (int ks = 0; ks < 2; ++ks) At0[ks] = *(const bf16x8*)(ATT + (((size_t)ci * 4 + h) * 64 + m) * 64 + 8 * g + 32 * ks);
#pragma unroll
    for (int kk = 0; kk < 4; ++kk) { const bf16_t* qp = QE + (size_t)(r0 + m) * 512 + h * 128 + 4 * g; Q0[kk][0] = *(const u32x2*)(qp + 32 * kk); Q0[kk][1] = *(const u32x2*)(qp + 32 * kk + 16); }
#pragma unroll
    for (int dt = 0; dt < 8; ++dt) {
        const bf16_t* kp = KET + (((size_t)ci * 4 + h) * 128 + 16 * dt + m) * 64 + 8 * g;
        Ka[dt][0] = *(const bf16x8*)kp; Ka[dt][1] = *(const bf16x8*)(kp + 32);
    }
    __builtin_amdgcn_sched_barrier(0);
    bf16x8 Bs[4];
#pragma unroll
    for (int kk = 0; kk < 4; ++kk) { u32x4 w; w.x = cvt_pk_bf16(S[2 * kk][0], S[2 * kk][1]); w.y = cvt_pk_bf16(S[2 * kk][2], S[2 * kk][3]); w.z = cvt_pk_bf16(S[2 * kk + 1][0], S[2 * kk + 1][1]); w.w = cvt_pk_bf16(S[2 * kk + 1][2], S[2 * kk + 1][3]);
        Bs[kk] = __builtin_bit_cast(bf16x8, w); }
    {
        f32x4 acc = (f32x4){0.f, 0.f, 0.f, 0.f};
#pragma unroll
        for (int ks = 0; ks < 2; ++ks) acc = __builtin_amdgcn_mfma_f32_16x16x32_bf16(At0[ks], Bv[ks], acc, 0, 0, 0);
#pragma unroll
        for (int kk = 0; kk < 4; ++kk) {
            const u32x4 w = (u32x4){Q0[kk][0].x, Q0[kk][0].y, Q0[kk][1].x, Q0[kk][1].y};
            acc = __builtin_amdgcn_mfma_f32_16x16x32_bf16(__builtin_bit_cast(bf16x8, w), Bs[kk], acc, 0, 0, 0);
        }
#pragma unroll
        for (int r = 0; r < 4; ++r) { const int t = 4 * g + r; if (t < T) O[(size_t)(r0 + t) * DM + h * 256 + 16 * et + m] = (bf16_t)(cvt_pk_bf16(acc[r], 0.f) & 0xffffu); }
    }
#pragma unroll 1
    for (int tt = 1; 16 * tt < T; ++tt) {
        f32x4 acc = (f32x4){0.f, 0.f, 0.f, 0.f};
        const bf16_t* ap = ATT + (((size_t)ci * 4 + h) * 64 + 16 * tt + m) * 64 + 8 * g;
#pragma unroll
        for (int ks = 0; ks < 2; ++ks) acc = __builtin_amdgcn_mfma_f32_16x16x32_bf16(*(const bf16x8*)(ap + 32 * ks), Bv[ks], acc, 0, 0, 0);
        const bf16_t* qp = QE + (size_t)(r0 + 16 * tt + m) * 512 + h * 128 + 4 * g;
#pragma unroll
        for (int kk = 0; kk < 4; ++kk) {
            const u32x2 a0 = *(const u32x2*)(qp + 32 * kk), a1 = *(const u32x2*)(qp + 32 * kk + 16);
            const u32x4 w = (u32x4){a0.x, a0.y, a1.x, a1.y};
            acc = __builtin_amdgcn_mfma_f32_16x16x32_bf16(__builtin_bit_cast(bf16x8, w), Bs[kk], acc, 0, 0, 0);
        }
#pragma unroll
        for (int r = 0; r < 4; ++r) { const int t = 16 * tt + 4 * g + r; if (t < T) O[(size_t)(r0 + t) * DM + h * 256 + 16 * et + m] = (bf16_t)(cvt_pk_bf16(acc[r], 0.f) & 0xffffu); }
    }
#pragma unroll
    for (int dt = 0; dt < 8; ++dt) {
        f32x4 U = S[dt];
#pragma unroll
        for (int ks = 0; ks < 2; ++ks) U = __builtin_amdgcn_mfma_f32_16x16x32_bf16(Ka[dt][ks], Bv[ks], U, 0, 0, 0);
        S[dt] = U * *(const f32x4*)(EBL + (size_t)ci * 512 + h * 128 + 16 * dt + 4 * g);
    }
}
constexpr int SC_ATT = 0, SC_QE = 9216, SC_KET = SC_QE + 17408, SC_EBL = SC_KET + 18432, SC_BUF = SC_EBL + 512;
static_assert(2 * SC_BUF <= LDS_MISC, "scan lds");
struct ScanStage { u32x4 att, ke0, ke1, qe0, qe1, eb; };
__device__ __forceinline__ void scan_stage_load(Frame& F, int ci, int h, ScanStage& st) {
    const bf16_t* QE = (const bf16_t*)(F.ws + WS_QE); const bf16_t* KET = (const bf16_t*)(F.ws + WS_KET); const bf16_t* ATT = (const bf16_t*)(F.ws + WS_ATT); const float* EBL = (const float*)(F.ws + WS_EBL);
    int r0, T; chunk_info(ci, r0, T);
    const int i = F.tid;
    st.att = *(const u32x4*)(ATT + (((size_t)ci * 4 + h) * 64 + (i >> 3)) * 64 + 8 * (i & 7));
    st.ke0 = *(const u32x4*)(KET + (((size_t)ci * 4 + h) * 128 + (i >> 3)) * 64 + 8 * (i & 7));
    st.ke1 = *(const u32x4*)(KET + (((size_t)ci * 4 + h) * 128 + 64 + (i >> 3)) * 64 + 8 * (i & 7));
    st.qe0 = *(const u32x4*)(QE + (size_t)(r0 + (i >> 4)) * 512 + h * 128 + 8 * (i & 15));
    st.qe1 = *(const u32x4*)(QE + (size_t)(r0 + 32 + (i >> 4)) * 512 + h * 128 + 8 * (i & 15));
    st.eb = *(const u32x4*)(EBL + (size_t)ci * 512 + h * 128 + 4 * (i & 31));
}
__device__ __forceinline__ void scan_stage_store(Frame& F, int buf, const ScanStage& st) {
    LAS unsigned char* base = F.lds + buf * SC_BUF; const int i = F.tid;
    *(LAS u32x4*)(base + SC_ATT + (i >> 3) * 144 + 16 * (i & 7)) = st.att;
    *(LAS u32x4*)(base + SC_KET + (i >> 3) * 144 + 16 * (i & 7)) = st.ke0;
    *(LAS u32x4*)(base + SC_KET + (64 + (i >> 3)) * 144 + 16 * (i & 7)) = st.ke1;
    *(LAS u32x4*)(base + SC_QE + (i >> 4) * 272 + 16 * (i & 15)) = st.qe0;
    *(LAS u32x4*)(base + SC_QE + (32 + (i >> 4)) * 272 + 16 * (i & 15)) = st.qe1;
    *(LAS u32x4*)(base + SC_EBL + 16 * (i & 31)) = st.eb;
}
__device__ __forceinline__ void scan_load_bv(Frame& F, int ci, int h, int et, int lane, bf16x8 (&Bv)[2]) {
    const bf16_t* VT = (const bf16_t*)(F.ws + WS_VT); const int m = lane & 15, g = lane >> 4;
#pragma unroll
    for (int ks = 0; ks < 2; ++ks) Bv[ks] = *(const bf16x8*)(VT + (((size_t)ci * 4 + h) * 256 + 16 * et + m) * 64 + 32 * ks + 8 * g);
}
__device__ __forceinline__ void gla_scan_prompt_step(Frame& F, int b, int h, int et, int c, f32x4 (&S)[8], ScanStage& st, const bf16x8 (&Bv)[2], bf16x8 (&Bn)[2]) {
    bf16_t* O = (bf16_t*)(F.ws + WS_O);
    const int lane = F.lane, m = lane & 15, g = lane >> 4;
    const int ci = c == 0 ? 0 : b * 32 + c, cn = b * 32 + c + 1, buf = c & 1;
    int r0, T; chunk_info(ci, r0, T);
    if (c + 1 < 33) { scan_stage_load(F, cn, h, st); scan_load_bv(F, cn, h, et, lane, Bn); }
    const LAS unsigned char* base = F.lds + buf * SC_BUF;
    bf16x8 Bs[4];
#pragma unroll
    for (int kk = 0; kk < 4; ++kk) { u32x4 wv; wv.x = cvt_pk_bf16(S[2 * kk][0], S[2 * kk][1]); wv.y = cvt_pk_bf16(S[2 * kk][2], S[2 * kk][3]); wv.z = cvt_pk_bf16(S[2 * kk + 1][0], S[2 * kk + 1][1]); wv.w = cvt_pk_bf16(S[2 * kk + 1][2], S[2 * kk + 1][3]);
        Bs[kk] = __builtin_bit_cast(bf16x8, wv); }
#pragma unroll
    for (int ti = 0; ti < 2; ++ti) {
        const int tt = 2 * (F.wave >> 2) + ti;
        bf16x8 Aa[2], Aq[4];
#pragma unroll
        for (int ks = 0; ks < 2; ++ks) Aa[ks] = *(const LAS bf16x8*)(base + SC_ATT + (16 * tt + m) * 144 + 64 * ks + 16 * g);
#pragma unroll
        for (int kk = 0; kk < 4; ++kk) { const u32x2 a0 = *(const LAS u32x2*)(base + SC_QE + (16 * tt + m) * 272 + 64 * kk + 8 * g), a1 = *(const LAS u32x2*)(base + SC_QE + (16 * tt + m) * 272 + 64 * kk + 32 + 8 * g);
            const u32x4 wv = (u32x4){a0.x, a0.y, a1.x, a1.y}; Aq[kk] = __builtin_bit_cast(bf16x8, wv); }
        f32x4 acc = (f32x4){0.f, 0.f, 0.f, 0.f}, acc2 = (f32x4){0.f, 0.f, 0.f, 0.f};
#pragma unroll
        for (int ks = 0; ks < 2; ++ks) acc = __builtin_amdgcn_mfma_f32_16x16x32_bf16(Aa[ks], Bv[ks], acc, 0, 0, 0);
#pragma unroll
        for (int kk = 0; kk < 4; kk += 2) { acc2 = __builtin_amdgcn_mfma_f32_16x16x32_bf16(Aq[kk], Bs[kk], acc2, 0, 0, 0); acc = __builtin_amdgcn_mfma_f32_16x16x32_bf16(Aq[kk + 1], Bs[kk + 1], acc, 0, 0, 0); }
        acc += acc2;
        bf16_t* op = O + (size_t)(r0 + 16 * tt + 4 * g) * DM + h * 256 + 16 * et + m;
        const unsigned p01 = cvt_pk_bf16(acc[0], acc[1]), p23 = cvt_pk_bf16(acc[2], acc[3]);
        if (16 * tt + 4 * g + 0 < T) op[0] = (bf16_t)(p01 & 0xffffu);
        if (16 * tt + 4 * g + 1 < T) op[(size_t)DM] = (bf16_t)(p01 >> 16);
        if (16 * tt + 4 * g + 2 < T) op[(size_t)2 * DM] = (bf16_t)(p23 & 0xffffu);
        if (16 * tt + 4 * g + 3 < T) op[(size_t)3 * DM] = (bf16_t)(p23 >> 16);
    }
#pragma unroll
    for (int dt = 0; dt < 8; ++dt) {
        bf16x8 Ak[2];
#pragma unroll
        for (int ks = 0; ks < 2; ++ks) Ak[ks] = *(const LAS bf16x8*)(base + SC_KET + (16 * dt + m) * 144 + 64 * ks + 16 * g);
        const f32x4 eb = *(const LAS f32x4*)(base + SC_EBL + (16 * dt + 4 * g) * 4);
        f32x4 U = S[dt];
#pragma unroll
        for (int ks = 0; ks < 2; ++ks) U = __builtin_amdgcn_mfma_f32_16x16x32_bf16(Ak[ks], Bv[ks], U, 0, 0, 0);
        S[dt] = U * eb;
        if ((dt & 3) == 3) __builtin_amdgcn_sched_barrier(0);
    }
    if (c + 1 < 33) scan_stage_store(F, buf ^ 1, st);
    asm volatile("s_waitcnt lgkmcnt(0)\n\ts_barrier" ::: "memory");
}
__device__ __forceinline__ void gla_scan_prompt_unit(Frame& F, int o, int b, int h, int hf) {
    const int lane = F.lane, w = F.wave, m = lane & 15, g = lane >> 4, et = 4 * hf + (w & 3);
    f32x4 S[8];
#pragma unroll
    for (int dt = 0; dt < 8; ++dt) S[dt] = (f32x4){0.f, 0.f, 0.f, 0.f};
    ScanStage st; bf16x8 Ba[2], Bb[2];
    __syncthreads();
    scan_stage_load(F, 0, h, st); scan_load_bv(F, 0, h, et, lane, Ba);
    scan_stage_store(F, 0, st);
    __syncthreads();
    for (int c = 0; c < 33; c += 2) {
        gla_scan_prompt_step(F, b, h, et, c, S, st, Ba, Bb);
        if (c + 1 < 33) gla_scan_prompt_step(F, b, h, et, c + 1, S, st, Bb, Ba);
    }
    float* dst = F.out + O_GP + (((size_t)(o * NBATCH + b) * 4 + h) * 128 + 4 * g) * 256 + 16 * et + m;
    if (w < 4) {
#pragma unroll
        for (int dt = 0; dt < 8; ++dt) {
#pragma unroll
            for (int r = 0; r < 4; ++r) dst[r * 256] = S[dt][r];
            dst += 16 * 256;
        }
    }
}
__device__ __forceinline__ void gla_scan_phase(Frame& F, int o, bool late_convert) {
    const int lane = F.lane, w = F.wave, m = lane & 15, g = lane >> 4;
    const int npw = F.G > 128 ? 128 : F.G;
    if (F.blk < npw) { for (int pu = F.blk; pu < 128; pu += npw) gla_scan_prompt_unit(F, o, pu >> 4, (pu >> 2) & 3, pu & 3); }
    if (late_convert && F.G > 128 && F.blk >= 128) convert_weights(F, 1, (F.blk - 128) * 8 + w, (F.G - 128) * 8, F.blk - 128, F.G - 128);
    if (F.G <= 128 || F.blk >= 128) {
        const int first = F.G > 128 ? (F.blk - 128) * 8 + w : F.blk * 8 + w, stride = F.G > 128 ? (F.G - 128) * 8 : F.G * 8;
        f32x4 S[8];
        for (int su = first; su < 2048; su += stride) {
            const int db = su >> 6, h = (su >> 4) & 3, et = su & 15;
            const float* src = F.in[IN_SGLA] + (((size_t)(o * DBATCH + db) * 4 + h) * 128) * 256 + 16 * et + m;
#pragma unroll
            for (int dt = 0; dt < 8; ++dt)
#pragma unroll
                for (int r = 0; r < 4; ++r) S[dt][r] = src[(size_t)(16 * dt + 4 * g + r) * 256];
            gla_scan_chunk(F, 257 + db, h, et, S, lane);
            float* dst = F.out + O_GS + (((size_t)(o * DBATCH + db) * 4 + h) * 128) * 256 + 16 * et + m;
#pragma unroll
            for (int dt = 0; dt < 8; ++dt)
#pragma unroll
                for (int r = 0; r < 4; ++r) dst[(size_t)(16 * dt + 4 * g + r) * 256] = S[dt][r];
        }
    }
}
__device__ __forceinline__ void gla_post_phase(Frame& F, int o) {
    const float* proj = (const float*)(F.ws + WS_PROJ); const bf16_t* O = (const bf16_t*)(F.ws + WS_O); bf16_t* act = (bf16_t*)(F.ws + WS_ACT);
    const int lane = F.lane;
    const f32x4 gn = *(const f32x4*)(F.in[IN_GNORM] + o * 256 + 4 * lane);
    for (int row = F.blk * 8 + F.wave; row < MREAL; row += F.G * 8) {
        f32x4 v[4], gg[4]; float sq[4];
#pragma unroll
        for (int h = 0; h < 4; ++h) { { const u32x2 ob = *(const u32x2*)(O + (size_t)row * DM + h * 256 + 4 * lane); v[h] = (f32x4){bf_lo(ob.x), bf_hi(ob.x), bf_lo(ob.y), bf_hi(ob.y)}; } { const u32x2 gb = *(const u32x2*)((const bf16_t*)proj + (size_t)row * PLB + OG + h * 256 + 4 * lane); gg[h] = (f32x4){bf_lo(gb.x), bf_hi(gb.x), bf_lo(gb.y), bf_hi(gb.y)}; } }
#pragma unroll
        for (int h = 0; h < 4; ++h) sq[h] = (v[h][0] * v[h][0] + v[h][1] * v[h][1]) + (v[h][2] * v[h][2] + v[h][3] * v[h][3]);
#pragma unroll
        for (int o2 = 1; o2 < 64; o2 <<= 1) {
#pragma unroll
            for (int h = 0; h < 4; ++h) sq[h] += __shfl_xor(sq[h], o2);
        }
#pragma unroll
        for (int h = 0; h < 4; ++h) {
            const float rs = rsqrtf(sq[h] * (1.f / 256.f) + EPS);
            f32x4 y;
#pragma unroll
            for (int i = 0; i < 4; ++i) y[i] = v[h][i] * rs * gn[i] * silu_f(gg[h][i]);
            u32x2 wv; wv.x = cvt_pk_bf16(y[0], y[1]); wv.y = cvt_pk_bf16(y[2], y[3]);
            *(u32x2*)(act + (size_t)row * DM + h * 256 + 4 * lane) = wv;
        }
    }
}
__device__ __forceinline__ void final_phase(Frame& F) {
    const bf16_t* XBf = (const bf16_t*)(F.ws + WS_XB); const float* ssf = (const float*)(F.ws + WS_SSP) + (size_t)8 * MP * 16;
    const int lane = F.lane;
    for (int row = F.blk * 8 + F.wave; row < MREAL; row += F.G * 8) {
        float* dst;
        if (row < ROW_META) dst = F.out + O_YP + (size_t)row * DM; else if (row >= ROW_SAMP) dst = F.out + O_YS + (size_t)(row - ROW_SAMP) * DM; else continue;
        float rs;
        if (row < TR0) rs = row_rstd(ssf, row);
        else { const float* p = (const float*)(F.ws + WS_SST) + ((size_t)8 * TROWS + (row - TR0)) * 64; float sacc = 0.f;
#pragma unroll
            for (int i = 0; i < 16; ++i) { const f32x4 a = *(const f32x4*)(p + 4 * i); sacc += (a[0] + a[1]) + (a[2] + a[3]); }
            rs = rsqrtf(sacc * (1.f / DM) + EPS); }
#pragma unroll
        for (int j = 0; j < 4; ++j) {
            const u32x2 xb = *(const u32x2*)(XBf + (size_t)row * DM + 256 * j + 4 * lane); const f32x4 v = (f32x4){bf_lo(xb.x), bf_hi(xb.x), bf_lo(xb.y), bf_hi(xb.y)}, gn = *(const f32x4*)(F.in[IN_NFIN] + 256 * j + 4 * lane);
            *(f32x4*)(dst + 256 * j + 4 * lane) = v * rs * gn;
        }
    }
}

constexpr int NPHASE = 30;
__global__ void __launch_bounds__(512, 2) mega_fwd(Args args) {
    extern __shared__ __attribute__((aligned(16))) unsigned char lds_raw[];
    volatile LAS unsigned* misc = (volatile LAS unsigned*)((LAS unsigned char*)lds_raw + LDS_MISC);
    if (threadIdx.x < 8) misc[threadIdx.x] = 0u;
    __syncthreads();
    const int lo = args.ph_lo, hi = args.ph_hi;
    const bool multi = (hi - lo) > 1;
    XcdBarrier bar; bar.bar = (unsigned*)(args.ws + WS_CTL) + CW_BAR; bar.x = 0; bar.st = misc;
    if (multi) bar = xcd_barrier_post((unsigned*)(args.ws + WS_CTL) + CW_BAR, misc);
#ifndef PH_MASK
#define PH_MASK 0xffu
#endif
#ifndef DUP_MASK
#define DUP_MASK 0u
#endif
#define IN(k) (lo <= (k) && (k) < hi)
#define SEAM(k) do { if (IN((k) + 1)) xcd_barrier(bar); } while (0)
#define PHASE_FRAME() Frame F; { int tid_l = threadIdx.x; asm volatile("" : "+v"(tid_l)); size_t zoff = 0; asm volatile("" : "+s"(zoff)); unsigned char* ws_l = args.ws + zoff; \
    F.lds = (LAS unsigned char*)lds_raw; F.tid = tid_l; F.lane = tid_l & 63; F.wave = __builtin_amdgcn_readfirstlane(tid_l >> 6); F.G = gridDim.x; F.blk = blockIdx.x; \
    F.in = args.in; F.out = args.out; F.ws = ws_l; F.ctl = (unsigned*)(ws_l + WS_CTL); } unsigned char* ws = F.ws; float* ssb = (float*)(F.ws + WS_SSP); float* sstb = (float*)(F.ws + WS_SST); (void)ssb; (void)sstb; (void)ws
    if ((PH_MASK & 1u) && IN(0)) { PHASE_FRAME(); p0_prologue(F); if (DUP_MASK & 1u) { xcd_barrier(bar); p0_prologue(F); } SEAM(0); }
    for (int l = 0; l < 4; ++l) {
        const int base = 1 + 7 * l, odd = l & 1, eo = l >> 1;
        if ((PH_MASK & 2u) && IN(base + 0)) {
            PHASE_FRAME();
            pg8::Gemm g{(const bf16_t*)(ws + WS_XB), odd ? (const bf16_t*)(ws + WS_WINO) + (size_t)eo * NO * DM : (const bf16_t*)(ws + WS_WINE) + (size_t)eo * NE * DM, TR0, odd ? 3072 : NE, DM};
            pg8::StaticOrder S; S.init(g.M, g.N, F.G, F.blk);
            const int pm0 = panel_rstd_to_lds(F, ssb + (size_t)l * MP * 16, g.M, g.N);
            pg8::EpiProj E{(float*)(ws + WS_PROJ), PLD, ssb + (size_t)l * MP * 16, odd ? 0 : 1, (bf16_t*)(ws + WS_KVB), (_Float16*)(ws + WS_KIH), F.out, eo, (const LAS float*)(F.lds + LDS_RSL), pm0, (bf16_t*)(ws + WS_QE), (_Float16*)(ws + WS_KEB)};
            pg8::gemm_phase(F.lds, g, S, E, F.tid);
            { SkinnyEpi K{}; K.C = (float*)(ws + WS_PROJ); K.ldc = PLD; K.even = odd ? 0 : 1; K.kvb = (bf16_t*)(ws + WS_KVB); K.kih = (_Float16*)(ws + WS_KIH); K.out = F.out; K.eidx = eo; K.qb16 = (bf16_t*)(ws + WS_QE); K.qih = (_Float16*)(ws + WS_KEB);
              if (odd) skinny_phase<SKM_PROJ, 2, 4>(F, g.A, g.Bt, DM, 192, sstb + (size_t)l * TROWS * 64, K); else skinny_phase<SKM_PROJ, 2, 3>(F, g.A, g.Bt, DM, 117, sstb + (size_t)l * TROWS * 64, K); }
            SEAM(base + 0);
        }
        if (!odd) {
            if ((PH_MASK & 4u) && IN(base + 1)) { PHASE_FRAME(); even_mixer_phase(F, eo, l); if (DUP_MASK & 2u) { xcd_barrier(bar); even_mixer_phase(F, eo, l + 4); } SEAM(base + 3); }
        } else {
            if ((PH_MASK & 8u) && IN(base + 1)) { PHASE_FRAME(); for (int ci = F.blk; ci < NCHUNK; ci += F.G) gla_prep_unit(F, eo, ci, ssb + (size_t)l * MP * 16, sstb + (size_t)l * TROWS * 64); if (DUP_MASK & 4u) { xcd_barrier(bar); for (int ci = F.blk; ci < NCHUNK; ci += F.G) gla_prep_unit(F, eo, ci, ssb + (size_t)l * MP * 16, sstb + (size_t)l * TROWS * 64); } SEAM(base + 1); }
            if ((PH_MASK & 16u) && IN(base + 2)) { PHASE_FRAME(); gla_scan_phase(F, eo, l == 1); if (DUP_MASK & 8u) { xcd_barrier(bar); gla_scan_phase(F, eo, false); } SEAM(base + 2); }
            if ((PH_MASK & 32u) && IN(base + 3)) { PHASE_FRAME(); gla_post_phase(F, eo); if (DUP_MASK & 16u) { xcd_barrier(bar); gla_post_phase(F, eo); } SEAM(base + 3); }
        }
        if ((PH_MASK & 64u) && IN(base + 4)) {
            PHASE_FRAME();
            pg8::Gemm g{(const bf16_t*)(ws + WS_ACT), odd ? (const bf16_t*)(ws + WS_WOUTO) + (size_t)eo * DM * DM : (const bf16_t*)(ws + WS_WOUTE) + (size_t)eo * DM * DM, TR0, DM, DM};
            pg8::StaticOrder S; S.init(g.M, g.N, F.G, F.blk);
            pg8::EpiRes E{(bf16_t*)(ws + WS_XB), ssb + (size_t)(4 + l) * MP * 16, l == 0 ? F.in[IN_XP] : nullptr};
            pg8::gemm_phase(F.lds, g, S, E, F.tid);
            { SkinnyEpi K{}; K.XB = (bf16_t*)(ws + WS_XB); K.sst_next = sstb + (size_t)(4 + l) * TROWS * 64;
              skinny_phase<SKM_RES, 2, 2>(F, g.A, g.Bt, DM, 64, nullptr, K); }
            SEAM(base + 4);
        }
        if ((PH_MASK & 128u) && IN(base + 5)) {
            PHASE_FRAME();
            pg8::Gemm g{(const bf16_t*)(ws + WS_XB), (const bf16_t*)(ws + WS_WGU) + (size_t)l * NGU * DM, TR0, NGU, DM};
            pg8::StaticOrder S; S.init(g.M, g.N, F.G, F.blk);
            const int pm0 = panel_rstd_to_lds(F, ssb + (size_t)(4 + l) * MP * 16, g.M, g.N);
            pg8::EpiGU E{(bf16_t*)(ws + WS_HFF), ssb + (size_t)(4 + l) * MP * 16, (const LAS float*)(F.lds + LDS_RSL), pm0};
            pg8::gemm_phase(F.lds, g, S, E, F.tid);
            { SkinnyEpi K{}; K.H = (bf16_t*)(ws + WS_HFF);
              skinny_phase<SKM_GU, 5, 2>(F, g.A, g.Bt, DM, 176, sstb + (size_t)(4 + l) * TROWS * 64, K, F.G == 256 ? 128 : 0); }
            SEAM(base + 5);
        }
        if ((PH_MASK & 64u) && IN(base + 6)) {
            PHASE_FRAME();
            pg8::Gemm g{(const bf16_t*)(ws + WS_HFF), (const bf16_t*)(ws + WS_WDN) + (size_t)l * DM * DFF, TR0, DM, DFF};
            pg8::StaticOrder S; S.init(g.M, g.N, F.G, F.blk);
            pg8::EpiRes E{(bf16_t*)(ws + WS_XB), ssb + (size_t)(l < 3 ? (l + 1) : 8) * MP * 16, nullptr};
            pg8::gemm_phase(F.lds, g, S, E, F.tid);
            { SkinnyEpi K{}; K.XB = (bf16_t*)(ws + WS_XB); K.sst_next = sstb + (size_t)(l < 3 ? (l + 1) : 8) * TROWS * 64;
              skinny_phase<SKM_RES, 2, 2>(F, g.A, g.Bt, DFF, 64, nullptr, K); }
            SEAM(base + 6);
        }
    }
    if (IN(29)) { PHASE_FRAME(); final_phase(F); if (DUP_MASK & 32u) { xcd_barrier(bar); final_phase(F); } }
#undef IN
#undef SEAM
}

#ifdef DBG_COPY
__global__ void dbg_copy(const unsigned char* ws, float* out) {
    const bf16_t* src = (const bf16_t*)(ws + DBG_SRC);
    for (size_t i = (size_t)blockIdx.x * blockDim.x + threadIdx.x; i < (size_t)DBG_N; i += (size_t)gridDim.x * blockDim.x) out[i] = bf_lo((unsigned)src[i]);
}
#endif
#ifndef MK_ONE_LAUNCH
#define MK_ONE_LAUNCH 1
#endif
extern "C" void kernel_launch(void* const* d_in, const int* in_sizes, int n_in, void* d_out, int out_size, void* d_ws, size_t ws_size, hipStream_t stream) {
    static int grid = 0;
    if (grid == 0) {
        if (n_in != 24 || ws_size < WS_END || (size_t)out_size != O_END) { grid = -1; return; }
        int dev = 0, cus = 0;
        if (hipGetDevice(&dev) != hipSuccess || hipDeviceGetAttribute(&cus, hipDeviceAttributeMultiprocessorCount, dev) != hipSuccess) { grid = -1; return; }
        if (hipFuncSetAttribute((const void*)mega_fwd, hipFuncAttributeMaxDynamicSharedMemorySize, LDS_BYTES) != hipSuccess) { grid = -1; return; }
        int per_cu = 0;
        (void)hipOccupancyMaxActiveBlocksPerMultiprocessor(&per_cu, (const void*)mega_fwd, 512, LDS_BYTES);
        (void)hipGetLastError();
        grid = cus;
    }
    if (grid < 0) return;
    (void)hipMemsetAsync((char*)d_ws + WS_CTL, 0, CTL_BYTES, stream);
#ifdef DBG_FILL
    (void)hipMemsetAsync(d_out, 0, (size_t)out_size * 4, stream);
#endif
    Args a{};
    for (int i = 0; i < 24; ++i) a.in[i] = (const float*)d_in[i];
    a.out = (float*)d_out; a.ws = (unsigned char*)d_ws;
#if MK_ONE_LAUNCH
    a.ph_lo = 0; a.ph_hi = NPHASE;
    hipLaunchKernelGGL(mega_fwd, dim3(grid), dim3(512), LDS_BYTES, stream, a);
#else
#ifndef PH_LIMIT
#define PH_LIMIT NPHASE
#endif
    for (int p = 0; p < PH_LIMIT; ++p) {
        const int l = (p - 1) / 7, k = (p - 1) % 7;
        if (p >= 1 && p <= 28 && !(l & 1) && (k == 2 || k == 3)) continue;
        a.ph_lo = p; a.ph_hi = p + 1;
        hipLaunchKernelGGL(mega_fwd, dim3(grid), dim3(512), LDS_BYTES, stream, a);
    }
#ifdef DBG_COPY
    hipLaunchKernelGGL(dbg_copy, dim3(1024), dim3(256), 0, stream, (const unsigned char*)d_ws, (float*)d_out);
#endif
#endif
}
```

```cpp
#include <hip/hip_runtime.h>
#include <stdint.h>

#define LAS __attribute__((address_space(3)))
#define GAS __attribute__((address_space(1)))
typedef unsigned short u16;
typedef unsigned short bf16_t;
typedef short bf16x8 __attribute__((ext_vector_type(8)));
typedef _Float16 f16x8 __attribute__((ext_vector_type(8)));
typedef _Float16 f16x4 __attribute__((ext_vector_type(4)));
typedef float f32x2 __attribute__((ext_vector_type(2)));
typedef float f32x4 __attribute__((ext_vector_type(4)));
typedef float f32x16 __attribute__((ext_vector_type(16)));
typedef unsigned u32x2 __attribute__((ext_vector_type(2)));
typedef unsigned u32x4 __attribute__((ext_vector_type(4)));

constexpr int DM = 1024, NBATCH = 8, SEQ = 2048, NMETA = 16, LP = 2064, DBATCH = 32, DSEQ = 4, PAST = 8192, PAGE = 128, NPAGES = 64, NPOOLPG = 2560;
constexpr int ROW_META = 16384, ROW_SAMP = 16400, MREAL = 16528, MP = 16640;
constexpr int NE = 2048, NO = 3328, NGU = 5632, DFF = 2816, PLD = 3328;
constexpr int EIN = 1864, OIN = 3088;
constexpr int EQ = 0, EQI = 512, EU = 1024, EK = 1536, EV = 1664, EKI = 1792, EWI = 1856;
constexpr int OQ = 0, OKK = 512, OV = 1024, OG = 2048, OGD = 3072;
constexpr int PLB = 3072;
constexpr int NCHUNK = 289;
constexpr float EPS = 1e-6f;

constexpr size_t MiB = 1u << 20;
constexpr size_t WS_CTL = 0, CTL_BYTES = 4 * MiB;
constexpr size_t WS_WINE = 4 * MiB, WS_WOUTE = 12 * MiB, WS_WINO = 16 * MiB, WS_WOUTO = 29 * MiB, WS_WGU = 33 * MiB, WS_WDN = 77 * MiB;
constexpr size_t WS_X = 100 * MiB, WS_XB = 166 * MiB, WS_PROJ = 199 * MiB, WS_ACT = 411 * MiB, WS_HFF = 444 * MiB, WS_KVB = 534 * MiB, WS_KIH = 543 * MiB;
constexpr size_t WS_QE = 546 * MiB, WS_KET = 563 * MiB, WS_VT = 582 * MiB, WS_ATT = 619 * MiB, WS_EBL = 629 * MiB, WS_O = 630 * MiB, WS_SSP = 696 * MiB, WS_KEB = 706 * MiB, WS_SST = 723 * MiB, WS_END = 724 * MiB;
static_assert(WS_X + (size_t)MP * DM * 4 <= WS_XB && WS_XB + (size_t)MP * DM * 2 <= WS_PROJ && WS_PROJ + (size_t)MP * PLD * 4 <= WS_ACT, "ws map");
static_assert(WS_ACT + (size_t)MP * DM * 2 <= WS_HFF && WS_HFF + (size_t)MP * DFF * 2 <= WS_KVB && WS_KVB + (size_t)MP * 256 * 2 <= WS_KIH && WS_KIH + (size_t)MP * 64 * 2 <= WS_QE, "ws map");
static_assert(WS_QE + (size_t)MP * 512 * 2 <= WS_KET && WS_KET + (size_t)NCHUNK * 4 * 128 * 64 * 2 <= WS_VT && WS_VT + (size_t)NCHUNK * 4 * 256 * 64 * 2 <= WS_ATT, "ws map");
static_assert(WS_ATT + (size_t)NCHUNK * 4 * 64 * 64 * 2 <= WS_EBL && WS_EBL + (size_t)NCHUNK * 512 * 4 <= WS_O && WS_O + (size_t)MP * DM * 4 <= WS_SSP && WS_SSP + (size_t)9 * MP * 16 * 4 <= WS_KEB && WS_KEB + (size_t)MP * 512 * 2 <= WS_SST && WS_SST + (size_t)9 * 160 * 64 * 4 <= WS_END, "ws map");
static_assert(WS_WINE + 2 * (size_t)NE * DM * 2 <= WS_WOUTE && WS_WINO + 2 * (size_t)NO * DM * 2 <= WS_WOUTO && WS_WGU + 4 * (size_t)NGU * DM * 2 <= WS_WDN && WS_WDN + 4 * (size_t)DM * DFF * 2 <= WS_X, "ws map");
constexpr int CW_BAR = 1024;
constexpr int CW_QUEUE = 8192;
constexpr int CW_SS = 16384;
static_assert((CW_SS + 9 * MP) * 4 <= (int)CTL_BYTES, "ctl");

constexpr size_t O_YP = 0, O_YS = O_YP + (size_t)NBATCH * SEQ * DM, O_KP = O_YS + (size_t)DBATCH * DSEQ * DM, O_VP = O_KP + (size_t)2 * NBATCH * LP * 128,
                 O_KIP = O_VP + (size_t)2 * NBATCH * LP * 128, O_KS = O_KIP + (size_t)2 * NBATCH * LP * 64, O_VS = O_KS + (size_t)2 * DBATCH * DSEQ * 128,
                 O_KIS = O_VS + (size_t)2 * DBATCH * DSEQ * 128, O_PP = O_KIS + (size_t)2 * DBATCH * DSEQ * 64, O_PS = O_PP + (size_t)2 * NBATCH * 15 * 512,
                 O_GP = O_PS + (size_t)2 * DBATCH * 15 * 512, O_GS = O_GP + (size_t)2 * NBATCH * 4 * 128 * 256, O_END = O_GS + (size_t)2 * DBATCH * 4 * 128 * 256;

constexpr int LDS_MISC = 159744, LDS_BYTES = 160000;

__device__ __forceinline__ unsigned cvt_pk_bf16(float lo, float hi) { unsigned r; asm volatile("v_cvt_pk_bf16_f32 %0, %1, %2" : "=v"(r) : "v"(lo), "v"(hi)); return r; }
__device__ __forceinline__ float bf_lo(unsigned u) { return __builtin_bit_cast(float, u << 16); }
__device__ __forceinline__ float bf_hi(unsigned u) { return __builtin_bit_cast(float, u & 0xffff0000u); }
__device__ __forceinline__ float wave_sum(float v) {
#pragma unroll
    for (int o = 1; o < 64; o <<= 1) v += __shfl_xor(v, o);
    return v;
}
__device__ __forceinline__ int prow(int b, int p) { return p < NMETA ? ROW_META + p : b * SEQ + p - NMETA; }
__device__ __forceinline__ unsigned mbcnt64(unsigned long long m) { return __builtin_amdgcn_mbcnt_hi((unsigned)(m >> 32), __builtin_amdgcn_mbcnt_lo((unsigned)m, 0u)); }
__device__ __forceinline__ float row_rstd(const float* ssp, int row) {
    const f32x4 a = *(const f32x4*)(ssp + (size_t)row * 16), b = *(const f32x4*)(ssp + (size_t)row * 16 + 4), c = *(const f32x4*)(ssp + (size_t)row * 16 + 8), d = *(const f32x4*)(ssp + (size_t)row * 16 + 12);
    const float s = (((a[0] + a[1]) + (a[2] + a[3])) + ((b[0] + b[1]) + (b[2] + b[3]))) + (((c[0] + c[1]) + (c[2] + c[3])) + ((d[0] + d[1]) + (d[2] + d[3])));
    return rsqrtf(s * (1.f / DM) + EPS);
}
__device__ __forceinline__ float tail_rstd(const float* sst, int trow) {
    const float* p = sst + (size_t)trow * 64; float s = 0.f;
#pragma unroll
    for (int i = 0; i < 16; ++i) { const f32x4 a = *(const f32x4*)(p + 4 * i); s += (a[0] + a[1]) + (a[2] + a[3]); }
    return rsqrtf(s * (1.f / DM) + EPS);
}
__device__ __forceinline__ float tail_rstd_batched(const float* sst, int trow) {
    const float* p = sst + (size_t)trow * 64; float s = 0.f; f32x4 a[16];
#pragma unroll
    for (int i = 0; i < 16; ++i) a[i] = *(const f32x4*)(p + 4 * i);
    __builtin_amdgcn_sched_barrier(0);
#pragma unroll
    for (int i = 0; i < 16; ++i) s += (a[i][0] + a[i][1]) + (a[i][2] + a[i][3]);
    return rsqrtf(s * (1.f / DM) + EPS);
}
__device__ __forceinline__ float silu_f(float x) { return x * __builtin_amdgcn_rcpf(1.f + __expf(-x)); }

#define XB_TMO      128
#define XB_XCNT(j)  (256  + 64 * (j))
#define XB_XSUB(j)  (1280 + 64 * (j))
#define XB_XGEN(j)  (2304 + 64 * (j))
#define XB_TOP      3328
#define XB_TOPGEN   3392
#define XCD_BAR_WORDS 3456
#define XB_SPIN_CAP (1u << 18)
__device__ __forceinline__ unsigned xb_ld(unsigned* p)              { return __hip_atomic_load(p, __ATOMIC_RELAXED, __HIP_MEMORY_SCOPE_AGENT); }
__device__ __forceinline__ unsigned xb_add(unsigned* p, unsigned v) { return __hip_atomic_fetch_add(p, v, __ATOMIC_RELAXED, __HIP_MEMORY_SCOPE_AGENT); }
__device__ __forceinline__ unsigned xb_xcc_id() { return (unsigned)__builtin_amdgcn_s_getreg((3 << 11) | 20) & 0xFu; }
#define XB_SPIN(cond, bar) do { unsigned _sp = 0; while (cond) { __builtin_amdgcn_s_sleep(1); \
    if ((++_sp & 255u) == 0u) { if (xb_ld(&(bar)[XB_TMO])) break; if (_sp > XB_SPIN_CAP) { atomicAdd(&(bar)[XB_TMO], 1u); break; } } } } while (0)
struct XcdBarrier { unsigned* bar; unsigned x; volatile LAS unsigned* st; };
__device__ __forceinline__ XcdBarrier xcd_barrier_post(unsigned* bar, volatile LAS unsigned* st) {
    XcdBarrier b; b.bar = bar; b.x = xb_xcc_id(); b.st = st;
    if (threadIdx.x == 0) (void)xb_add(&bar[XB_XCNT(b.x)], 1u);
    return b;
}
__device__ __forceinline__ void xcd_barrier_complete(unsigned* bar, unsigned x, unsigned& nloc, unsigned& nx) {
    const unsigned G = gridDim.x * gridDim.y * gridDim.z;
    unsigned sum, cnt, mine, sp = 0u;
    for (;;) {
        sum = 0u; cnt = 0u; mine = 0u;
#pragma unroll
        for (unsigned j = 0; j < 16; ++j) { const unsigned c = xb_ld(&bar[XB_XCNT(j)]); sum += c; cnt += (c > 0u) ? 1u : 0u; mine = (j == x) ? c : mine; }
        if (sum == G) break;
        __builtin_amdgcn_s_sleep(1);
        if ((++sp & 255u) == 0u) { if (xb_ld(&bar[XB_TMO])) break; if (sp > XB_SPIN_CAP) { atomicAdd(&bar[XB_TMO], 1u); break; } }
    }
    nloc = mine > 0u ? mine : 1u; nx = cnt > 0u ? cnt : 1u;
}
__device__ __forceinline__ void xcd_barrier(const XcdBarrier& b) {
    asm volatile("s_waitcnt vmcnt(0)" ::: "memory");
    __syncthreads();
    if (threadIdx.x == 0) {
        unsigned* bar = b.bar;
        __builtin_amdgcn_s_waitcnt(0);
        unsigned nloc = b.st[0], nx = b.st[1];
        if (nloc == 0u) { xcd_barrier_complete(bar, b.x, nloc, nx); b.st[0] = nloc; b.st[1] = nx; }
        const unsigned old = xb_add(&bar[XB_XSUB(b.x)], 1u);
        const unsigned gen = old / nloc;
        if (old + 1u == (gen + 1u) * nloc) {
            __builtin_amdgcn_fence(__ATOMIC_RELEASE, "agent");
            asm volatile("s_waitcnt vmcnt(0)" ::: "memory");
            const unsigned og = xb_add(&bar[XB_TOP], 1u);
            const unsigned tg = og / nx;
            if (og + 1u == (tg + 1u) * nx) xb_add(&bar[XB_TOPGEN], 1u);
            else XB_SPIN(xb_ld(&bar[XB_TOPGEN]) == tg, bar);
            __builtin_amdgcn_fence(__ATOMIC_ACQUIRE, "agent");
            xb_add(&bar[XB_XGEN(b.x)], 1u);
            asm volatile("s_waitcnt vmcnt(0)" ::: "memory");
        } else {
            XB_SPIN(xb_ld(&bar[XB_XGEN(b.x)]) == gen, bar);
            __builtin_amdgcn_fence(__ATOMIC_ACQUIRE, "agent");
            asm volatile("s_waitcnt vmcnt(0)" ::: "memory");
        }
    }
    __syncthreads();
}

__device__ __forceinline__ void proj_even_extras(int row, int col, const f32x4 v, bf16_t* kvb, _Float16* kih, float* out, int eidx) {
    size_t ooff; int width, oc;
    if (col < EV) { ooff = O_KP; width = 128; oc = col - EK; } else if (col < EKI) { ooff = O_VP; width = 128; oc = col - EV; } else { ooff = O_KIP; width = 64; oc = col - EKI; }
    if (col < EKI) { u32x2 w; w.x = cvt_pk_bf16(v[0], v[1]); w.y = cvt_pk_bf16(v[2], v[3]); *(u32x2*)(kvb + (size_t)row * 256 + (col - EK)) = w; }
    else { f16x4 h; h[0] = (_Float16)v[0]; h[1] = (_Float16)v[1]; h[2] = (_Float16)v[2]; h[3] = (_Float16)v[3]; *(f16x4*)(kih + (size_t)row * 64 + (col - EKI)) = h; }
    if (row < ROW_META) *(f32x4*)(out + ooff + ((size_t)(eidx * NBATCH + (row >> 11)) * LP + NMETA + (row & 2047)) * width + oc) = v;
    else if (row < ROW_SAMP) { for (int bb = 0; bb < NBATCH; ++bb) *(f32x4*)(out + ooff + ((size_t)(eidx * NBATCH + bb) * LP + (row - ROW_META)) * width + oc) = v; }
    else if (row < MREAL) { const size_t so = col < EV ? O_KS : col < EKI ? O_VS : O_KIS; *(f32x4*)(out + so + ((size_t)eidx * DBATCH * DSEQ + (row - ROW_SAMP)) * width + oc) = v; }
}

namespace pg8 {
constexpr int BM = 256, BK = 64, HALF = 128, HTB = HALF * BK * 2, STAGE_BYTES = 8 * HTB, NXCD = 8, WGM = 8;
__host__ __device__ __forceinline__ int lds_byte(int r, int c) { const int st = (r >> 4) * 2 + (c >> 5), rr = r & 15, cc = c & 31, ob = rr * 64 + cc * 2; return st * 1024 + (ob ^ (((ob >> 9) & 1) << 5)); }
__host__ __device__ __forceinline__ void stage_rc(int b, int& R, int& C) { const int st = b / 1024, sb = b % 1024, swz = sb ^ (((sb >> 9) & 1) << 5); R = (st >> 1) * 16 + swz / 64; C = (st & 1) * 32 + (swz % 64) / 2; }
__host__ __device__ __forceinline__ int perm32(int rho) { const int n = rho >> 4, i = rho & 15; return 8 * (i >> 2) + 4 * n + (i & 3); }
struct Unit { int pm, pn; };
struct Gemm { const bf16_t* A; const bf16_t* Bt; int M, N, K; };
struct StaticOrder {
    int nM, nN, nwg, G, c;
    __host__ __device__ void init(int M, int N, int G_, int c_) { nM = M / BM; nN = N / BM; nwg = nM * nN; G = G_; c = c_; }
    __host__ __device__ bool next(int i, Unit& u) const {
        const long L = (long)i * G + c; if (L >= nwg) return false;
        int wgid = (int)L; { const int q = nwg / NXCD, r = nwg % NXCD, xcd = wgid % NXCD, off = wgid / NXCD; wgid = (xcd < r ? xcd * (q + 1) : r * (q + 1) + (xcd - r) * q) + off; }
        const int nig = WGM * nN, gid = wgid / nig, fm = gid * WGM, gsz = (nM - fm) < WGM ? (nM - fm) : WGM;
        u.pm = fm + ((wgid % nig) % gsz); u.pn = (wgid % nig) / gsz; return true;
    }
    __device__ __forceinline__ void a_ready(const Unit&) const {}
    __device__ __forceinline__ void done(const Unit&) const {}
};

struct EpiProj {
    static constexpr bool PERM = true, AFTER_DRAIN = false;
    float* C; int ldc; const float* ss; int even; bf16_t* kvb; _Float16* kih; float* out; int eidx; const LAS float* rsl; int pm0; bf16_t* qb16; _Float16* qih;
    __device__ __forceinline__ void operator()(const f32x4 (&acc)[2][2][4][2], const Unit& u, int wr, int wc, int fr, int fq) const {
        const int row0 = u.pm * BM + wr * 64 + fr, col0 = u.pn * BM + wc * 32 + 8 * fq;
#pragma unroll
        for (int ai = 0; ai < 2; ++ai)
#pragma unroll
            for (int m = 0; m < 4; ++m) {
                const int row = row0 + ai * HALF + m * 16;
                const float rs = u.pm == pm0 ? rsl[row - pm0 * BM] : row_rstd(ss, row);
#pragma unroll
                for (int bj = 0; bj < 2; ++bj) {
                    const f32x4 v0 = acc[ai][bj][m][0] * rs, v1 = acc[ai][bj][m][1] * rs;
                    const int col = col0 + bj * HALF;
                    if (!even) { u32x4 w; w.x = cvt_pk_bf16(v0[0], v0[1]); w.y = cvt_pk_bf16(v0[2], v0[3]); w.z = cvt_pk_bf16(v1[0], v1[1]); w.w = cvt_pk_bf16(v1[2], v1[3]); *(u32x4*)((bf16_t*)C + (size_t)row * PLB + col) = w; }
                    else if (col < EQI) { u32x4 w; w.x = cvt_pk_bf16(v0[0], v0[1]); w.y = cvt_pk_bf16(v0[2], v0[3]); w.z = cvt_pk_bf16(v1[0], v1[1]); w.w = cvt_pk_bf16(v1[2], v1[3]); *(u32x4*)(qb16 + (size_t)row * 512 + col) = w; }
                    else if (col < EU) { f16x8 h; h[0] = (_Float16)v0[0]; h[1] = (_Float16)v0[1]; h[2] = (_Float16)v0[2]; h[3] = (_Float16)v0[3]; h[4] = (_Float16)v1[0]; h[5] = (_Float16)v1[1]; h[6] = (_Float16)v1[2]; h[7] = (_Float16)v1[3];
                        *(f16x8*)(qih + (size_t)row * 512 + (col - EQI)) = h; }
                    else {
                        float* rowp = C + (size_t)row * ldc + col;
                        *(f32x4*)rowp = v0; *(f32x4*)(rowp + 4) = v1;
                        if (col >= EK && col < EKI + 64) { proj_even_extras(row, col, v0, kvb, kih, out, eidx); proj_even_extras(row, col + 4, v1, kvb, kih, out, eidx); }
                    }
                }
            }
    }
};
struct EpiRes {
    static constexpr bool PERM = true, AFTER_DRAIN = false;
    bf16_t* XB; float* ssn; const float* Xf32;
    __device__ __forceinline__ void operator()(const f32x4 (&acc)[2][2][4][2], const Unit& u, int wr, int wc, int fr, int fq) const {
        const int row0 = u.pm * BM + wr * 64 + fr, col0 = u.pn * BM + wc * 32 + 8 * fq;
#pragma unroll
        for (int ai = 0; ai < 2; ++ai) {
            f32x4 xv[4][2][2];
            if (Xf32) {
#pragma unroll
                for (int m = 0; m < 4; ++m) { const float* rowp = Xf32 + (size_t)(row0 + ai * HALF + m * 16) * DM + col0;
#pragma unroll
                    for (int bj = 0; bj < 2; ++bj) { xv[m][bj][0] = *(const f32x4*)(rowp + bj * HALF); xv[m][bj][1] = *(const f32x4*)(rowp + bj * HALF + 4); } }
            } else {
                u32x4 xb[4][2];
#pragma unroll
                for (int m = 0; m < 4; ++m) { const bf16_t* rowb = XB + (size_t)(row0 + ai * HALF + m * 16) * DM + col0;
#pragma unroll
                    for (int bj = 0; bj < 2; ++bj) xb[m][bj] = *(const u32x4*)(rowb + bj * HALF); }
#pragma unroll
                for (int m = 0; m < 4; ++m)
#pragma unroll
                    for (int bj = 0; bj < 2; ++bj) { xv[m][bj][0] = (f32x4){bf_lo(xb[m][bj].x), bf_hi(xb[m][bj].x), bf_lo(xb[m][bj].y), bf_hi(xb[m][bj].y)};
                                                     xv[m][bj][1] = (f32x4){bf_lo(xb[m][bj].z), bf_hi(xb[m][bj].z), bf_lo(xb[m][bj].w), bf_hi(xb[m][bj].w)}; }
            }
#pragma unroll
            for (int m = 0; m < 4; ++m) {
                const int row = row0 + ai * HALF + m * 16;
                bf16_t* rowb = XB + (size_t)row * DM + col0;
                float sq = 0.f;
#pragma unroll
                for (int bj = 0; bj < 2; ++bj) {
                    const f32x4 x0 = xv[m][bj][0] + acc[ai][bj][m][0], x1 = xv[m][bj][1] + acc[ai][bj][m][1];
                    u32x4 w; w.x = cvt_pk_bf16(x0[0], x0[1]); w.y = cvt_pk_bf16(x0[2], x0[3]); w.z = cvt_pk_bf16(x1[0], x1[1]); w.w = cvt_pk_bf16(x1[2], x1[3]);
                    *(u32x4*)(rowb + bj * HALF) = w;
                    const float r0 = bf_lo(w.x), r1 = bf_hi(w.x), r2 = bf_lo(w.y), r3 = bf_hi(w.y), r4 = bf_lo(w.z), r5 = bf_hi(w.z), r6 = bf_lo(w.w), r7 = bf_hi(w.w);
                    sq += ((r0 * r0 + r1 * r1) + (r2 * r2 + r3 * r3)) + ((r4 * r4 + r5 * r5) + (r6 * r6 + r7 * r7));
                }
                sq += __shfl_xor(sq, 16); sq += __shfl_xor(sq, 32);
                if (fq == 0) ssn[(size_t)row * 16 + u.pn * 4 + wc] = sq;
            }
        }
    }
};
struct EpiGU {
    static constexpr bool PERM = true, AFTER_DRAIN = false;
    bf16_t* H; const float* ss; const LAS float* rsl; int pm0;
    __device__ __forceinline__ void operator()(const f32x4 (&acc)[2][2][4][2], const Unit& u, int wr, int wc, int fr, int fq) const {
        const int row0 = u.pm * BM + wr * 64 + fr, col0 = u.pn * HALF + wc * 32 + 8 * fq;
#pragma unroll
        for (int ai = 0; ai < 2; ++ai)
#pragma unroll
            for (int m = 0; m < 4; ++m) {
                const int row = row0 + ai * HALF + m * 16;
                const float rs = u.pm == pm0 ? rsl[row - pm0 * BM] : row_rstd(ss, row);
                float h[8];
#pragma unroll
                for (int n = 0; n < 2; ++n)
#pragma unroll
                    for (int i = 0; i < 4; ++i) { const float g = acc[ai][0][m][n][i] * rs, uu = acc[ai][1][m][n][i] * rs; h[n * 4 + i] = silu_f(g) * uu; }
                u32x4 w; w.x = cvt_pk_bf16(h[0], h[1]); w.y = cvt_pk_bf16(h[2], h[3]); w.z = cvt_pk_bf16(h[4], h[5]); w.w = cvt_pk_bf16(h[6], h[7]);
                *(u32x4*)(H + (size_t)row * DFF + col0) = w;
            }
    }
};

template <class Epi, class Sched>
__device__ __forceinline__ void gemm_phase(LAS unsigned char* lds, const Gemm g, const Sched& S, const Epi& E, const int tid) {
    const int wid = __builtin_amdgcn_readfirstlane(tid >> 6), lane = tid & 63, wr = wid >> 2, wc = wid & 3, fr = lane & 15, fq = lane >> 4;
    const int K = g.K, nt = K / BK;
    unsigned voffA[2], voffB[2];
#pragma unroll
    for (int i = 0; i < 2; ++i) { int R, C; stage_rc(tid * 16 + i * 8192, R, C); const int Rb = Epi::PERM ? ((R & ~31) + perm32(R & 31)) : R;
        voffA[i] = (unsigned)(R * K + C) * 2u; voffB[i] = (unsigned)(Rb * K + C) * 2u; }
    const size_t kstep = (size_t)(BK * 2);
    const size_t hstep = (size_t)HALF * K * 2;
    const size_t tstep = 2 * hstep;
    const unsigned ldsw = (unsigned)wid * 1024u;
    const int aoff = lds_byte(wr * 64 + fr, fq * 8), boff = lds_byte(wc * 32 + fr, fq * 8);
#define PG8_SA(b, h) (((b) * 2 + (h)) * HTB)
#define PG8_SB(b, h) ((4 + (b) * 2 + (h)) * HTB)
#define PG8_STAGE(bufoff, gbase, voff) do { _Pragma("unroll") for (int _i = 0; _i < 2; ++_i) \
        __builtin_amdgcn_global_load_lds((const unsigned*)((const char*)(gbase) + (voff)[_i]), (LAS unsigned*)(lds + (bufoff) + ldsw + _i * 8192), 16, 0, 0); } while (0)
#define PG8_LDA(dst, b, h) do { _Pragma("unroll") for (int m = 0; m < 4; ++m) _Pragma("unroll") for (int k = 0; k < 2; ++k) dst[m][k] = *(const LAS bf16x8*)(lds + PG8_SA(b, h) + aoff + m * 2048 + k * 1024); } while (0)
#define PG8_LDB(dst, b, h) do { _Pragma("unroll") for (int n = 0; n < 2; ++n) _Pragma("unroll") for (int k = 0; k < 2; ++k) dst[n][k] = *(const LAS bf16x8*)(lds + PG8_SB(b, h) + boff + n * 2048 + k * 1024); } while (0)
#define PG8_MMA(ai, bj, At, Bt) do { __builtin_amdgcn_s_setprio(1); _Pragma("unroll") for (int m = 0; m < 4; ++m) _Pragma("unroll") for (int n = 0; n < 2; ++n) _Pragma("unroll") for (int k = 0; k < 2; ++k) \
        acc[ai][bj][m][n] = __builtin_amdgcn_mfma_f32_16x16x32_bf16(Bt[n][k], At[m][k], acc[ai][bj][m][n], 0, 0, 0); __builtin_amdgcn_s_setprio(0); } while (0)
#define PG8_WAIT_V(n) asm volatile("s_waitcnt vmcnt(" #n ")" ::: "memory")
#define PG8_WAIT_L(n) asm volatile("s_waitcnt lgkmcnt(" #n ")" ::: "memory")
#define PG8_BAR __builtin_amdgcn_s_barrier()
#define PG8_SCHED __builtin_amdgcn_sched_barrier(0)
    Unit cur, nxt; int ui = 0;
    if (!S.next(0, cur)) return;
    f32x4 acc[2][2][4][2];
#pragma unroll
    for (int a = 0; a < 2; ++a)
#pragma unroll
        for (int b = 0; b < 2; ++b)
#pragma unroll
            for (int m = 0; m < 4; ++m)
#pragma unroll
                for (int n = 0; n < 2; ++n) acc[a][b][m][n] = (f32x4){0.f, 0.f, 0.f, 0.f};
    bf16x8 At[4][2], B0[2][2], B1[2][2];
    const char* cA = (const char*)g.A + (size_t)cur.pm * tstep; const char* cB = (const char*)g.Bt + (size_t)cur.pn * tstep;
    S.a_ready(cur);
    PG8_STAGE(PG8_SB(0, 0), cB, voffB); PG8_STAGE(PG8_SA(0, 0), cA, voffA); PG8_STAGE(PG8_SB(0, 1), cB + hstep, voffB); PG8_STAGE(PG8_SA(0, 1), cA + hstep, voffA);
    if (wr == 1) PG8_BAR;
    PG8_WAIT_V(4); PG8_BAR;
    PG8_STAGE(PG8_SB(1, 0), cB + kstep, voffB); PG8_STAGE(PG8_SA(1, 0), cA + kstep, voffA); PG8_STAGE(PG8_SB(1, 1), cB + hstep + kstep, voffB);
    PG8_WAIT_V(6); PG8_BAR;
    for (;;) {
        const bool has_next = S.next(ui + 1, nxt);
        const char* nA = has_next ? (const char*)g.A + (size_t)nxt.pm * tstep : cA; const char* nB = has_next ? (const char*)g.Bt + (size_t)nxt.pn * tstep : cB;
        for (int t = 0; t < nt; t += 2) {
            const bool last = (t == nt - 2);
            const char* a1 = cA + (size_t)(t + 1) * kstep;
            const char* a2 = last ? nA : cA + (size_t)(t + 2) * kstep; const char* b2 = last ? nB : cB + (size_t)(t + 2) * kstep;
            const char* a3 = a2 + kstep; const char* b3 = b2 + kstep;
            if (last && has_next) S.a_ready(nxt);
            PG8_LDB(B0, 0, 0); PG8_SCHED; PG8_LDA(At, 0, 0); PG8_STAGE(PG8_SA(1, 1), a1 + hstep, voffA);
            PG8_WAIT_L(8); PG8_BAR; PG8_WAIT_L(0); PG8_MMA(0, 0, At, B0); PG8_BAR; PG8_SCHED;
            PG8_LDB(B1, 0, 1); PG8_STAGE(PG8_SB(0, 0), b2, voffB);
            PG8_BAR; PG8_WAIT_L(0); PG8_MMA(0, 1, At, B1); PG8_BAR;
            PG8_LDA(At, 0, 1); PG8_STAGE(PG8_SA(0, 0), a2, voffA);
            PG8_BAR; PG8_WAIT_L(0); PG8_MMA(1, 0, At, B0); PG8_BAR; PG8_SCHED;
            PG8_STAGE(PG8_SB(0, 1), b2 + hstep, voffB);
            PG8_WAIT_V(6); PG8_BAR; PG8_MMA(1, 1, At, B1); PG8_BAR;
            PG8_LDB(B0, 1, 0); PG8_SCHED; PG8_LDA(At, 1, 0); PG8_STAGE(PG8_SA(0, 1), a2 + hstep, voffA);
            PG8_WAIT_L(8); PG8_BAR; PG8_WAIT_L(0); PG8_MMA(0, 0, At, B0); PG8_BAR; PG8_SCHED;
            PG8_LDB(B1, 1, 1); PG8_STAGE(PG8_SB(1, 0), b3, voffB);
            PG8_BAR; PG8_WAIT_L(0); PG8_MMA(0, 1, At, B1); PG8_BAR;
            PG8_LDA(At, 1, 1); PG8_STAGE(PG8_SA(1, 0), a3, voffA);
            PG8_BAR; PG8_WAIT_L(0); PG8_MMA(1, 0, At, B0); PG8_BAR; PG8_SCHED;
            PG8_STAGE(PG8_SB(1, 1), b3 + hstep, voffB);
            PG8_WAIT_V(6); PG8_BAR; PG8_MMA(1, 1, At, B1); PG8_BAR;
        }
        E(acc, cur, wr, wc, fr, fq); S.done(cur);
        if (!has_next) break;
#pragma unroll
        for (int a = 0; a < 2; ++a)
#pragma unroll
            for (int b = 0; b < 2; ++b)
#pragma unroll
                for (int m = 0; m < 4; ++m)
#pragma unroll
                    for (int n = 0; n < 2; ++n) acc[a][b][m][n] = (f32x4){0.f, 0.f, 0.f, 0.f};
        cur = nxt; cA = nA; cB = nB; ++ui;
    }
    PG8_WAIT_V(0);
    if (wr == 0) PG8_BAR;
    PG8_BAR;
#undef PG8_SA
#undef PG8_SB
#undef PG8_STAGE
#undef PG8_LDA
#undef PG8_LDB
#undef PG8_MMA
#undef PG8_WAIT_V
#undef PG8_WAIT_L
#undef PG8_BAR
#undef PG8_SCHED
}
}

struct Args { const float* in[24]; float* out; unsigned char* ws; int ph_lo, ph_hi; };
struct Frame {
    LAS unsigned char* lds;
    int tid, lane, wave, G, blk;
    const float* const* in;
    float* out; unsigned char* ws;
    unsigned* ctl;
};
#define IN_XP 0
#define IN_XS 1
#define IN_CK 2
#define IN_CV 3
#define IN_CKI 4
#define IN_SPOOL 5
#define IN_SGLA 6
#define IN_PT 7
#define IN_META 8
#define IN_NMIX 9
#define IN_NFFN 10
#define IN_NFIN 11
#define IN_WINE 12
#define IN_WOUTE 13
#define IN_POOLW 14
#define IN_POOLS 15
#define IN_WINO 16
#define IN_WGATE 17
#define IN_BGATE 18
#define IN_GNORM 19
#define IN_WOUTO 20
#define IN_FG 21
#define IN_FU 22
#define IN_FD 23

constexpr int TR0 = 16384, NTM = 10, TROWS = 160;
constexpr int SKL_PART = 0, SKL_GATE = 81920, SKL_RS = SKL_GATE + 10240, SKL_SQ = SKL_RS + 640, SKL_END = SKL_SQ + 2560;
static_assert(SKL_END <= LDS_MISC, "skinny lds");
enum { SKM_PROJ = 0, SKM_RES = 1, SKM_GU = 2 };
struct SkinnyEpi { float* C; int ldc; int even; bf16_t* kvb; _Float16* kih; float* out; int eidx; bf16_t* qb16; _Float16* qih;
                   bf16_t* XB; float* sst_next;
                   bf16_t* H; };
__device__ __forceinline__ void skinny_rstd_to_lds(const float* sst, LAS float* rs_l, int tid) {
    if (tid < TROWS) {
        const float* p = sst + (size_t)tid * 64; float s = 0.f;
#pragma unroll
        for (int i = 0; i < 16; ++i) { const f32x4 a = *(const f32x4*)(p + 4 * i); s += (a[0] + a[1]) + (a[2] + a[3]); }
        rs_l[tid] = rsqrtf(s * (1.f / DM) + EPS);
    }
}
template <int MT, int NS>
__device__ __forceinline__ void skinny_load(const bf16_t* ap, const bf16_t* bp, int K, const int (&n0)[NS], int ks, bf16x8 (&Af)[MT], bf16x8 (&Bf)[NS]) {
#pragma unroll
    for (int ns = 0; ns < NS; ++ns) Bf[ns] = *(const bf16x8*)(bp + (size_t)n0[ns] * K + 32 * ks);
#pragma unroll
    for (int mt = 0; mt < MT; ++mt) Af[mt] = *(const bf16x8*)(ap + (size_t)(16 * mt) * K + 32 * ks);
}
template <int MT, int NS>
__device__ __forceinline__ void skinny_mma(const bf16x8 (&Af)[MT], const bf16x8 (&Bf)[NS], f32x4 (&acc)[MT][NS]) {
#pragma unroll
    for (int mt = 0; mt < MT; ++mt)
#pragma unroll
        for (int ns = 0; ns < NS; ++ns) acc[mt][ns] = __builtin_amdgcn_mfma_f32_16x16x32_bf16(Bf[ns], Af[mt], acc[mt][ns], 0, 0, 0);
}
template <int MT, int NS>
__device__ __forceinline__ void skinny_kloop(const bf16_t* A, const bf16_t* Bt, int K, int mt0, const int (&n0)[NS], int ks0, int ks1, int lane, f32x4 (&acc)[MT][NS]) {
    const int fr = lane & 15, fq = lane >> 4;
    const bf16_t* ap = A + (size_t)(TR0 + 16 * mt0 + fr) * K + 8 * fq; const bf16_t* bp = Bt + (size_t)fr * K + 8 * fq;
    bf16x8 A0[MT], B0[NS], A1[MT], B1[NS];
    skinny_load<MT, NS>(ap, bp, K, n0, ks0, A0, B0);
    for (int ks = ks0; ks < ks1; ks += 2) {
        skinny_load<MT, NS>(ap, bp, K, n0, ks + 1 < ks1 ? ks + 1 : ks, A1, B1);
        skinny_mma<MT, NS>(A0, B0, acc);
        skinny_load<MT, NS>(ap, bp, K, n0, ks + 2 < ks1 ? ks + 2 : ks, A0, B0);
        if (ks + 1 < ks1) skinny_mma<MT, NS>(A1, B1, acc);
    }
}
template <int MODE, int MT, int NS>
__device__ __forceinline__ void skinny_phase(Frame& F, const bf16_t* A, const bf16_t* Bt, int K, int nslices, const float* sst_in, const SkinnyEpi& E, int wg0 = 0) {
    static_assert(NTM % MT == 0 && MT * 64 <= 512 && 8 * MT * NS * 1024 <= SKL_GATE, "skinny tile");
    const int tid = F.tid, lane = F.lane, w = F.wave;
    LAS float* part = (LAS float*)(F.lds + SKL_PART); LAS float* rs_l = (LAS float*)(F.lds + SKL_RS); LAS float* sq_l = (LAS float*)(F.lds + SKL_SQ);
    __syncthreads();
    if (MODE != SKM_RES) skinny_rstd_to_lds(sst_in, rs_l, tid);
    const int ksteps = K / 32, kw = ksteps / 8, ks0 = w * kw, ks1 = ks0 + kw;
    constexpr int NMG = NTM / MT;
    const int nng = MODE == SKM_GU ? nslices : (nslices + NS - 1) / NS, nunits = nng * NMG;
    for (int u = F.blk - wg0; u >= 0 && u < nunits; u += F.G - wg0) {
        const int mg = u % NMG, ng = u / NMG, mt0 = mg * MT;
        int n0[NS]; int sl[NS];
#pragma unroll
        for (int ns = 0; ns < NS; ++ns) {
            if (MODE == SKM_GU) { sl[ns] = ng; n0[ns] = 256 * (ng >> 3) + 16 * (ng & 7) + 128 * ns; }
            else { const int sraw = ng * NS + ns; sl[ns] = sraw < nslices ? sraw : nslices - 1; n0[ns] = 16 * sl[ns]; }
        }
        f32x4 acc[MT][NS];
#pragma unroll
        for (int mt = 0; mt < MT; ++mt)
#pragma unroll
            for (int ns = 0; ns < NS; ++ns) acc[mt][ns] = (f32x4){0.f, 0.f, 0.f, 0.f};
        skinny_kloop<MT, NS>(A, Bt, K, mt0, n0, ks0, ks1, lane, acc);
        __syncthreads();
#pragma unroll
        for (int mt = 0; mt < MT; ++mt)
#pragma unroll
            for (int ns = 0; ns < NS; ++ns) *(LAS f32x4*)(part + (((w * MT + mt) * NS + ns) * 64 + lane) * 4) = acc[mt][ns];
        __syncthreads();
        if (tid < MT * 64) {
            const int mt = tid >> 6, ln = tid & 63, fr = ln & 15, fq = ln >> 4, trow = 16 * (mt0 + mt) + fr, row = TR0 + trow;
            f32x4 red[NS];
#pragma unroll
            for (int ns = 0; ns < NS; ++ns) {
                f32x4 sum = *(const LAS f32x4*)(part + (((0 * MT + mt) * NS + ns) * 64 + ln) * 4);
#pragma unroll
                for (int ww = 1; ww < 8; ++ww) sum += *(const LAS f32x4*)(part + (((ww * MT + mt) * NS + ns) * 64 + ln) * 4);
                red[ns] = sum;
            }
            if (MODE == SKM_PROJ) {
                const float rs = rs_l[trow];
#pragma unroll
                for (int ns = 0; ns < NS; ++ns) {
                    const int col = 16 * sl[ns] + 4 * fq; const f32x4 v = red[ns] * rs;
                    if (!E.even) { u32x2 wv; wv.x = cvt_pk_bf16(v[0], v[1]); wv.y = cvt_pk_bf16(v[2], v[3]); *(u32x2*)((bf16_t*)E.C + (size_t)row * PLB + col) = wv; }
                    else if (col < EQI) { u32x2 wv; wv.x = cvt_pk_bf16(v[0], v[1]); wv.y = cvt_pk_bf16(v[2], v[3]); *(u32x2*)(E.qb16 + (size_t)row * 512 + col) = wv; }
                    else if (col < EU) { f16x4 hq; hq[0] = (_Float16)v[0]; hq[1] = (_Float16)v[1]; hq[2] = (_Float16)v[2]; hq[3] = (_Float16)v[3]; *(f16x4*)(E.qih + (size_t)row * 512 + (col - EQI)) = hq; }
                    else *(f32x4*)(E.C + (size_t)row * E.ldc + col) = v;
                    if (E.even && col >= EK && col < EKI + 64) proj_even_extras(row, col, v, E.kvb, E.kih, E.out, E.eidx);
                }
            } else if (MODE == SKM_RES) {
#pragma unroll
                for (int ns = 0; ns < NS; ++ns) {
                    const int col = 16 * sl[ns] + 4 * fq;
                    const bool dup = (ng * NS + ns) >= nslices;
                    if (!dup) {
                        const u32x2 xb = *(const u32x2*)(E.XB + (size_t)row * DM + col);
                        const f32x4 x = (f32x4){bf_lo(xb.x), bf_hi(xb.x), bf_lo(xb.y), bf_hi(xb.y)} + red[ns];
                        u32x2 wv; wv.x = cvt_pk_bf16(x[0], x[1]); wv.y = cvt_pk_bf16(x[2], x[3]); *(u32x2*)(E.XB + (size_t)row * DM + col) = wv;
                        const float r0 = bf_lo(wv.x), r1 = bf_hi(wv.x), r2 = bf_lo(wv.y), r3 = bf_hi(wv.y);
                        sq_l[(ns * MT * 16 + mt * 16 + fr) * 4 + fq] = (r0 * r0 + r1 * r1) + (r2 * r2 + r3 * r3);
                    }
                }
            } else {
                const float rs = rs_l[trow]; const f32x4 g = red[0] * rs, uu = red[NS - 1] * rs;
                u32x2 wv; wv.x = cvt_pk_bf16(silu_f(g[0]) * uu[0], silu_f(g[1]) * uu[1]); wv.y = cvt_pk_bf16(silu_f(g[2]) * uu[2], silu_f(g[3]) * uu[3]);
                *(u32x2*)(E.H + (size_t)row * DFF + 16 * ng + 4 * fq) = wv;
            }
        }
        if (MODE == SKM_RES) {
            __syncthreads();
            if (tid < NS * MT * 16) {
                const int ns = tid / (MT * 16), r = tid % (MT * 16), sraw = ng * NS + ns;
                if (sraw < nslices) E.sst_next[(size_t)(16 * mt0 + r) * 64 + sraw] = (sq_l[tid * 4] + sq_l[tid * 4 + 1]) + (sq_l[tid * 4 + 2] + sq_l[tid * 4 + 3]);
            }
        }
    }
    __syncthreads();
}

constexpr int LDS_RSL = 131072;
static_assert(LDS_RSL + 1024 <= LDS_MISC, "gemm lds");
__device__ __forceinline__ int panel_rstd_to_lds(Frame& F, const float* ss, int M, int N) {
    pg8::StaticOrder S; S.init(M, N, F.G, F.blk); pg8::Unit u;
    int pm0 = -1;
    if (S.next(0, u)) pm0 = u.pm;
    __syncthreads();
    if (pm0 >= 0 && F.tid < 256) ((LAS float*)(F.lds + LDS_RSL))[F.tid] = row_rstd(ss, pm0 * 256 + F.tid);
    __syncthreads();
    return pm0;
}

__device__ __forceinline__ void tr_item(const float* W, int Nsrc, int c0, int nvalid, bf16_t* dst, int K, int k0, const float* gain, float scale, LAS float* scr, int lane) {
    const int nn = lane & 31, hi = lane >> 5, c = lane & 7;
    const float* wp = W + (size_t)(k0 + hi) * Nsrc + c0 + (nn < nvalid ? nn : 0);
    float v[32];
#pragma unroll
    for (int i = 0; i < 32; ++i) v[i] = wp[(size_t)(2 * i) * Nsrc];
    f32x4 g0 = (f32x4){1.f, 1.f, 1.f, 1.f}, g1 = g0;
    if (gain) { g0 = *(const f32x4*)(gain + k0 + 8 * c); g1 = *(const f32x4*)(gain + k0 + 8 * c + 4); }
    __builtin_amdgcn_sched_barrier(0);
#pragma unroll
    for (int i = 0; i < 32; ++i) scr[(2 * i + hi) * 33 + nn] = nn < nvalid ? v[i] * scale : 0.f;
    asm volatile("s_waitcnt lgkmcnt(0)" ::: "memory");
#pragma unroll
    for (int j = 0; j < 4; ++j) {
        const int n = (lane >> 3) + 8 * j; const LAS float* s = scr + (8 * c) * 33 + n;
        u32x4 o; o.x = cvt_pk_bf16(s[0 * 33] * g0[0], s[1 * 33] * g0[1]); o.y = cvt_pk_bf16(s[2 * 33] * g0[2], s[3 * 33] * g0[3]); o.z = cvt_pk_bf16(s[4 * 33] * g1[0], s[5 * 33] * g1[1]); o.w = cvt_pk_bf16(s[6 * 33] * g1[2], s[7 * 33] * g1[3]);
        *(u32x4*)(dst + (size_t)n * K + k0 + 8 * c) = o;
    }
    asm volatile("s_waitcnt lgkmcnt(0)" ::: "memory");
}

__device__ __forceinline__ void convert_weights(Frame& F, int part, int gw, int NGW, int fb, int nfb) {
    LAS float* scr = (LAS float*)(F.lds + F.wave * 16384);
    const int lane = F.lane;
    unsigned char* ws = F.ws;
    constexpr int I_WINE = (NE / 32) * 16, I_WINO = (NO / 32) * 16, I_WOE = 32 * 8, I_WOO = 32 * 16, I_GU = (NGU / 32) * 16, I_DN = 32 * (DFF / 64);
    constexpr int NITEMS = 2 * I_WINE + 2 * I_WINO + 2 * I_WOE + 2 * I_WOO + 4 * I_GU + 4 * I_DN;
#define CW_WANT(early) (part == 2 || (part == 0) == (early))
    for (int it = gw; it < NITEMS; it += NGW) {
        int r = it;
        if (r < 2 * I_WINE) {
            const int e = r / I_WINE; r %= I_WINE; if (!CW_WANT(e == 0)) continue; const int ch = r / 16, kb = r % 16, n0 = ch * 32;
            int src, nv = 32; float sc = 1.f;
            if (n0 < 512) { src = n0; sc = 0.125f; }
            else if (n0 < 1024) src = 768 + (n0 - 512);
            else if (n0 < 1536) src = 1352 + (n0 - 1024);
            else if (n0 < 1664) src = 512 + (n0 - 1536);
            else if (n0 < 1792) src = 640 + (n0 - 1664);
            else if (n0 < 1856) src = 1280 + (n0 - 1792);
            else if (n0 == 1856) { src = 1344; nv = 8; }
            else { src = 0; nv = 0; }
            tr_item(F.in[IN_WINE] + (size_t)e * DM * EIN, EIN, src, nv, (bf16_t*)(ws + WS_WINE) + ((size_t)e * NE + n0) * DM, DM, kb * 64, F.in[IN_NMIX] + (2 * e) * DM, sc, scr, lane);
            continue;
        }
        r -= 2 * I_WINE;
        if (r < 2 * I_WINO) {
            const int o = r / I_WINO; r %= I_WINO; if (!CW_WANT(o == 0)) continue; const int ch = r / 16, kb = r % 16, n0 = ch * 32;
            int nv = 32; float sc = 1.f;
            if (n0 < 512) sc = 0.08838834764831845f;
            if (n0 == 3072) nv = 16; else if (n0 > 3072) nv = 0;
            tr_item(F.in[IN_WINO] + (size_t)o * DM * OIN, OIN, nv ? n0 : 0, nv, (bf16_t*)(ws + WS_WINO) + ((size_t)o * NO + n0) * DM, DM, kb * 64, F.in[IN_NMIX] + (2 * o + 1) * DM, sc, scr, lane);
            continue;
        }
        r -= 2 * I_WINO;
        if (r < 2 * I_WOE) {
            const int e = r / I_WOE; r %= I_WOE; if (!CW_WANT(e == 0)) continue; const int ch = r / 8, kb = r % 8, n0 = ch * 32;
            tr_item(F.in[IN_WOUTE] + (size_t)e * DM * DM, DM, n0, 32, (bf16_t*)(ws + WS_WOUTE) + ((size_t)e * DM + n0) * DM, DM, kb * 64, nullptr, 1.f, scr, lane);
            continue;
        }
        r -= 2 * I_WOE;
        if (r < 2 * I_WOO) {
            const int o = r / I_WOO; r %= I_WOO; if (!CW_WANT(false)) continue; const int ch = r / 16, kb = r % 16, n0 = ch * 32;
            tr_item(F.in[IN_WOUTO] + (size_t)o * DM * DM, DM, n0, 32, (bf16_t*)(ws + WS_WOUTO) + ((size_t)o * DM + n0) * DM, DM, kb * 64, nullptr, 1.f, scr, lane);
            continue;
        }
        r -= 2 * I_WOO;
        if (r < 4 * I_GU) {
            const int l = r / I_GU; r %= I_GU; if (!CW_WANT(l == 0)) continue; const int ch = r / 16, kb = r % 16, n0 = ch * 32, tile = n0 >> 8, within = n0 & 255;
            const float* W = (within < 128 ? F.in[IN_FG] : F.in[IN_FU]) + (size_t)l * DM * DFF;
            tr_item(W, DFF, tile * 128 + (within & 127), 32, (bf16_t*)(ws + WS_WGU) + ((size_t)l * NGU + n0) * DM, DM, kb * 64, F.in[IN_NFFN] + l * DM, 1.f, scr, lane);
            continue;
        }
        r -= 4 * I_GU;
        {
            const int l = r / I_DN; r %= I_DN; if (!CW_WANT(l == 0)) continue; const int ch = r / (DFF / 64), kb = r % (DFF / 64), n0 = ch * 32;
            tr_item(F.in[IN_FD] + (size_t)l * DFF * DM, DM, n0, 32, (bf16_t*)(ws + WS_WDN) + ((size_t)l * DM + n0) * DFF, DFF, kb * 64, nullptr, 1.f, scr, lane);
        }
    }
    LAS float* pwl = (LAS float*)(F.lds + 131072); LAS float* psl = pwl + 1024;
    for (int it = fb; it < 256; it += nfb) {
        const int e = it >> 7, g = (it >> 5) & 3, cb = (it >> 1) & 15, nb = it & 1, n = nb * 512 + F.tid;
        if (!CW_WANT(e == 0)) continue;
        const float* pw = F.in[IN_POOLW] + ((size_t)(e * 4 + g) * 128 + cb * 8) * 128;
        const float* ps = F.in[IN_POOLS] + e * 512 + g * 128;
        const float* wo = F.in[IN_WOUTE] + ((size_t)e * DM + 512 + g * 128) * DM + n;
        __syncthreads();
        pwl[F.tid] = pw[F.tid]; pwl[512 + F.tid] = pw[512 + F.tid]; if (F.tid < 128) psl[F.tid] = ps[F.tid];
        __syncthreads();
        float a[8];
#pragma unroll
        for (int c = 0; c < 8; ++c) a[c] = 0.f;
#pragma unroll 1
        for (int j0 = 0; j0 < 128; j0 += 32) {
            float wv[32];
#pragma unroll
            for (int jj = 0; jj < 32; ++jj) wv[jj] = wo[(size_t)(j0 + jj) * DM];
            __builtin_amdgcn_sched_barrier(0);
#pragma unroll
            for (int jj = 0; jj < 32; ++jj) {
                const float x = wv[jj] * psl[j0 + jj];
#pragma unroll
                for (int c = 0; c < 8; ++c) a[c] += pwl[c * 128 + j0 + jj] * x;
            }
        }
        u32x4 o; o.x = cvt_pk_bf16(a[0], a[1]); o.y = cvt_pk_bf16(a[2], a[3]); o.z = cvt_pk_bf16(a[4], a[5]); o.w = cvt_pk_bf16(a[6], a[7]);
        *(u32x4*)((bf16_t*)(ws + WS_WOUTE) + ((size_t)e * DM + n) * DM + 512 + g * 128 + cb * 8) = o;
    }
#undef CW_WANT
}
__device__ __forceinline__ void p0_prologue(Frame& F) {
    const int gw = F.blk * 8 + F.wave, NGW = F.G * 8, lane = F.lane;
    unsigned char* ws = F.ws;
    convert_weights(F, F.G > 128 ? 0 : 2, gw, NGW, F.blk, F.G);
    bf16_t* XB = (bf16_t*)(ws + WS_XB); float* ss0 = (float*)(ws + WS_SSP); float* sst0 = (float*)(ws + WS_SST);
    bf16_t* ACT = (bf16_t*)(ws + WS_ACT);
    for (int row0 = gw; row0 < MP; row0 += 4 * NGW) {
        f32x4 v[4][4];
#pragma unroll
        for (int i = 0; i < 4; ++i) {
            const int row = row0 + i * NGW;
            const float* src = nullptr;
            if (row < ROW_META) src = F.in[IN_XP] + (size_t)row * DM;
            else if (row < ROW_SAMP) src = F.in[IN_META] + (size_t)(row - ROW_META) * DM;
            else if (row < MREAL) src = F.in[IN_XS] + (size_t)(row - ROW_SAMP) * DM;
#pragma unroll
            for (int j = 0; j < 4; ++j) { v[i][j] = (f32x4){0.f, 0.f, 0.f, 0.f}; if (src) v[i][j] = *(const f32x4*)(src + 256 * j + 4 * lane); }
        }
        __builtin_amdgcn_sched_barrier(0);
#pragma unroll
        for (int i = 0; i < 4; ++i) {
            const int row = row0 + i * NGW;
            if (row >= MP) continue;
            float sq = 0.f;
#pragma unroll
            for (int j = 0; j < 4; ++j) {
                u32x2 w; w.x = cvt_pk_bf16(v[i][j][0], v[i][j][1]); w.y = cvt_pk_bf16(v[i][j][2], v[i][j][3]);
                *(u32x2*)(XB + (size_t)row * DM + 256 * j + 4 * lane) = w;
                if (row >= MREAL) *(u32x2*)(ACT + (size_t)row * DM + 256 * j + 4 * lane) = (u32x2){0u, 0u};
                sq += (v[i][j][0] * v[i][j][0] + v[i][j][1] * v[i][j][1]) + (v[i][j][2] * v[i][j][2] + v[i][j][3] * v[i][j][3]);
            }
            sq = wave_sum(sq);
            if (row < TR0) { if (lane < 16) ss0[(size_t)row * 16 + lane] = lane == 0 ? sq : 0.f; }
            else if (row < TR0 + TROWS) sst0[(size_t)(row - TR0) * 64 + lane] = lane == 0 ? sq : 0.f;
        }
    }
}

__device__ __forceinline__ unsigned f2key(float s) {
    const _Float16 h = (_Float16)s; const unsigned b = __builtin_bit_cast(unsigned short, h);
    return (b & 0x8000u) ? (~b & 0xffffu) : (b | 0x8000u);
}
template <int NREG>
__device__ __forceinline__ int select_topk(const LAS u16* row, int nvis, LAS u16* list, int lane) {
    if (nvis <= 256) { for (int j = lane; j < nvis; j += 64) list[j] = (u16)j; return nvis; }
    const LAS unsigned* r32 = (const LAS unsigned*)row;
    const int nsteps = (nvis + 127) >> 7;
    unsigned T = 0u; int cgt = 0;
    if constexpr (NREG > 0) {
        unsigned kr[NREG];
#pragma unroll
        for (int s = 0; s < NREG; ++s) kr[s] = s < nsteps ? r32[s * 64 + lane] : 0u;
        for (int bit = 15; bit >= 0; --bit) {
            const unsigned cand = T | (1u << bit), ch = cand << 16;
            int cnt = 0;
#pragma unroll
            for (int s = 0; s < NREG; ++s) cnt += __popcll(__ballot((kr[s] << 16) >= ch)) + __popcll(__ballot(kr[s] >= ch));
            if (cnt >= 256) T = cand;
        }
        { const unsigned ch = (T << 16) | 0xffffu;
#pragma unroll
          for (int s = 0; s < NREG; ++s) cgt += __popcll(__ballot(((kr[s] << 16) | 0xffffu) > ch)) + __popcll(__ballot((kr[s] | 0xffffu) > ch)); }
        const int need = 256 - cgt;
        int base = 0, tbase = 0;
#pragma unroll
        for (int s = 0; s < NREG; ++s) {
            const unsigned k2 = kr[s]; const unsigned lo = k2 & 0xffffu, hi = k2 >> 16;
            const bool tl = (lo == T), th = (hi == T);
            const unsigned long long btl = __ballot(tl), bth = __ballot(th);
            const int rl = tbase + (int)mbcnt64(btl) + (int)mbcnt64(bth), rh = rl + (tl ? 1 : 0);
            const bool sl = (lo > T) || (tl && rl < need), sh = (hi > T) || (th && rh < need);
            const unsigned long long bsl = __ballot(sl), bsh = __ballot(sh);
            const int ol = base + (int)mbcnt64(bsl) + (int)mbcnt64(bsh), oh = ol + (sl ? 1 : 0);
            const int pos = 2 * (s * 64 + lane);
            if (sl && ol < 256) list[ol] = (u16)pos;
            if (sh && oh < 256) list[oh] = (u16)(pos + 1);
            base += __popcll(bsl) + __popcll(bsh); tbase += __popcll(btl) + __popcll(bth);
        }
        return base < 256 ? base : 256;
    } else {
        for (int bit = 15; bit >= 0; --bit) {
            const unsigned cand = T | (1u << bit), ch = cand << 16;
            int cnt = 0;
#pragma unroll 5
            for (int s = 0; s < nsteps; ++s) { const unsigned k2 = r32[s * 64 + lane]; cnt += __popcll(__ballot((k2 << 16) >= ch)) + __popcll(__ballot(k2 >= ch)); }
            if (cnt >= 256) T = cand;
        }
#pragma unroll 5
        for (int s = 0; s < nsteps; ++s) { const unsigned k2 = r32[s * 64 + lane]; cgt += __popcll(__ballot((k2 & 0xffffu) > T)) + __popcll(__ballot((k2 >> 16) > T)); }
        const int need = 256 - cgt;
        int base = 0, tbase = 0;
#pragma unroll 5
        for (int s = 0; s < nsteps; ++s) {
            const unsigned k2 = r32[s * 64 + lane]; const unsigned lo = k2 & 0xffffu, hi = k2 >> 16;
            const bool tl = (lo == T), th = (hi == T);
            const unsigned long long btl = __ballot(tl), bth = __ballot(th);
            const int rl = tbase + (int)mbcnt64(btl) + (int)mbcnt64(bth), rh = rl + (tl ? 1 : 0);
            const bool sl = (lo > T) || (tl && rl < need), sh = (hi > T) || (th && rh < need);
            const unsigned long long bsl = __ballot(sl), bsh = __ballot(sh);
            const int ol = base + (int)mbcnt64(bsl) + (int)mbcnt64(bsh), oh = ol + (sl ? 1 : 0);
            const int pos = 2 * (s * 64 + lane);
            if (sl && ol < 256) list[ol] = (u16)pos;
            if (sh && oh < 256) list[oh] = (u16)(pos + 1);
            base += __popcll(bsl) + __popcll(bsh); tbase += __popcll(btl) + __popcll(bth);
        }
        return base < 256 ? base : 256;
    }
}

constexpr int MASK_WORDS = 68;
template <int NREG>
__device__ __forceinline__ void select_mask(const LAS u16* row, int nvis, LAS unsigned* mask, int lane) {
    if (nvis <= 256) {
        for (int j = lane; j < MASK_WORDS; j += 64) mask[j] = (32 * j + 32 <= nvis) ? 0xffffffffu : (32 * j < nvis ? ((1u << (nvis - 32 * j)) - 1u) : 0u);
        return;
    }
    for (int j = lane; j < MASK_WORDS; j += 64) mask[j] = 0u;
    const LAS unsigned* r32 = (const LAS unsigned*)row;
    const int nsteps = (nvis + 127) >> 7;
    unsigned T = 0u; int cgt = 0;
    unsigned kr[NREG];
#pragma unroll
    for (int s = 0; s < NREG; ++s) kr[s] = s < nsteps ? r32[s * 64 + lane] : 0u;
    for (int bit = 15; bit >= 0; --bit) {
        const unsigned cand = T | (1u << bit), ch = cand << 16;
        int cnt = 0;
#pragma unroll
        for (int s = 0; s < NREG; ++s) cnt += __popcll(__ballot((kr[s] << 16) >= ch)) + __popcll(__ballot(kr[s] >= ch));
        if (cnt >= 256) T = cand;
    }
    { const unsigned ch = (T << 16) | 0xffffu;
#pragma unroll
      for (int s = 0; s < NREG; ++s) cgt += __popcll(__ballot(((kr[s] << 16) | 0xffffu) > ch)) + __popcll(__ballot((kr[s] | 0xffffu) > ch)); }
    const int need = 256 - cgt;
    int tbase = 0;
#pragma unroll
    for (int s = 0; s < NREG; ++s) {
        const unsigned k2 = kr[s]; const unsigned lo = k2 & 0xffffu, hi = k2 >> 16;
        const bool tl = (lo == T), th = (hi == T);
        const unsigned long long btl = __ballot(tl), bth = __ballot(th);
        const int rl = tbase + (int)mbcnt64(btl) + (int)mbcnt64(bth), rh = rl + (tl ? 1 : 0);
        const bool sl = (lo > T) || (tl && rl < need), sh = (hi > T) || (th && rh < need);
        const int pos = 2 * (s * 64 + lane);
        const unsigned bits = (sl ? 1u : 0u) | (sh ? 2u : 0u);
        if (bits) (void)__hip_atomic_fetch_or(mask + (pos >> 5), bits << (pos & 31), __ATOMIC_RELAXED, __HIP_MEMORY_SCOPE_WORKGROUP);
        tbase += __popcll(btl) + __popcll(bth);
    }
}

template <int NR>
__device__ __forceinline__ void select_topk_pair(const LAS u16* row, int nvis, LAS u16* list, volatile LAS int* xch, int lane, int w) {
    const int half = w & 1, s0 = NR * half;
    const LAS unsigned* r32 = (const LAS unsigned*)row + s0 * 64 + lane;
    unsigned T = 0u;
    for (int bit = 15; bit >= 0; --bit) {
        const unsigned cand = T | (1u << bit), ch = cand << 16;
        int cnt = 0;
#pragma unroll 11
        for (int s = 0; s < NR; ++s) { const unsigned kv = r32[s * 64]; cnt += __popcll(__ballot((kv << 16) >= ch)) + __popcll(__ballot(kv >= ch)); }
        if (lane == 0) xch[(bit & 1) * 8 + w] = cnt;
        __syncthreads();
        if (cnt + xch[(bit & 1) * 8 + (w ^ 1)] >= 256) T = cand;
    }
    int cgt = 0, cti = 0;
#pragma unroll 11
    for (int s = 0; s < NR; ++s) { const unsigned kv = r32[s * 64]; const unsigned lo = kv & 0xffffu, hi = kv >> 16;
        cgt += __popcll(__ballot(lo > T)) + __popcll(__ballot(hi > T)); cti += __popcll(__ballot(lo == T)) + __popcll(__ballot(hi == T)); }
    if (lane == 0) { xch[16 + 2 * w] = cgt; xch[16 + 2 * w + 1] = cti; }
    __syncthreads();
    const int cgt_p = xch[16 + 2 * (w ^ 1)], cti_p = xch[16 + 2 * (w ^ 1) + 1];
    const int need = 256 - (cgt + cgt_p);
    int base = half ? cgt_p + (cti_p < need ? cti_p : need) : 0, tbase = half ? cti_p : 0;
#pragma unroll 3
    for (int s = 0; s < NR; ++s) {
        const unsigned k2 = r32[s * 64]; const unsigned lo = k2 & 0xffffu, hi = k2 >> 16;
        const bool tl = (lo == T), th = (hi == T);
        const unsigned long long btl = __ballot(tl), bth = __ballot(th);
        const int rl = tbase + (int)mbcnt64(btl) + (int)mbcnt64(bth), rh = rl + (tl ? 1 : 0);
        const bool sl = (lo > T) || (tl && rl < need), sh = (hi > T) || (th && rh < need);
        const unsigned long long bsl = __ballot(sl), bsh = __ballot(sh);
        const int ol = base + (int)mbcnt64(bsl) + (int)mbcnt64(bsh), oh = ol + (sl ? 1 : 0);
        const int pos = 2 * ((s0 + s) * 64 + lane);
        if (sl && ol < 256) list[ol] = (u16)pos;
        if (sh && oh < 256) list[oh] = (u16)(pos + 1);
        base += __popcll(bsl) + __popcll(bsh); tbase += __popcll(btl) + __popcll(bth);
    }
}

struct SrcPrompt {
    const bf16_t* kvb; int b;
    __device__ __forceinline__ void kfrag(int pos, int kq, bf16x8 (&B)[4]) const {
        const bf16_t* p = kvb + (size_t)prow(b, pos) * 256 + 32 * kq;
#pragma unroll
        for (int s = 0; s < 4; ++s) B[s] = *(const bf16x8*)(p + 8 * s);
    }
    typedef unsigned vraw;
    __device__ __forceinline__ vraw vload(int pos, int lane) const { return *(const unsigned*)(kvb + (size_t)prow(b, pos) * 256 + 128 + 2 * lane); }
    __device__ __forceinline__ f32x2 vcvt(vraw u) const { return (f32x2){bf_lo(u), bf_hi(u)}; }
};
struct SrcSample {
    const float* ck; const float* cv; const LAS int* pt; const float* proj; int db;
    __device__ __forceinline__ const float* krow(int pos) const { return pos < PAST ? ck + ((size_t)pt[pos >> 7] * PAGE + (pos & 127)) * 128 : proj + (size_t)(ROW_SAMP + db * DSEQ + (pos - PAST)) * PLD + EK; }
    __device__ __forceinline__ const float* vrow(int pos) const { return pos < PAST ? cv + ((size_t)pt[pos >> 7] * PAGE + (pos & 127)) * 128 : proj + (size_t)(ROW_SAMP + db * DSEQ + (pos - PAST)) * PLD + EV; }
    __device__ __forceinline__ void kfrag(int pos, int kq, bf16x8 (&B)[4]) const {
        const float* p = krow(pos) + 32 * kq;
        f32x4 a[8];
#pragma unroll
        for (int s = 0; s < 8; ++s) a[s] = *(const f32x4*)(p + 4 * s);
#pragma unroll
        for (int s = 0; s < 4; ++s) {
            u32x4 w; w.x = cvt_pk_bf16(a[2 * s][0], a[2 * s][1]); w.y = cvt_pk_bf16(a[2 * s][2], a[2 * s][3]); w.z = cvt_pk_bf16(a[2 * s + 1][0], a[2 * s + 1][1]); w.w = cvt_pk_bf16(a[2 * s + 1][2], a[2 * s + 1][3]);
            B[s] = __builtin_bit_cast(bf16x8, w);
        }
    }
    typedef f32x2 vraw;
    __device__ __forceinline__ vraw vload(int pos, int lane) const { return *(const f32x2*)(vrow(pos) + 2 * lane); }
    __device__ __forceinline__ f32x2 vcvt(vraw u) const { return u; }
};

template <class Src, int QKB>
__device__ __forceinline__ void attn_half(const Src& S, const bf16_t* qb16, int qrow, const LAS u16* list, LAS float* pb, LAS float* stat, int lane, f32x2 (&o)[4]) {
    const int m = lane & 15, kq = lane >> 4;
    bf16x8 A[4];
    {
        const bool valid = (m < 8) && ((kq >> 1) == (m >> 2));
        const bf16_t* qp = qb16 + (size_t)qrow * 512 + (m & 7) * 64 + 32 * (kq & 1);
#pragma unroll
        for (int s = 0; s < 4; ++s) {
            u32x4 w = (u32x4){0u, 0u, 0u, 0u};
            if (valid) w = *(const u32x4*)(qp + 8 * s);
            A[s] = __builtin_bit_cast(bf16x8, w);
        }
    }
    f32x4 lg[8];
#pragma unroll
    for (int tb = 0; tb < 8; tb += QKB) {
        bf16x8 B[QKB][4];
#pragma unroll
        for (int t = 0; t < QKB; ++t) S.kfrag((int)list[16 * (tb + t) + m], kq, B[t]);
#pragma unroll
        for (int t = 0; t < QKB; ++t) {
            f32x4 acc = (f32x4){0.f, 0.f, 0.f, 0.f};
#pragma unroll
            for (int s = 0; s < 4; ++s) acc = __builtin_amdgcn_mfma_f32_16x16x32_bf16(A[s], B[t][s], acc, 0, 0, 0);
            lg[tb + t] = acc;
        }
    }
    f32x4 mx = lg[0];
#pragma unroll
    for (int t = 1; t < 8; ++t) { mx[0] = fmaxf(mx[0], lg[t][0]); mx[1] = fmaxf(mx[1], lg[t][1]); mx[2] = fmaxf(mx[2], lg[t][2]); mx[3] = fmaxf(mx[3], lg[t][3]); }
#pragma unroll
    for (int of = 1; of < 16; of <<= 1) {
#pragma unroll
        for (int r = 0; r < 4; ++r) mx[r] = fmaxf(mx[r], __shfl_xor(mx[r], of));
    }
    f32x4 sm = (f32x4){0.f, 0.f, 0.f, 0.f};
#pragma unroll
    for (int t = 0; t < 8; ++t) {
#pragma unroll
        for (int r = 0; r < 4; ++r) { const float e = __expf(lg[t][r] - mx[r]); lg[t][r] = e; sm[r] += e; }
    }
#pragma unroll
    for (int of = 1; of < 16; of <<= 1) {
#pragma unroll
        for (int r = 0; r < 4; ++r) sm[r] += __shfl_xor(sm[r], of);
    }
    f32x4 inv; inv[0] = 1.f / sm[0]; inv[1] = 1.f / sm[1]; inv[2] = 1.f / sm[2]; inv[3] = 1.f / sm[3];
    if (kq < 2) {
#pragma unroll
        for (int t = 0; t < 8; ++t) *(LAS f32x4*)(pb + (16 * t + m) * 8 + 4 * kq) = lg[t] * inv;
        if (m == 0) { *(LAS f32x4*)(stat + 4 * kq) = mx; *(LAS f32x4*)(stat + 8 + 4 * kq) = sm; }
    }
    asm volatile("s_waitcnt lgkmcnt(0)" ::: "memory");
    const int kvh = lane >> 5;
    o[0] = (f32x2){0.f, 0.f}; o[1] = o[0]; o[2] = o[0]; o[3] = o[0];
    const LAS u32x4* l4 = (const LAS u32x4*)list;
    for (int kb = 0; kb < 128; kb += 8) {
        const u32x4 pa = l4[(kb >> 3)];
        typename Src::vraw vr[8];
#pragma unroll
        for (int j = 0; j < 8; ++j) {
            const unsigned wv = pa[j >> 1];
            const int pos = (j & 1) ? (int)(wv >> 16) : (int)(wv & 0xffffu);
            vr[j] = S.vload(pos, lane);
        }
#pragma unroll
        for (int j = 0; j < 8; ++j) {
            const f32x4 p = *(const LAS f32x4*)(pb + (kb + j) * 8 + 4 * kvh);
            const f32x2 v = S.vcvt(vr[j]);
            o[0] += v * p[0]; o[1] += v * p[1]; o[2] += v * p[2]; o[3] += v * p[3];
        }
    }
}

constexpr int LDS_STG = 139264 + 8704;
static_assert(LDS_STG + 64 * 144 <= LDS_MISC, "dsa lds");
constexpr int SK_PITCH = 2176, SKS_PITCH = 8704, LDS_LIST = 139264, LDS_NSEL = LDS_LIST + 32 * 512, LDS_PBS = 4 * SKS_PITCH * 2;
static_assert(LDS_NSEL + 128 <= LDS_MISC && LDS_PBS + 4 * 8192 <= LDS_LIST, "dsa lds");

__device__ __forceinline__ void idx_afrag(const _Float16* qih, const int (&qrows)[4], int lane, f16x8 (&A)[4]) {
    const int m = lane & 31, hh = lane >> 5, q4 = 2 * (m >> 4) + ((m >> 2) & 1), head = 4 * ((m >> 3) & 1) + (m & 3);
    const int qr = q4 == 0 ? qrows[0] : q4 == 1 ? qrows[1] : q4 == 2 ? qrows[2] : qrows[3];
    const _Float16* p = qih + (size_t)qr * 512 + head * 64 + 32 * hh;
#pragma unroll
    for (int s = 0; s < 4; ++s) A[s] = *(const f16x8*)(p + 8 * s);
}
__device__ __forceinline__ void idx_score(const f32x16& acc, const float (&wa)[8], const float (&wb)[8], float& sa, float& sb) {
    sa = 0.f; sb = 0.f;
#pragma unroll
    for (int r = 0; r < 8; ++r) { sa += __builtin_amdgcn_fmed3f(acc[r], 0.f, __builtin_inff()) * wa[r]; sb += __builtin_amdgcn_fmed3f(acc[8 + r], 0.f, __builtin_inff()) * wb[r]; }
}

__device__ __forceinline__ void dsa_prompt_unit(Frame& F, int b, int p0, int nq) {
    const float* proj = (const float*)(F.ws + WS_PROJ);
    const _Float16* kih = (const _Float16*)(F.ws + WS_KIH);
    bf16_t* act = (bf16_t*)(F.ws + WS_ACT);
    LAS u16* sk = (LAS u16*)F.lds; LAS unsigned* masks = (LAS unsigned*)(F.lds + LDS_LIST);
    const int lane = F.lane, w = F.wave, Lk = p0 + nq, ntiles = (Lk + 31) >> 5;
    const bool active = 4 * w < nq;
    {
        LAS unsigned char* stg = F.lds + LDS_STG;
        const int hh = lane >> 5, n = lane & 31;
        const int skey = F.tid >> 3, schunk = F.tid & 7;
        const int nblocks = (Lk + 63) >> 6;
        f16x8 A[4]; float wa[8], wb[8];
        const int qpa = p0 + 4 * w + hh, qpb = qpa + 2;
        if (active) {
            int qrows[4];
#pragma unroll
            for (int i = 0; i < 4; ++i) qrows[i] = prow(b, p0 + 4 * w + i);
            idx_afrag((const _Float16*)(F.ws + WS_KEB), qrows, lane, A);
            const float* pa = proj + (size_t)prow(b, qpa) * PLD + EWI; const float* pbq = proj + (size_t)prow(b, qpb) * PLD + EWI;
#pragma unroll
            for (int r = 0; r < 8; ++r) { wa[r] = pa[r]; wb[r] = pbq[r]; }
        } else {
#pragma unroll
            for (int s = 0; s < 4; ++s) A[s] = (f16x8){0, 0, 0, 0, 0, 0, 0, 0};
#pragma unroll
            for (int r = 0; r < 8; ++r) { wa[r] = 0.f; wb[r] = 0.f; }
        }
        LAS u16* ra = sk + (4 * w + hh) * SK_PITCH; LAS u16* rb = sk + (4 * w + 2 + hh) * SK_PITCH;
#define SC_LOADBLK(g, i) do { const int pp_ = 64 * (i) + skey, pos_ = pp_ < LP ? pp_ : LP - 1; g = *(const u32x4*)(kih + (size_t)prow(b, pos_) * 64 + 8 * schunk); } while (0)
#define SC_STEP(g, i) do { if ((i) < nblocks) { \
            __syncthreads(); *(LAS u32x4*)(stg + skey * 144 + 16 * schunk) = g; __syncthreads(); \
            SC_LOADBLK(g, (i) + 3); \
            if (active) { f16x8 Bf_[2][4]; f32x16 acc_[2]; \
                _Pragma("unroll") for (int tl = 0; tl < 2; ++tl) _Pragma("unroll") for (int s2 = 0; s2 < 4; ++s2) Bf_[tl][s2] = *(const LAS f16x8*)(stg + (32 * tl + n) * 144 + 64 * hh + 16 * s2); \
                __builtin_amdgcn_sched_barrier(0); \
                _Pragma("unroll") for (int tl = 0; tl < 2; ++tl) _Pragma("unroll") for (int r = 0; r < 16; ++r) acc_[tl][r] = 0.f; \
                _Pragma("unroll") for (int s2 = 0; s2 < 4; ++s2) _Pragma("unroll") for (int tl = 0; tl < 2; ++tl) acc_[tl] = __builtin_amdgcn_mfma_f32_32x32x16_f16(A[s2], Bf_[tl][s2], acc_[tl], 0, 0, 0); \
                _Pragma("unroll") for (int tl = 0; tl < 2; ++tl) { const int pos = 64 * (i) + 32 * tl + n; \
                    float sa, sb; idx_score(acc_[tl], wa, wb, sa, sb); \
                    if (pos < 32 * ntiles) { ra[pos] = (u16)(pos <= qpa ? f2key(sa) : 0u); rb[pos] = (u16)(pos <= qpb ? f2key(sb) : 0u); } } } } } while (0)
        u32x4 gk0, gk1, gk2;
        SC_LOADBLK(gk0, 0); SC_LOADBLK(gk1, 1); SC_LOADBLK(gk2, 2);
        for (int blkk = 0; blkk < nblocks; blkk += 3) { SC_STEP(gk0, blkk); SC_STEP(gk1, blkk + 1); SC_STEP(gk2, blkk + 2); }
#undef SC_STEP
#undef SC_LOADBLK
    }
    if (active) {
        for (int i = 0; i < 4; ++i) { LAS u16* r = sk + (4 * w + i) * SK_PITCH; for (int j = 32 * ntiles + lane; j < ((Lk + 127) & ~127); j += 64) r[j] = 0; }
        asm volatile("s_waitcnt lgkmcnt(0)" ::: "memory");
        for (int i = 0; i < 4; ++i) {
            const int q = 4 * w + i;
            { const int nv = p0 + q + 1, nst = (nv + 127) >> 7;
              if (nst <= 5) select_mask<5>(sk + q * SK_PITCH, nv, masks + q * MASK_WORDS, lane);
              else if (nst <= 9) select_mask<9>(sk + q * SK_PITCH, nv, masks + q * MASK_WORDS, lane);
              else if (nst <= 13) select_mask<13>(sk + q * SK_PITCH, nv, masks + q * MASK_WORDS, lane);
              else select_mask<17>(sk + q * SK_PITCH, nv, masks + q * MASK_WORDS, lane); }
        }
    }
    __syncthreads();
    {
        const bf16_t* kvb = (const bf16_t*)(F.ws + WS_KVB);
        const int kvh = w >> 2, rb = w & 3, n = lane & 31, hi = lane >> 5;
        const bool act_w = 8 * rb < nq;
        const int qpos = p0 + 8 * rb + (n >> 2), head = 4 * kvh + (n & 3);
        const int qrow = prow(b, act_w ? qpos : p0);
        bf16x8 qf[4];
        { const bf16_t* qp = (const bf16_t*)(F.ws + WS_QE) + (size_t)qrow * 512 + head * 64 + 32 * hi;
#pragma unroll
          for (int s = 0; s < 4; ++s) qf[s] = *(const bf16x8*)(qp + 8 * s); }
        const int skey = F.tid >> 4, sc = F.tid & 15;
        const unsigned kdst = (unsigned)((sc >> 3) * 4608 + skey * 144 + 16 * (sc & 7));
        const unsigned vdst = (unsigned)(9216 + (sc >> 3) * 4096 + ((sc & 7) >> 2) * 2048 + skey * 64 + 16 * (sc & 3));
        constexpr int KVBUF = 17408;
#define FL_COMPUTE \
            if (act_w) { \
                f32x16 sc16; bf16x8 kf_[4], vf_[2][2]; \
_Pragma("unroll") \
                for (int s = 0; s < 4; ++s) kf_[s] = *(const LAS bf16x8*)(kbase + boff + 16 * s); \
_Pragma("unroll") \
                for (int ks = 0; ks < 2; ++ks) { \
_Pragma("unroll") \
                    for (int dh = 0; dh < 2; ++dh) { \
                        typedef short v4i16_t __attribute__((ext_vector_type(4))); \
                        const LAS unsigned char* vp = vbase + boff + dh * 2048 + ks * 1024; \
                        const v4i16_t lo = __builtin_amdgcn_ds_read_tr16_b64_v4i16((LAS v4i16_t*)vp), hi4 = __builtin_amdgcn_ds_read_tr16_b64_v4i16((LAS v4i16_t*)(vp + 512)); \
                        vf_[ks][dh] = (bf16x8){lo[0], lo[1], lo[2], lo[3], hi4[0], hi4[1], hi4[2], hi4[3]}; \
                    } \
                } \
                __builtin_amdgcn_sched_barrier(0); \
_Pragma("unroll") \
                for (int r = 0; r < 16; ++r) sc16[r] = 0.f; \
_Pragma("unroll") \
                for (int s = 0; s < 4; ++s) sc16 = __builtin_amdgcn_mfma_f32_32x32x16_bf16(kf_[s], qf[s], sc16, 0, 0, 0); \
                const unsigned mw = mrow[t] >> (4 * hi); \
                float tmax = -1e30f; \
_Pragma("unroll") \
                for (int r = 0; r < 16; ++r) { const bool on = (mw >> ((r & 3) + 8 * (r >> 2))) & 1u; sc16[r] = on ? sc16[r] : -1e30f; tmax = fmaxf(tmax, sc16[r]); } \
                { auto rr = __builtin_amdgcn_permlane32_swap(__float_as_uint(tmax), __float_as_uint(tmax), false, false); tmax = fmaxf(__uint_as_float(rr[0]), __uint_as_float(rr[1])); } \
                const float m_new = fmaxf(m_run, tmax), alpha = __expf(m_run - m_new); \
                m_run = m_new; \
                float psum = 0.f; \
_Pragma("unroll") \
                for (int r = 0; r < 16; ++r) { const bool on = (mw >> ((r & 3) + 8 * (r >> 2))) & 1u; const float p = on ? __expf(sc16[r] - m_new) : 0.f; sc16[r] = p; psum += p; } \
                l_run = l_run * alpha + psum; \
_Pragma("unroll") \
                for (int r = 0; r < 16; ++r) { o0[r] *= alpha; o1[r] *= alpha; } \
                bf16x8 pw[2]; \
_Pragma("unroll") \
                for (int ks = 0; ks < 2; ++ks) { u32x4 wv; wv.x = cvt_pk_bf16(sc16[8 * ks], sc16[8 * ks + 1]); wv.y = cvt_pk_bf16(sc16[8 * ks + 2], sc16[8 * ks + 3]); wv.z = cvt_pk_bf16(sc16[8 * ks + 4], sc16[8 * ks + 5]); wv.w = cvt_pk_bf16(sc16[8 * ks + 6], sc16[8 * ks + 7]); pw[ks] = __builtin_bit_cast(bf16x8, wv); } \
_Pragma("unroll") \
                for (int ks = 0; ks < 2; ++ks) { o0 = __builtin_amdgcn_mfma_f32_32x32x16_bf16(vf_[ks][0], pw[ks], o0, 0, 0, 0); o1 = __builtin_amdgcn_mfma_f32_32x32x16_bf16(vf_[ks][1], pw[ks], o1, 0, 0, 0); } \
            }
#define FL_LOAD(gk_, gv_, i) do { const int pp_ = 32 * (i) + skey, pos_ = pp_ < LP ? pp_ : LP - 1; const bf16_t* src_ = kvb + (size_t)prow(b, pos_) * 256 + 8 * sc; gk_ = *(const u32x4*)src_; gv_ = *(const u32x4*)(src_ + 128); } while (0)
        u32x4 gkA, gvA, gkB, gvB, gkC, gvC;
        FL_LOAD(gkA, gvA, 0); FL_LOAD(gkB, gvB, 1); FL_LOAD(gkC, gvC, 2);
        *(LAS u32x4*)(F.lds + kdst) = gkA; *(LAS u32x4*)(F.lds + vdst) = gvA;
        FL_LOAD(gkA, gvA, 3);
        __syncthreads();
        const LAS unsigned char* kbase = F.lds + kvh * 4608 + n * 144 + 64 * hi;
        const LAS unsigned char* vbase = F.lds + 9216 + kvh * 4096 + (4 * hi + ((lane & 15) >> 2)) * 64 + ((lane >> 4) & 1) * 32 + (lane & 3) * 8;
        const LAS unsigned* mrow = masks + (8 * rb + (n >> 2)) * MASK_WORDS;
        float m_run = -1e30f, l_run = 0.f;
        f32x16 o0, o1;
#pragma unroll
        for (int r = 0; r < 16; ++r) { o0[r] = 0.f; o1[r] = 0.f; }
#define FL_STEP(tt_, gk_, gv_) do { if ((tt_) < ntiles) { const int t = (tt_); const int boff = (t & 1) * KVBUF; \
            FL_COMPUTE \
            if (t + 1 < ntiles) { const int nb = ((t + 1) & 1) * KVBUF; *(LAS u32x4*)(F.lds + nb + kdst) = gk_; *(LAS u32x4*)(F.lds + nb + vdst) = gv_; FL_LOAD(gk_, gv_, t + 4); } \
            __syncthreads(); } } while (0)
        for (int t3 = 0; t3 < ntiles; t3 += 3) { FL_STEP(t3, gkB, gvB); FL_STEP(t3 + 1, gkC, gvC); FL_STEP(t3 + 2, gkA, gvA); }
#undef FL_STEP
#undef FL_COMPUTE
#undef FL_LOAD
        if (act_w) {
            { auto rr = __builtin_amdgcn_permlane32_swap(__float_as_uint(l_run), __float_as_uint(l_run), false, false); l_run = __uint_as_float(rr[0]) + __uint_as_float(rr[1]); }
            const float inv = 1.f / l_run;
            bf16_t* ap = act + (size_t)qrow * DM + head * 64 + 4 * hi;
#pragma unroll
            for (int g4 = 0; g4 < 4; ++g4) {
                u32x2 w0; w0.x = cvt_pk_bf16(o0[4 * g4] * inv, o0[4 * g4 + 1] * inv); w0.y = cvt_pk_bf16(o0[4 * g4 + 2] * inv, o0[4 * g4 + 3] * inv);
                u32x2 w1; w1.x = cvt_pk_bf16(o1[4 * g4] * inv, o1[4 * g4 + 1] * inv); w1.y = cvt_pk_bf16(o1[4 * g4 + 2] * inv, o1[4 * g4 + 3] * inv);
                *(u32x2*)(ap + 8 * g4) = w0; *(u32x2*)(ap + 32 + 8 * g4) = w1;
            }
        }
    }
    __syncthreads();
}

constexpr int LDS_PTS = LDS_NSEL + 128;
constexpr int LDS_STAT = LDS_PBS + 8 * 4096, LDS_OPART = LDS_STAT + 512, LDS_XCH = LDS_OPART + 8192;
static_assert(LDS_XCH + 128 <= LDS_LIST, "dsa lds");
static_assert(LDS_PTS + 256 <= LDS_MISC, "dsa lds");
__device__ __forceinline__ const float* samp_kiptr(const float* cki, const LAS int* pts, const float* proj, int db, int pos, int hh) {
    const int posc = pos < PAST + DSEQ ? pos : PAST + DSEQ - 1;
    return posc < PAST ? cki + ((size_t)pts[posc >> 7] * PAGE + (posc & 127)) * 64 + 32 * hh
                       : proj + (size_t)(ROW_SAMP + db * DSEQ + (posc - PAST)) * PLD + EKI + 32 * hh;
}
__device__ __forceinline__ void dsa_sample_unit(Frame& F, int e, int db) {
    const float* proj = (const float*)(F.ws + WS_PROJ);
    bf16_t* act = (bf16_t*)(F.ws + WS_ACT);
    const float* cki = F.in[IN_CKI] + (size_t)e * NPOOLPG * PAGE * 64;
    LAS u16* sk = (LAS u16*)F.lds; LAS u16* lists = (LAS u16*)(F.lds + LDS_LIST); LAS int* pts = (LAS int*)(F.lds + LDS_PTS);
    const int lane = F.lane, w = F.wave, hh = lane >> 5, n = lane & 31;
    if (F.tid < NPAGES) pts[F.tid] = ((const int*)F.in[IN_PT])[db * NPAGES + F.tid];
    int qrows[4];
#pragma unroll
    for (int i = 0; i < 4; ++i) qrows[i] = ROW_SAMP + db * DSEQ + i;
    f16x8 A[4]; idx_afrag((const _Float16*)(F.ws + WS_KEB), qrows, lane, A);
    float wa[8], wb[8];
    const int qpa = PAST + hh, qpb = qpa + 2;
    { const float* pa = proj + (size_t)(ROW_SAMP + db * DSEQ + hh) * PLD + EWI; const float* pbq = proj + (size_t)(ROW_SAMP + db * DSEQ + 2 + hh) * PLD + EWI;
#pragma unroll
      for (int r = 0; r < 8; ++r) { wa[r] = pa[r]; wb[r] = pbq[r]; } }
    LAS u16* ra = sk + hh * SKS_PITCH; LAS u16* rb = sk + (2 + hh) * SKS_PITCH;
    constexpr int NT = (PAST + DSEQ + 31) / 32;
    for (int q = 0; q < 4; ++q) for (int c = 32 * NT + F.tid; c < SKS_PITCH; c += 512) sk[q * SKS_PITCH + c] = 0;
    __syncthreads();
#define SS_LOAD(buf_, t_) do { const float* kp_ = samp_kiptr(cki, pts, proj, db, 32 * (t_) + n, hh); _Pragma("unroll") for (int s2 = 0; s2 < 8; ++s2) buf_[s2] = *(const f32x4*)(kp_ + 4 * s2); } while (0)
#define SS_STEP(buf_, t_) do { if ((t_) < NT) { const int pos = 32 * (t_) + n; f32x16 acc; \
        _Pragma("unroll") for (int r = 0; r < 16; ++r) acc[r] = 0.f; \
        _Pragma("unroll") for (int s2 = 0; s2 < 4; ++s2) { const f32x4 a = buf_[2 * s2], c = buf_[2 * s2 + 1]; \
            f16x8 h; h[0] = (_Float16)a[0]; h[1] = (_Float16)a[1]; h[2] = (_Float16)a[2]; h[3] = (_Float16)a[3]; h[4] = (_Float16)c[0]; h[5] = (_Float16)c[1]; h[6] = (_Float16)c[2]; h[7] = (_Float16)c[3]; \
            acc = __builtin_amdgcn_mfma_f32_32x32x16_f16(A[s2], h, acc, 0, 0, 0); } \
        SS_LOAD(buf_, (t_) + 16); \
        float sa, sb; idx_score(acc, wa, wb, sa, sb); \
        ra[pos] = (u16)(pos <= qpa ? f2key(sa) : 0u); rb[pos] = (u16)(pos <= qpb ? f2key(sb) : 0u); } } while (0)
    f32x4 r0s[8], r1s[8];
    SS_LOAD(r0s, w); SS_LOAD(r1s, w + 8);
    for (int t = w; t < NT; t += 16) { SS_STEP(r0s, t); SS_STEP(r1s, t + 8); }
#undef SS_STEP
#undef SS_LOAD
    __syncthreads();
    {
        const int q = w >> 1, half = w & 1;
        volatile LAS int* xch = (volatile LAS int*)(F.lds + LDS_XCH);
        select_topk_pair<33>(sk + q * SKS_PITCH, PAST + q + 1, lists + q * 256, xch, lane, w);
        __syncthreads();
        SrcSample S; S.ck = F.in[IN_CK] + (size_t)e * NPOOLPG * PAGE * 128; S.cv = F.in[IN_CV] + (size_t)e * NPOOLPG * PAGE * 128; S.pt = pts; S.proj = proj; S.db = db;
        LAS float* stat = (LAS float*)(F.lds + LDS_STAT) + w * 16; LAS float* opart = (LAS float*)(F.lds + LDS_OPART) + q * 512;
        f32x2 o[4];
        const int qrow = ROW_SAMP + db * DSEQ + q;
        attn_half<SrcSample, 1>(S, (const bf16_t*)(F.ws + WS_QE), qrow, lists + q * 256 + 128 * half, (LAS float*)(F.lds + LDS_PBS + w * 4096), stat, lane, o);
        if (half) { *(LAS f32x4*)(opart + lane * 8) = (f32x4){o[0][0], o[0][1], o[1][0], o[1][1]}; *(LAS f32x4*)(opart + lane * 8 + 4) = (f32x4){o[2][0], o[2][1], o[3][0], o[3][1]}; }
        __syncthreads();
        if (!half) {
            const int kvh = lane >> 5;
            const LAS float* st0 = (const LAS float*)(F.lds + LDS_STAT) + w * 16; const LAS float* st1 = st0 + 16;
            const f32x4 m0 = *(const LAS f32x4*)(st0 + 4 * kvh), l0 = *(const LAS f32x4*)(st0 + 8 + 4 * kvh), m1 = *(const LAS f32x4*)(st1 + 4 * kvh), l1 = *(const LAS f32x4*)(st1 + 8 + 4 * kvh);
            const f32x4 pa = *(const LAS f32x4*)(opart + lane * 8), pc = *(const LAS f32x4*)(opart + lane * 8 + 4);
            const f32x2 op[4] = {(f32x2){pa[0], pa[1]}, (f32x2){pa[2], pa[3]}, (f32x2){pc[0], pc[1]}, (f32x2){pc[2], pc[3]}};
            bf16_t* ap = act + (size_t)qrow * DM + (4 * kvh) * 64 + 2 * (lane & 31);
#pragma unroll
            for (int j = 0; j < 4; ++j) {
                const float M = fmaxf(m0[j], m1[j]), w0 = l0[j] * __expf(m0[j] - M), w1 = l1[j] * __expf(m1[j] - M), inv = 1.f / (w0 + w1);
                const f32x2 r = (o[j] * w0 + op[j] * w1) * inv;
                *(unsigned*)(ap + 64 * j) = cvt_pk_bf16(r[0], r[1]);
            }
        }
    }
    __syncthreads();
}

template <int W>
__device__ __forceinline__ void pool_diff_group(Frame& F, const float* proj, const float* spool, bf16_t* act, int g) {
    const int gt = F.blk * 512 + F.tid, NT = F.G * 512;
    for (int idx = gt; idx < (MREAL - ROW_META) * 32; idx += NT) {
        const int row = ROW_META + (idx >> 5), c = 128 * g + 4 * (idx & 31);
        f32x4 v[W]; float cnt;
        if (row < ROW_SAMP) {
            int b = 0, p;
            if (row < ROW_META) { b = row >> 11; p = NMETA + (row & 2047); } else p = row - ROW_META;
            const int nw = W < p + 1 ? W : p + 1;
#pragma unroll
            for (int j = 0; j < W; ++j) { const int pj = p - j > 0 ? p - j : 0; v[j] = *(const f32x4*)(proj + (size_t)prow(b, pj) * PLD + EU + c); }
#pragma unroll
            for (int j = 1; j < W; ++j) if (j >= nw) v[j] = (f32x4){0.f, 0.f, 0.f, 0.f};
            cnt = (float)nw;
        } else {
            const int db = (row - ROW_SAMP) >> 2, t = (row - ROW_SAMP) & 3;
#pragma unroll
            for (int j = 0; j < W; ++j) {
                const int i = 15 + t - j;
                const float* src = i < 15 ? spool + ((size_t)db * 15 + i) * 512 + c : proj + (size_t)(ROW_SAMP + db * DSEQ + (i - 15)) * PLD + EU + c;
                v[j] = *(const f32x4*)src;
            }
            cnt = (float)W;
        }
        f32x4 sum = v[0];
#pragma unroll
        for (int j = 1; j < W; ++j) sum += v[j];
        const f32x4 d = sum / cnt - v[0];
        u32x2 wv; wv.x = cvt_pk_bf16(d[0], d[1]); wv.y = cvt_pk_bf16(d[2], d[3]);
        *(u32x2*)(act + (size_t)row * DM + 512 + c) = wv;
    }
}

template <int W>
__device__ __forceinline__ void pool_diff_item(const float* proj, bf16_t* act, int b, int blk16, int c) {
    const int p0 = NMETA + 16 * blk16;
    f32x4 v[16 + W - 1];
#pragma unroll
    for (int i = 0; i < 16 + W - 1; ++i) v[i] = *(const f32x4*)(proj + (size_t)prow(b, p0 - (W - 1) + i) * PLD + EU + c);
    const float inv = 1.f / (float)W;
#pragma unroll
    for (int r = 0; r < 16; ++r) {
        f32x4 sum = v[r + W - 1];
#pragma unroll
        for (int j = 1; j < W; ++j) sum += v[r + W - 1 - j];
        const f32x4 d = sum * inv - v[r + W - 1];
        u32x2 wv; wv.x = cvt_pk_bf16(d[0], d[1]); wv.y = cvt_pk_bf16(d[2], d[3]);
        *(u32x2*)(act + (size_t)(b * SEQ + 16 * blk16 + r) * DM + 512 + c) = wv;
    }
}
__device__ __forceinline__ void pool_diff_blocks(Frame& F, const float* proj, bf16_t* act) {
    const int gt = F.blk * 512 + F.tid, NT = F.G * 512;
    for (int idx = gt; idx < NBATCH * 128 * 128; idx += NT) {
        const int cq = idx & 31, g = (idx >> 6) & 3, blk16 = ((idx >> 8) & 63) * 2 + ((idx >> 5) & 1), b = idx >> 14, c = 128 * g + 4 * cq;
        if (g == 0) pool_diff_item<2>(proj, act, b, blk16, c); else if (g == 1) pool_diff_item<4>(proj, act, b, blk16, c);
        else if (g == 2) pool_diff_item<8>(proj, act, b, blk16, c); else pool_diff_item<16>(proj, act, b, blk16, c);
    }
}

__device__ __forceinline__ void even_mixer_phase(Frame& F, int e, int l) {
    const float* proj = (const float*)(F.ws + WS_PROJ);
    bf16_t* act = (bf16_t*)(F.ws + WS_ACT);
    const float* spool = F.in[IN_SPOOL] + (size_t)e * DBATCH * 15 * 512;
    const int gt = F.blk * 512 + F.tid, NT = F.G * 512;
    pool_diff_group<2>(F, proj, spool, act, 0); pool_diff_group<4>(F, proj, spool, act, 1); pool_diff_group<8>(F, proj, spool, act, 2); pool_diff_group<16>(F, proj, spool, act, 3);
    pool_diff_blocks(F, proj, act);
    float* out = F.out;
    for (int idx = gt; idx < NBATCH * 15 * 128; idx += NT) {
        const int bj = idx >> 7, cq = idx & 127, b = bj / 15, j = bj % 15;
        *(f32x4*)(out + O_PP + ((size_t)(e * NBATCH + b) * 15 + j) * 512 + 4 * cq) = *(const f32x4*)(proj + (size_t)prow(b, LP - 15 + j) * PLD + EU + 4 * cq);
    }
    for (int idx = gt; idx < DBATCH * 15 * 128; idx += NT) {
        const int bj = idx >> 7, cq = idx & 127, db = bj / 15, j = bj % 15, i = DSEQ + j;
        const f32x4 v = i < 15 ? *(const f32x4*)(spool + ((size_t)db * 15 + i) * 512 + 4 * cq) : *(const f32x4*)(proj + (size_t)(ROW_SAMP + db * DSEQ + (i - 15)) * PLD + EU + 4 * cq);
        *(f32x4*)(out + O_PS + ((size_t)(e * DBATCH + db) * 15 + j) * 512 + 4 * cq) = v;
    }
    volatile LAS int* bc = (volatile LAS int*)(F.lds + LDS_MISC + 16);
    unsigned* qh = F.ctl + CW_QUEUE + 64 * l;
    for (;;) {
        __syncthreads();
        if (F.tid == 0) *bc = (int)__hip_atomic_fetch_add(qh, 1u, __ATOMIC_RELAXED, __HIP_MEMORY_SCOPE_AGENT);
        __syncthreads();
        const int u = *bc;
        if (u >= 32 + 512 + 1) break;
#ifdef NO_SAMPLE
        if (u < 32) {}
#else
        if (u < 32) dsa_sample_unit(F, e, u);
#endif
#ifdef NO_PROMPT
        else {}
        if (0) {}
#endif
        else if (u < 544) { const int v = u - 32, qb = 63 - (v >> 3), b = v & 7; dsa_prompt_unit(F, b, NMETA + 32 * qb, 32); }
        else dsa_prompt_unit(F, 0, 0, 16);
    }
}

__device__ __forceinline__ void chunk_info(int ci, int& r0, int& T) {
    if (ci == 0) { r0 = ROW_META; T = NMETA; } else if (ci <= 256) { r0 = (ci - 1) * 64; T = 64; } else { r0 = ROW_SAMP + (ci - 257) * DSEQ; T = DSEQ; }
}
constexpr int QES_PITCH = 520;
__device__ __forceinline__ void gla_prep_unit(Frame& F, int o, int ci, const float* ssl, const float* sstl) {
    const float* proj = (const float*)(F.ws + WS_PROJ);
    bf16_t* QE = (bf16_t*)(F.ws + WS_QE); bf16_t* KET = (bf16_t*)(F.ws + WS_KET); bf16_t* VT = (bf16_t*)(F.ws + WS_VT); bf16_t* ATT = (bf16_t*)(F.ws + WS_ATT);
    float* EBL = (float*)(F.ws + WS_EBL); bf16_t* KEB = (bf16_t*)(F.ws + WS_KEB);
    LAS bf16_t* qes = (LAS bf16_t*)F.lds; LAS bf16_t* kes = (LAS bf16_t*)(F.lds + 64 * QES_PITCH * 2); LAS float* gds = (LAS float*)(F.lds + 2 * 64 * QES_PITCH * 2);
    int r0, T; chunk_info(ci, r0, T);
    const int tid = F.tid, col = tid, h = col >> 7, d = col & 127;
    __syncthreads();
    {
        const bf16_t* XBp = (const bf16_t*)(F.ws + WS_XB); const bf16_t* WGD = (const bf16_t*)(F.ws + WS_WINO) + ((size_t)o * NO + OGD) * DM;
        LAS float* part = (LAS float*)F.lds; LAS float* rsg = (LAS float*)(F.lds + 32768);
        const int lane = F.lane, w = F.wave, m = lane & 15, kq = lane >> 4;
        bf16x8 Af[4][4], Bf[4];
#pragma unroll
        for (int ks = 0; ks < 4; ++ks) Bf[ks] = *(const bf16x8*)(WGD + (size_t)m * DM + 128 * w + 32 * ks + 8 * kq);
#pragma unroll
        for (int tt = 0; tt < 4; ++tt)
#pragma unroll
            for (int ks = 0; ks < 4; ++ks) Af[tt][ks] = *(const bf16x8*)(XBp + (size_t)(r0 + (16 * tt < T ? 16 * tt : 0) + m) * DM + 128 * w + 32 * ks + 8 * kq);
        float rs_mine = 0.f;
        if (tid < 64) { const int row = r0 + (tid < T ? tid : T - 1); rs_mine = row < TR0 ? row_rstd(ssl, row) : tail_rstd_batched(sstl, row - TR0); }
        __builtin_amdgcn_sched_barrier(0);
#pragma unroll
        for (int tt = 0; tt < 4; ++tt) {
            f32x4 acc = (f32x4){0.f, 0.f, 0.f, 0.f};
#pragma unroll
            for (int ks = 0; ks < 4; ++ks) acc = __builtin_amdgcn_mfma_f32_16x16x32_bf16(Af[tt][ks], Bf[ks], acc, 0, 0, 0);
            *(LAS f32x4*)(part + ((w * 4 + tt) * 64 + lane) * 4) = acc;
        }
        if (tid < 64) rsg[tid] = rs_mine;
        __syncthreads();
        if (tid < 256) {
            const int tt = tid >> 6, ln = tid & 63, r = ln & 15, g = ln >> 4;
            f32x4 sum = *(const LAS f32x4*)(part + ((0 * 4 + tt) * 64 + ln) * 4);
#pragma unroll
            for (int ww = 1; ww < 8; ++ww) sum += *(const LAS f32x4*)(part + ((ww * 4 + tt) * 64 + ln) * 4);
#pragma unroll
            for (int j = 0; j < 4; ++j) {
                const int t = 16 * tt + 4 * g + j;
                gds[t * 16 + r] = t < T ? sum[j] * rsg[t] : 0.f;
            }
        }
    }
    float wg[16];
#pragma unroll
    for (int r = 0; r < 16; ++r) wg[r] = F.in[IN_WGATE][((size_t)o * 16 + r) * 512 + col];
    const float bgc = F.in[IN_BGATE][o * 512 + col];
    __syncthreads();
    float bcum = 0.f;
#define PREP_LOAD(qv, kv, va, vb, t0_) do { _Pragma("unroll") for (int u = 0; u < 8; ++u) { \
        const int tc = ((t0_) + u) < T ? ((t0_) + u) : (T - 1); const bf16_t* pr = (const bf16_t*)proj + (size_t)(r0 + tc) * PLB; \
        qv[u] = bf_lo((unsigned)pr[OQ + col]); kv[u] = bf_lo((unsigned)pr[OKK + col]); va[u] = bf_lo((unsigned)pr[OV + col]); vb[u] = bf_lo((unsigned)pr[OV + 512 + col]); } } while (0)
#define PREP_BLOCK(qv, kv, va, vb, t0_) do { const int tb0 = (t0_); unsigned kp[4], v0p[4], v1p[4], qkp[8]; \
        if (tb0 < T) { float ke8[8], v08[8], v18[8]; \
            _Pragma("unroll") for (int u = 0; u < 8; ++u) { const int t = tb0 + u; float qe = 0.f, ke = 0.f, v0 = 0.f, v1 = 0.f; \
                if (t < T) { \
                    const f32x4 g0 = *(const LAS f32x4*)(gds + t * 16), g1 = *(const LAS f32x4*)(gds + t * 16 + 4), g2 = *(const LAS f32x4*)(gds + t * 16 + 8), g3 = *(const LAS f32x4*)(gds + t * 16 + 12); \
                    float x = bgc; \
                    _Pragma("unroll") for (int r = 0; r < 4; ++r) { x += g0[r] * wg[r]; x += g1[r] * wg[4 + r]; x += g2[r] * wg[8 + r]; x += g3[r] * wg[12 + r]; } \
                    const float la = (fminf(x, 0.f) - __logf(1.f + __expf(-fabsf(x)))) * (1.f / 16.f); \
                    bcum += la; const float eb = __expf(bcum); \
                    qe = qv[u] * eb; ke = kv[u] * __builtin_amdgcn_rcpf(eb); v0 = va[u]; v1 = vb[u]; } \
                qkp[u] = cvt_pk_bf16(qe, ke); ke8[u] = ke; v08[u] = v0; v18[u] = v1; } \
            _Pragma("unroll") for (int u = 0; u < 4; ++u) { kp[u] = cvt_pk_bf16(ke8[2 * u], ke8[2 * u + 1]); v0p[u] = cvt_pk_bf16(v08[2 * u], v08[2 * u + 1]); v1p[u] = cvt_pk_bf16(v18[2 * u], v18[2 * u + 1]); } \
            _Pragma("unroll") for (int u = 0; u < 8; ++u) { if (tb0 + u < T) { QE[(size_t)(r0 + tb0 + u) * 512 + col] = (bf16_t)(qkp[u] & 0xffffu); KEB[(size_t)(r0 + tb0 + u) * 512 + col] = (bf16_t)(qkp[u] >> 16); } } \
        } else { _Pragma("unroll") for (int u = 0; u < 4; ++u) { kp[u] = 0u; v0p[u] = 0u; v1p[u] = 0u; } } \
        *(u32x4*)(KET + (((size_t)ci * 4 + h) * 128 + d) * 64 + tb0) = (u32x4){kp[0], kp[1], kp[2], kp[3]}; \
        *(u32x4*)(VT + (((size_t)ci * 4 + (col >> 8)) * 256 + (col & 255)) * 64 + tb0) = (u32x4){v0p[0], v0p[1], v0p[2], v0p[3]}; \
        *(u32x4*)(VT + (((size_t)ci * 4 + 2 + (col >> 8)) * 256 + (col & 255)) * 64 + tb0) = (u32x4){v1p[0], v1p[1], v1p[2], v1p[3]}; } while (0)
    {
        float qa[8], ka[8], vaa[8], vba[8], qb[8], kb[8], vab[8], vbb[8];
        PREP_LOAD(qa, ka, vaa, vba, 0);
        for (int t0 = 0; t0 < 64; t0 += 16) {
            if (t0 + 8 < T) PREP_LOAD(qb, kb, vab, vbb, t0 + 8);
            PREP_BLOCK(qa, ka, vaa, vba, t0);
            if (t0 + 16 < T) PREP_LOAD(qa, ka, vaa, vba, t0 + 16);
            PREP_BLOCK(qb, kb, vab, vbb, t0 + 8);
        }
    }
#undef PREP_BLOCK
#undef PREP_LOAD
    EBL[(size_t)ci * 512 + col] = __expf(bcum);
    __syncthreads();
    {
        const int w = F.wave, lane = F.lane, hd = w >> 1, th = w & 1, m = lane & 15, kq = lane >> 4;
        bf16x8 A[2][4], B[4][4];
        const bool live0 = 32 * th < T, live1 = 32 * th + 16 < T;
        if (live0) {
#pragma unroll
            for (int ks = 0; ks < 4; ++ks) A[0][ks] = *(const bf16x8*)(QE + (size_t)(r0 + 32 * th + m) * 512 + hd * 128 + 32 * ks + 8 * kq);
#pragma unroll
            for (int st = 0; st < 4; ++st)
#pragma unroll
                for (int ks = 0; ks < 4; ++ks) B[st][ks] = *(const bf16x8*)(KEB + (size_t)(r0 + 16 * st + m) * 512 + hd * 128 + 32 * ks + 8 * kq);
        }
        if (live1) {
#pragma unroll
            for (int ks = 0; ks < 4; ++ks) A[1][ks] = *(const bf16x8*)(QE + (size_t)(r0 + 32 * th + 16 + m) * 512 + hd * 128 + 32 * ks + 8 * kq);
        }
        f32x4 acc[2][4];
#pragma unroll
        for (int tt = 0; tt < 2; ++tt)
#pragma unroll
            for (int st = 0; st < 4; ++st) acc[tt][st] = (f32x4){0.f, 0.f, 0.f, 0.f};
        if (live0) {
#pragma unroll
            for (int st = 0; st < 4; ++st)
#pragma unroll
                for (int ks = 0; ks < 4; ++ks) acc[0][st] = __builtin_amdgcn_mfma_f32_16x16x32_bf16(A[0][ks], B[st][ks], acc[0][st], 0, 0, 0);
        }
        if (live1) {
#pragma unroll
            for (int st = 0; st < 4; ++st)
#pragma unroll
                for (int ks = 0; ks < 4; ++ks) acc[1][st] = __builtin_amdgcn_mfma_f32_16x16x32_bf16(A[1][ks], B[st][ks], acc[1][st], 0, 0, 0);
        }
#pragma unroll
        for (int tt = 0; tt < 2; ++tt) {
            const int trow = 16 * (2 * th + tt);
#pragma unroll
            for (int st = 0; st < 4; ++st) {
                const int s_ = 16 * st + m;
#pragma unroll
                for (int r = 0; r < 4; ++r) { const int t = trow + 4 * kq + r; const float v = (s_ <= t && t < T) ? acc[tt][st][r] : 0.f;
                    ATT[(((size_t)ci * 4 + hd) * 64 + t) * 64 + s_] = (bf16_t)(cvt_pk_bf16(v, 0.f) & 0xffffu); }
            }
        }
    }
}

__device__ __forceinline__ void gla_scan_chunk(Frame& F, int ci, int h, int et, f32x4 (&S)[8], int lane) {
    const bf16_t* QE = (const bf16_t*)(F.ws + WS_QE); const bf16_t* KET = (const bf16_t*)(F.ws + WS_KET); const bf16_t* VT = (const bf16_t*)(F.ws + WS_VT); const bf16_t* ATT = (const bf16_t*)(F.ws + WS_ATT);
    const float* EBL = (const float*)(F.ws + WS_EBL); bf16_t* O = (bf16_t*)(F.ws + WS_O);
    int r0, T; chunk_info(ci, r0, T);
    const int m = lane & 15, g = lane >> 4;
    bf16x8 Bv[2], At0[2], Ka[8][2]; u32x2 Q0[4][2];
#pragma unroll
    for (int ks = 0; ks < 2; ++ks) Bv[ks] = *(const bf16x8*)(VT + (((size_t)ci * 4 + h) * 256 + 16 * et + m) * 64 + 32 * ks + 8 * g);
#pragma unroll
    for (int ks = 0; ks < 2; ++ks) At0[ks] = *(const bf16x8*)(ATT + (((size_t)ci * 4 + h) * 64 + m) * 64 + 8 * g + 32 * ks);
#pragma unroll
    for (int kk = 0; kk < 4; ++kk) { const bf16_t* qp = QE + (size_t)(r0 + m) * 512 + h * 128 + 4 * g; Q0[kk][0] = *(const u32x2*)(qp + 32 * kk); Q0[kk][1] = *(const u32x2*)(qp + 32 * kk + 16); }
#pragma unroll
    for (int dt = 0; dt < 8; ++dt) {
        const bf16_t* kp = KET + (((size_t)ci * 4 + h) * 128 + 16 * dt + m) * 64 + 8 * g;
        Ka[dt][0] = *(const bf16x8*)kp; Ka[dt][1] = *(const bf16x8*)(kp + 32);
    }
    __builtin_amdgcn_sched_barrier(0);
    bf16x8 Bs[4];
#pragma unroll
    for (int kk = 0; kk < 4; ++kk) { u32x4 w; w.x = cvt_pk_bf16(S[2 * kk][0], S[2 * kk][1]); w.y = cvt_pk_bf16(S[2 * kk][2], S[2 * kk][3]); w.z = cvt_pk_bf16(S[2 * kk + 1][0], S[2 * kk + 1][1]); w.w = cvt_pk_bf16(S[2 * kk + 1][2], S[2 * kk + 1][3]);
        Bs[kk] = __builtin_bit_cast(bf16x8, w); }
    {
        f32x4 acc = (f32x4){0.f, 0.f, 0.f, 0.f};
#pragma unroll
        for (int ks = 0; ks < 2; ++ks) acc = __builtin_amdgcn_mfma_f32_16x16x32_bf16(At0[ks], Bv[ks], acc, 0, 0, 0);
#pragma unroll
        for (int kk = 0; kk < 4; ++kk) {
            const u32x4 w = (u32x4){Q0[kk][0].x, Q0[kk][0].y, Q0[kk][1].x, Q0[kk][1].y};
            acc = __builtin_amdgcn_mfma_f32_16x16x32_bf16(__builtin_bit_cast(bf16x8, w), Bs[kk], acc, 0, 0, 0);
        }
#pragma unroll
        for (int r = 0; r < 4; ++r) { const int t = 4 * g + r; if (t < T) O[(size_t)(r0 + t) * DM + h * 256 + 16 * et + m] = (bf16_t)(cvt_pk_bf16(acc[r], 0.f) & 0xffffu); }
    }
#pragma unroll 1
    for (int tt = 1; 16 * tt < T; ++tt) {
        f32x4 acc = (f32x4){0.f, 0.f, 0.f, 0.f};
        const bf16_t* ap = ATT + (((size_t)ci * 4 + h) * 64 + 16 * tt + m) * 64 + 8 * g;
#pragma unroll
        for (int ks = 0; ks < 2; ++ks) acc = __builtin_amdgcn_mfma_f32_16x16x32_bf16(*(const bf16x8*)(ap + 32 * ks), Bv[ks], acc, 0, 0, 0);
        const bf16_t* qp = QE + (size_t)(r0 + 16 * tt + m) * 512 + h * 128 + 4 * g;
#pragma unroll
        for (int kk = 0; kk < 4; ++kk) {
            const u32x2 a0 = *(const u32x2*)(qp + 32 * kk), a1 = *(const u32x2*)(qp + 32 * kk + 16);
            const u32x4 w = (u32x4){a0.x, a0.y, a1.x, a1.y};
            acc = __builtin_amdgcn_mfma_f32_16x16x32_bf16(__builtin_bit_cast(bf16x8, w), Bs[kk], acc, 0, 0, 0);
        }
#pragma unroll
        for (int r = 0; r < 4; ++r) { const int t = 16 * tt + 4 * g + r; if (t < T) O[(size_t)(r0 + t) * DM + h * 256 + 16 * et + m] = (bf16_t)(cvt_pk_bf16(acc[r], 0.f) & 0xffffu); }
    }
#pragma unroll
    for (int dt = 0; dt < 8; ++dt) {
        f32x4 U = S[dt];
#pragma unroll
        for (int ks = 0; ks < 2; ++ks) U = __builtin_amdgcn_mfma_f32_16x16x32_bf16(Ka[dt][ks], Bv[ks], U, 0, 0, 0);
        S[dt] = U * *(const f32x4*)(EBL + (size_t)ci * 512 + h * 128 + 16 * dt + 4 * g);
    }
}
constexpr int SC_ATT = 0, SC_QE = 9216, SC_KET = SC_QE + 17408, SC_EBL = SC_KET + 18432, SC_BUF = SC_EBL + 512;
static_assert(2 * SC_BUF <= LDS_MISC, "scan lds");
struct ScanStage { u32x4 att, ke0, ke1, qe0, qe1, eb; };
__device__ __forceinline__ void scan_stage_load(Frame& F, int ci, int h, ScanStage& st) {
    const bf16_t* QE = (const bf16_t*)(F.ws + WS_QE); const bf16_t* KET = (const bf16_t*)(F.ws + WS_KET); const bf16_t* ATT = (const bf16_t*)(F.ws + WS_ATT); const float* EBL = (const float*)(F.ws + WS_EBL);
    int r0, T; chunk_info(ci, r0, T);
    const int i = F.tid;
    st.att = *(const u32x4*)(ATT + (((size_t)ci * 4 + h) * 64 + (i >> 3)) * 64 + 8 * (i & 7));
    st.ke0 = *(const u32x4*)(KET + (((size_t)ci * 4 + h) * 128 + (i >> 3)) * 64 + 8 * (i & 7));
    st.ke1 = *(const u32x4*)(KET + (((size_t)ci * 4 + h) * 128 + 64 + (i >> 3)) * 64 + 8 * (i & 7));
    st.qe0 = *(const u32x4*)(QE + (size_t)(r0 + (i >> 4)) * 512 + h * 128 + 8 * (i & 15));
    st.qe1 = *(const u32x4*)(QE + (size_t)(r0 + 32 + (i >> 4)) * 512 + h * 128 + 8 * (i & 15));
    st.eb = *(const u32x4*)(EBL + (size_t)ci * 512 + h * 128 + 4 * (i & 31));
}
__device__ __forceinline__ void scan_stage_store(Frame& F, int buf, const ScanStage& st) {
    LAS unsigned char* base = F.lds + buf * SC_BUF; const int i = F.tid;
    *(LAS u32x4*)(base + SC_ATT + (i >> 3) * 144 + 16 * (i & 7)) = st.att;
    *(LAS u32x4*)(base + SC_KET + (i >> 3) * 144 + 16 * (i & 7)) = st.ke0;
    *(LAS u32x4*)(base + SC_KET + (64 + (i >> 3)) * 144 + 16 * (i & 7)) = st.ke1;
    *(LAS u32x4*)(base + SC_QE + (i >> 4) * 272 + 16 * (i & 15)) = st.qe0;
    *(LAS u32x4*)(base + SC_QE + (32 + (i >> 4)) * 272 + 16 * (i & 15)) = st.qe1;
    *(LAS u32x4*)(base + SC_EBL + 16 * (i & 31)) = st.eb;
}
__device__ __forceinline__ void scan_load_bv(Frame& F, int ci, int h, int et, int lane, bf16x8 (&Bv)[2]) {
    const bf16_t* VT = (const bf16_t*)(F.ws + WS_VT); const int m = lane & 15, g = lane >> 4;
#pragma unroll
    for (int ks = 0; ks < 2; ++ks) Bv[ks] = *(const bf16x8*)(VT + (((size_t)ci * 4 + h) * 256 + 16 * et + m) * 64 + 32 * ks + 8 * g);
}
__device__ __forceinline__ void gla_scan_prompt_step(Frame& F, int b, int h, int et, int c, f32x4 (&S)[8], ScanStage& st, const bf16x8 (&Bv)[2], bf16x8 (&Bn)[2]) {
    bf16_t* O = (bf16_t*)(F.ws + WS_O);
    const int lane = F.lane, m = lane & 15, g = lane >> 4;
    const int ci = c == 0 ? 0 : b * 32 + c, cn = b * 32 + c + 1, buf = c & 1;
    int r0, T; chunk_info(ci, r0, T);
    if (c + 1 < 33) { scan_stage_load(F, cn, h, st); scan_load_bv(F, cn, h, et, lane, Bn); }
    const LAS unsigned char* base = F.lds + buf * SC_BUF;
    bf16x8 Bs[4];
#pragma unroll
    for (int kk = 0; kk < 4; ++kk) { u32x4 wv; wv.x = cvt_pk_bf16(S[2 * kk][0], S[2 * kk][1]); wv.y = cvt_pk_bf16(S[2 * kk][2], S[2 * kk][3]); wv.z = cvt_pk_bf16(S[2 * kk + 1][0], S[2 * kk + 1][1]); wv.w = cvt_pk_bf16(S[2 * kk + 1][2], S[2 * kk + 1][3]);
        Bs[kk] = __builtin_bit_cast(bf16x8, wv); }
    {
        const int tt0 = 2 * (F.wave >> 2);
        bf16x8 Aa[2][2], Aq[2][4];
#pragma unroll
        for (int ti = 0; ti < 2; ++ti) {
            const int tt = tt0 + ti;
#pragma unroll
            for (int ks = 0; ks < 2; ++ks) Aa[ti][ks] = *(const LAS bf16x8*)(base + SC_ATT + (16 * tt + m) * 144 + 64 * ks + 16 * g);
#pragma unroll
            for (int kk = 0; kk < 4; ++kk) { const u32x2 a0 = *(const LAS u32x2*)(base + SC_QE + (16 * tt + m) * 272 + 64 * kk + 8 * g), a1 = *(const LAS u32x2*)(base + SC_QE + (16 * tt + m) * 272 + 64 * kk + 32 + 8 * g);
                const u32x4 wv = (u32x4){a0.x, a0.y, a1.x, a1.y}; Aq[ti][kk] = __builtin_bit_cast(bf16x8, wv); }
        }
        __builtin_amdgcn_sched_barrier(0);
        f32x4 acc[2], acc2[2];
#pragma unroll
        for (int ti = 0; ti < 2; ++ti) { acc[ti] = (f32x4){0.f, 0.f, 0.f, 0.f}; acc2[ti] = (f32x4){0.f, 0.f, 0.f, 0.f}; }
#pragma unroll
        for (int ks = 0; ks < 2; ++ks) {
#pragma unroll
            for (int ti = 0; ti < 2; ++ti) acc[ti] = __builtin_amdgcn_mfma_f32_16x16x32_bf16(Aa[ti][ks], Bv[ks], acc[ti], 0, 0, 0);
            if (ks == 0) {
#pragma unroll
                for (int ti = 0; ti < 2; ++ti) acc2[ti] = __builtin_amdgcn_mfma_f32_16x16x32_bf16(Aq[ti][0], Bs[0], acc2[ti], 0, 0, 0);
            } else {
#pragma unroll
                for (int ti = 0; ti < 2; ++ti) acc2[ti] = __builtin_amdgcn_mfma_f32_16x16x32_bf16(Aq[ti][2], Bs[2], acc2[ti], 0, 0, 0);
            }
        }
#pragma unroll
        for (int kk = 1; kk < 4; kk += 2) {
#pragma unroll
            for (int ti = 0; ti < 2; ++ti) acc[ti] = __builtin_amdgcn_mfma_f32_16x16x32_bf16(Aq[ti][kk], Bs[kk], acc[ti], 0, 0, 0);
        }
#pragma unroll
        for (int ti = 0; ti < 2; ++ti) {
            const int tt = tt0 + ti;
            const f32x4 a = acc[ti] + acc2[ti];
            bf16_t* op = O + (size_t)(r0 + 16 * tt + 4 * g) * DM + h * 256 + 16 * et + m;
            const unsigned p01 = cvt_pk_bf16(a[0], a[1]), p23 = cvt_pk_bf16(a[2], a[3]);
            if (16 * tt + 4 * g + 0 < T) op[0] = (bf16_t)(p01 & 0xffffu);
            if (16 * tt + 4 * g + 1 < T) op[(size_t)DM] = (bf16_t)(p01 >> 16);
            if (16 * tt + 4 * g + 2 < T) op[(size_t)2 * DM] = (bf16_t)(p23 & 0xffffu);
            if (16 * tt + 4 * g + 3 < T) op[(size_t)3 * DM] = (bf16_t)(p23 >> 16);
        }
    }
#pragma unroll
    for (int hf = 0; hf < 2; ++hf) {
        bf16x8 Ak[4][2]; f32x4 ebv[4];
#pragma unroll
        for (int d4 = 0; d4 < 4; ++d4) {
            const int dt = 4 * hf + d4;
#pragma unroll
            for (int ks = 0; ks < 2; ++ks) Ak[d4][ks] = *(const LAS bf16x8*)(base + SC_KET + (16 * dt + m) * 144 + 64 * ks + 16 * g);
            ebv[d4] = *(const LAS f32x4*)(base + SC_EBL + (16 * dt + 4 * g) * 4);
        }
        __builtin_amdgcn_sched_barrier(0);
#pragma unroll
        for (int ks = 0; ks < 2; ++ks)
#pragma unroll
            for (int d4 = 0; d4 < 4; ++d4) S[4 * hf + d4] = __builtin_amdgcn_mfma_f32_16x16x32_bf16(Ak[d4][ks], Bv[ks], S[4 * hf + d4], 0, 0, 0);
#pragma unroll
        for (int d4 = 0; d4 < 4; ++d4) S[4 * hf + d4] = S[4 * hf + d4] * ebv[d4];
        __builtin_amdgcn_sched_barrier(0);
    }
    if (c + 1 < 33) scan_stage_store(F, buf ^ 1, st);
    asm volatile("s_waitcnt lgkmcnt(0)\n\ts_barrier" ::: "memory");
}
__device__ __forceinline__ void gla_scan_prompt_unit(Frame& F, int o, int b, int h, int hf) {
    const int lane = F.lane, w = F.wave, m = lane & 15, g = lane >> 4, et = 4 * hf + (w & 3);
    f32x4 S[8];
#pragma unroll
    for (int dt = 0; dt < 8; ++dt) S[dt] = (f32x4){0.f, 0.f, 0.f, 0.f};
    ScanStage st; bf16x8 Ba[2], Bb[2];
    __syncthreads();
    scan_stage_load(F, 0, h, st); scan_load_bv(F, 0, h, et, lane, Ba);
    scan_stage_store(F, 0, st);
    __syncthreads();
    for (int c = 0; c < 33; c += 2) {
        gla_scan_prompt_step(F, b, h, et, c, S, st, Ba, Bb);
        if (c + 1 < 33) gla_scan_prompt_step(F, b, h, et, c + 1, S, st, Bb, Ba);
    }
    float* dst = F.out + O_GP + (((size_t)(o * NBATCH + b) * 4 + h) * 128 + 4 * g) * 256 + 16 * et + m;
    if (w < 4) {
#pragma unroll
        for (int dt = 0; dt < 8; ++dt) {
#pragma unroll
            for (int r = 0; r < 4; ++r) dst[r * 256] = S[dt][r];
            dst += 16 * 256;
        }
    }
}
__device__ __forceinline__ void gla_scan_phase(Frame& F, int o, bool late_convert) {
    const int lane = F.lane, w = F.wave, m = lane & 15, g = lane >> 4;
    const int npw = F.G > 128 ? 128 : F.G;
    if (F.blk < npw) {
        if (npw == 128) {
            const int xcd = F.blk & 7, slot = F.blk >> 3, grp = xcd * 4 + (slot >> 2);
            gla_scan_prompt_unit(F, o, grp >> 2, grp & 3, slot & 3);
        } else { for (int pu = F.blk; pu < 128; pu += npw) gla_scan_prompt_unit(F, o, pu >> 4, (pu >> 2) & 3, pu & 3); }
    }
    if (late_convert && F.G > 128 && F.blk >= 128) convert_weights(F, 1, (F.blk - 128) * 8 + w, (F.G - 128) * 8, F.blk - 128, F.G - 128);
    if (F.G <= 128 || F.blk >= 128) {
        const int first = F.G > 128 ? (F.blk - 128) * 8 + w : F.blk * 8 + w, stride = F.G > 128 ? (F.G - 128) * 8 : F.G * 8;
        f32x4 S[8];
        for (int su = first; su < 2048; su += stride) {
            const int db = su >> 6, h = (su >> 4) & 3, et = su & 15;
            const float* src = F.in[IN_SGLA] + (((size_t)(o * DBATCH + db) * 4 + h) * 128) * 256 + 16 * et + m;
#pragma unroll
            for (int dt = 0; dt < 8; ++dt)
#pragma unroll
                for (int r = 0; r < 4; ++r) S[dt][r] = src[(size_t)(16 * dt + 4 * g + r) * 256];
            gla_scan_chunk(F, 257 + db, h, et, S, lane);
            float* dst = F.out + O_GS + (((size_t)(o * DBATCH + db) * 4 + h) * 128) * 256 + 16 * et + m;
#pragma unroll
            for (int dt = 0; dt < 8; ++dt)
#pragma unroll
                for (int r = 0; r < 4; ++r) dst[(size_t)(16 * dt + 4 * g + r) * 256] = S[dt][r];
        }
    }
}
__device__ __forceinline__ void gla_post_phase(Frame& F, int o) {
    const float* proj = (const float*)(F.ws + WS_PROJ); const bf16_t* O = (const bf16_t*)(F.ws + WS_O); bf16_t* act = (bf16_t*)(F.ws + WS_ACT);
    const int lane = F.lane;
    const f32x4 gn = *(const f32x4*)(F.in[IN_GNORM] + o * 256 + 4 * lane);
    for (int row = F.blk * 8 + F.wave; row < MREAL; row += F.G * 8) {
        f32x4 v[4], gg[4]; float sq[4];
#pragma unroll
        for (int h = 0; h < 4; ++h) { { const u32x2 ob = *(const u32x2*)(O + (size_t)row * DM + h * 256 + 4 * lane); v[h] = (f32x4){bf_lo(ob.x), bf_hi(ob.x), bf_lo(ob.y), bf_hi(ob.y)}; } { const u32x2 gb = *(const u32x2*)((const bf16_t*)proj + (size_t)row * PLB + OG + h * 256 + 4 * lane); gg[h] = (f32x4){bf_lo(gb.x), bf_hi(gb.x), bf_lo(gb.y), bf_hi(gb.y)}; } }
#pragma unroll
        for (int h = 0; h < 4; ++h) sq[h] = (v[h][0] * v[h][0] + v[h][1] * v[h][1]) + (v[h][2] * v[h][2] + v[h][3] * v[h][3]);
#pragma unroll
        for (int o2 = 1; o2 < 64; o2 <<= 1) {
#pragma unroll
            for (int h = 0; h < 4; ++h) sq[h] += __shfl_xor(sq[h], o2);
        }
#pragma unroll
        for (int h = 0; h < 4; ++h) {
            const float rs = rsqrtf(sq[h] * (1.f / 256.f) + EPS);
            f32x4 y;
#pragma unroll
            for (int i = 0; i < 4; ++i) y[i] = v[h][i] * rs * gn[i] * silu_f(gg[h][i]);
            u32x2 wv; wv.x = cvt_pk_bf16(y[0], y[1]); wv.y = cvt_pk_bf16(y[2], y[3]);
            *(u32x2*)(act + (size_t)row * DM + h * 256 + 4 * lane) = wv;
        }
    }
}
__device__ __forceinline__ void final_phase(Frame& F) {
    const bf16_t* XBf = (const bf16_t*)(F.ws + WS_XB); const float* ssf = (const float*)(F.ws + WS_SSP) + (size_t)8 * MP * 16;
    const int lane = F.lane;
    for (int row = F.blk * 8 + F.wave; row < MREAL; row += F.G * 8) {
        float* dst;
        if (row < ROW_META) dst = F.out + O_YP + (size_t)row * DM; else if (row >= ROW_SAMP) dst = F.out + O_YS + (size_t)(row - ROW_SAMP) * DM; else continue;
        float rs;
        if (row < TR0) rs = row_rstd(ssf, row);
        else { const float* p = (const float*)(F.ws + WS_SST) + ((size_t)8 * TROWS + (row - TR0)) * 64; float sacc = 0.f;
#pragma unroll
            for (int i = 0; i < 16; ++i) { const f32x4 a = *(const f32x4*)(p + 4 * i); sacc += (a[0] + a[1]) + (a[2] + a[3]); }
            rs = rsqrtf(sacc * (1.f / DM) + EPS); }
#pragma unroll
        for (int j = 0; j < 4; ++j) {
            const u32x2 xb = *(const u32x2*)(XBf + (size_t)row * DM + 256 * j + 4 * lane); const f32x4 v = (f32x4){bf_lo(xb.x), bf_hi(xb.x), bf_lo(xb.y), bf_hi(xb.y)}, gn = *(const f32x4*)(F.in[IN_NFIN] + 256 * j + 4 * lane);
            *(f32x4*)(dst + 256 * j + 4 * lane) = v * rs * gn;
        }
    }
}

constexpr int NPHASE = 30;
__global__ void __launch_bounds__(512, 2) mega_fwd(Args args) {
    extern __shared__ __attribute__((aligned(16))) unsigned char lds_raw[];
    volatile LAS unsigned* misc = (volatile LAS unsigned*)((LAS unsigned char*)lds_raw + LDS_MISC);
    if (threadIdx.x < 8) misc[threadIdx.x] = 0u;
    __syncthreads();
    const int lo = args.ph_lo, hi = args.ph_hi;
    const bool multi = (hi - lo) > 1;
    XcdBarrier bar; bar.bar = (unsigned*)(args.ws + WS_CTL) + CW_BAR; bar.x = 0; bar.st = misc;
    if (multi) bar = xcd_barrier_post((unsigned*)(args.ws + WS_CTL) + CW_BAR, misc);
#ifndef PH_MASK
#define PH_MASK 0xffu
#endif
#ifndef DUP_MASK
#define DUP_MASK 0u
#endif
#define IN(k) (lo <= (k) && (k) < hi)
#define SEAM(k) do { if (IN((k) + 1)) xcd_barrier(bar); } while (0)
#define PHASE_FRAME() Frame F; { int tid_l = threadIdx.x; asm volatile("" : "+v"(tid_l)); size_t zoff = 0; asm volatile("" : "+s"(zoff)); unsigned char* ws_l = args.ws + zoff; \
    F.lds = (LAS unsigned char*)lds_raw; F.tid = tid_l; F.lane = tid_l & 63; F.wave = __builtin_amdgcn_readfirstlane(tid_l >> 6); F.G = gridDim.x; F.blk = blockIdx.x; \
    F.in = args.in; F.out = args.out; F.ws = ws_l; F.ctl = (unsigned*)(ws_l + WS_CTL); } unsigned char* ws = F.ws; float* ssb = (float*)(F.ws + WS_SSP); float* sstb = (float*)(F.ws + WS_SST); (void)ssb; (void)sstb; (void)ws
    if ((PH_MASK & 1u) && IN(0)) { PHASE_FRAME(); p0_prologue(F); if (DUP_MASK & 1u) { xcd_barrier(bar); p0_prologue(F); } SEAM(0); }
    for (int l = 0; l < 4; ++l) {
        const int base = 1 + 7 * l, odd = l & 1, eo = l >> 1;
        if ((PH_MASK & 2u) && IN(base + 0)) {
            PHASE_FRAME();
            pg8::Gemm g{(const bf16_t*)(ws + WS_XB), odd ? (const bf16_t*)(ws + WS_WINO) + (size_t)eo * NO * DM : (const bf16_t*)(ws + WS_WINE) + (size_t)eo * NE * DM, TR0, odd ? 3072 : NE, DM};
            pg8::StaticOrder S; S.init(g.M, g.N, F.G, F.blk);
            const int pm0 = panel_rstd_to_lds(F, ssb + (size_t)l * MP * 16, g.M, g.N);
            pg8::EpiProj E{(float*)(ws + WS_PROJ), PLD, ssb + (size_t)l * MP * 16, odd ? 0 : 1, (bf16_t*)(ws + WS_KVB), (_Float16*)(ws + WS_KIH), F.out, eo, (const LAS float*)(F.lds + LDS_RSL), pm0, (bf16_t*)(ws + WS_QE), (_Float16*)(ws + WS_KEB)};
            pg8::gemm_phase(F.lds, g, S, E, F.tid);
            { SkinnyEpi K{}; K.C = (float*)(ws + WS_PROJ); K.ldc = PLD; K.even = odd ? 0 : 1; K.kvb = (bf16_t*)(ws + WS_KVB); K.kih = (_Float16*)(ws + WS_KIH); K.out = F.out; K.eidx = eo; K.qb16 = (bf16_t*)(ws + WS_QE); K.qih = (_Float16*)(ws + WS_KEB);
              if (odd) skinny_phase<SKM_PROJ, 2, 4>(F, g.A, g.Bt, DM, 192, sstb + (size_t)l * TROWS * 64, K); else skinny_phase<SKM_PROJ, 2, 3>(F, g.A, g.Bt, DM, 117, sstb + (size_t)l * TROWS * 64, K); }
            SEAM(base + 0);
        }
        if (!odd) {
            if ((PH_MASK & 4u) && IN(base + 1)) { PHASE_FRAME(); even_mixer_phase(F, eo, l); if (DUP_MASK & 2u) { xcd_barrier(bar); even_mixer_phase(F, eo, l + 4); } SEAM(base + 3); }
        } else {
            if ((PH_MASK & 8u) && IN(base + 1)) { PHASE_FRAME(); for (int ci = F.blk; ci < NCHUNK; ci += F.G) gla_prep_unit(F, eo, ci, ssb + (size_t)l * MP * 16, sstb + (size_t)l * TROWS * 64); if (DUP_MASK & 4u) { xcd_barrier(bar); for (int ci = F.blk; ci < NCHUNK; ci += F.G) gla_prep_unit(F, eo, ci, ssb + (size_t)l * MP * 16, sstb + (size_t)l * TROWS * 64); } SEAM(base + 1); }
            if ((PH_MASK & 16u) && IN(base + 2)) { PHASE_FRAME(); gla_scan_phase(F, eo, l == 1); if (DUP_MASK & 8u) { xcd_barrier(bar); gla_scan_phase(F, eo, false); } SEAM(base + 2); }
            if ((PH_MASK & 32u) && IN(base + 3)) { PHASE_FRAME(); gla_post_phase(F, eo); if (DUP_MASK & 16u) { xcd_barrier(bar); gla_post_phase(F, eo); } SEAM(base + 3); }
        }
        if ((PH_MASK & 64u) && IN(base + 4)) {
            PHASE_FRAME();
            pg8::Gemm g{(const bf16_t*)(ws + WS_ACT), odd ? (const bf16_t*)(ws + WS_WOUTO) + (size_t)eo * DM * DM : (const bf16_t*)(ws + WS_WOUTE) + (size_t)eo * DM * DM, TR0, DM, DM};
            pg8::StaticOrder S; S.init(g.M, g.N, F.G, F.blk);
            pg8::EpiRes E{(bf16_t*)(ws + WS_XB), ssb + (size_t)(4 + l) * MP * 16, l == 0 ? F.in[IN_XP] : nullptr};
            pg8::gemm_phase(F.lds, g, S, E, F.tid);
            { SkinnyEpi K{}; K.XB = (bf16_t*)(ws + WS_XB); K.sst_next = sstb + (size_t)(4 + l) * TROWS * 64;
              skinny_phase<SKM_RES, 2, 2>(F, g.A, g.Bt, DM, 64, nullptr, K); }
            SEAM(base + 4);
        }
        if ((PH_MASK & 128u) && IN(base + 5)) {
            PHASE_FRAME();
            pg8::Gemm g{(const bf16_t*)(ws + WS_XB), (const bf16_t*)(ws + WS_WGU) + (size_t)l * NGU * DM, TR0, NGU, DM};
            pg8::StaticOrder S; S.init(g.M, g.N, F.G, F.blk);
            const int pm0 = panel_rstd_to_lds(F, ssb + (size_t)(4 + l) * MP * 16, g.M, g.N);
            pg8::EpiGU E{(bf16_t*)(ws + WS_HFF), ssb + (size_t)(4 + l) * MP * 16, (const LAS float*)(F.lds + LDS_RSL), pm0};
            pg8::gemm_phase(F.lds, g, S, E, F.tid);
            { SkinnyEpi K{}; K.H = (bf16_t*)(ws + WS_HFF);
              skinny_phase<SKM_GU, 5, 2>(F, g.A, g.Bt, DM, 176, sstb + (size_t)(4 + l) * TROWS * 64, K, F.G == 256 ? 128 : 0); }
            SEAM(base + 5);
        }
        if ((PH_MASK & 64u) && IN(base + 6)) {
            PHASE_FRAME();
            pg8::Gemm g{(const bf16_t*)(ws + WS_HFF), (const bf16_t*)(ws + WS_WDN) + (size_t)l * DM * DFF, TR0, DM, DFF};
            pg8::StaticOrder S; S.init(g.M, g.N, F.G, F.blk);
            pg8::EpiRes E{(bf16_t*)(ws + WS_XB), ssb + (size_t)(l < 3 ? (l + 1) : 8) * MP * 16, nullptr};
            pg8::gemm_phase(F.lds, g, S, E, F.tid);
            { SkinnyEpi K{}; K.XB = (bf16_t*)(ws + WS_XB); K.sst_next = sstb + (size_t)(l < 3 ? (l + 1) : 8) * TROWS * 64;
              skinny_phase<SKM_RES, 2, 2>(F, g.A, g.Bt, DFF, 64, nullptr, K); }
            SEAM(base + 6);
        }
    }
    if (IN(29)) { PHASE_FRAME(); final_phase(F); if (DUP_MASK & 32u) { xcd_barrier(bar); final_phase(F); } }
#undef IN
#undef SEAM
}

#ifdef DBG_COPY
__global__ void dbg_copy(const unsigned char* ws, float* out) {
    const bf16_t* src = (const bf16_t*)(ws + DBG_SRC);
    for (size_t i = (size_t)blockIdx.x * blockDim.x + threadIdx.x; i < (size_t)DBG_N; i += (size_t)gridDim.x * blockDim.x) out[i] = bf_lo((unsigned)src[i]);
}
#endif
#ifndef MK_ONE_LAUNCH
#define MK_ONE_LAUNCH 1
#endif
extern "C" void kernel_launch(void* const* d_in, const int* in_sizes, int n_in, void* d_out, int out_size, void* d_ws, size_t ws_size, hipStream_t stream) {
    static int grid = 0;
    if (grid == 0) {
        if (n_in != 24 || ws_size < WS_END || (size_t)out_size != O_END) { grid = -1; return; }
        int dev = 0, cus = 0;
        if (hipGetDevice(&dev) != hipSuccess || hipDeviceGetAttribute(&cus, hipDeviceAttributeMultiprocessorCount, dev) != hipSuccess) { grid = -1; return; }
        if (hipFuncSetAttribute((const void*)mega_fwd, hipFuncAttributeMaxDynamicSharedMemorySize, LDS_BYTES) != hipSuccess) { grid = -1; return; }
        int per_cu = 0;
        (void)hipOccupancyMaxActiveBlocksPerMultiprocessor(&per_cu, (const void*)mega_fwd, 512, LDS_BYTES);
        (void)hipGetLastError();
        grid = cus;
    }
    if (grid < 0) return;
    (void)hipMemsetAsync((char*)d_ws + WS_CTL, 0, CTL_BYTES, stream);
#ifdef DBG_FILL
    (void)hipMemsetAsync(d_out, 0, (size_t)out_size * 4, stream);
#endif
    Args a{};
    for (int i = 0; i < 24; ++i) a.in[i] = (const float*)d_in[i];
    a.out = (float*)d_out; a.ws = (unsigned char*)d_ws;
#if MK_ONE_LAUNCH
    a.ph_lo = 0; a.ph_hi = NPHASE;
    hipLaunchKernelGGL(mega_fwd, dim3(grid), dim3(512), LDS_BYTES, stream, a);
#else
#ifndef PH_LIMIT
#define PH_LIMIT NPHASE
#endif
    for (int p = 0; p < PH_LIMIT; ++p) {
        const int l = (p - 1) / 7, k = (p - 1) % 7;
        if (p >= 1 && p <= 28 && !(l & 1) && (k == 2 || k == 3)) continue;
        a.ph_lo = p; a.ph_hi = p + 1;
        hipLaunchKernelGGL(mega_fwd, dim3(grid), dim3(512), LDS_BYTES, stream, a);
    }
#ifdef DBG_COPY
    hipLaunchKernelGGL(dbg_copy, dim3(1024), dim3(256), 0, stream, (const unsigned char*)d_ws, (float*)d_out);
#endif
#endif
}
```

```cpp
#include <hip/hip_runtime.h>
#include <stdint.h>

#define LAS __attribute__((address_space(3)))
#define GAS __attribute__((address_space(1)))
typedef unsigned short u16;
typedef unsigned short bf16_t;
typedef short bf16x8 __attribute__((ext_vector_type(8)));
typedef _Float16 f16x8 __attribute__((ext_vector_type(8)));
typedef _Float16 f16x4 __attribute__((ext_vector_type(4)));
typedef float f32x2 __attribute__((ext_vector_type(2)));
typedef float f32x4 __attribute__((ext_vector_type(4)));
typedef float f32x16 __attribute__((ext_vector_type(16)));
typedef unsigned u32x2 __attribute__((ext_vector_type(2)));
typedef unsigned u32x4 __attribute__((ext_vector_type(4)));

constexpr int DM = 1024, NBATCH = 8, SEQ = 2048, NMETA = 16, LP = 2064, DBATCH = 32, DSEQ = 4, PAST = 8192, PAGE = 128, NPAGES = 64, NPOOLPG = 2560;
constexpr int ROW_META = 16384, ROW_SAMP = 16400, MREAL = 16528, MP = 16640;
constexpr int NE = 2048, NO = 3328, NGU = 5632, DFF = 2816, PLD = 3328;
constexpr int EIN = 1864, OIN = 3088;
constexpr int EQ = 0, EQI = 512, EU = 1024, EK = 1536, EV = 1664, EKI = 1792, EWI = 1856;
constexpr int OQ = 0, OKK = 512, OV = 1024, OG = 2048, OGD = 3072;
constexpr int PLB = 3072;
constexpr int NCHUNK = 289;
constexpr float EPS = 1e-6f;

constexpr size_t MiB = 1u << 20;
constexpr size_t WS_CTL = 0, CTL_BYTES = 4 * MiB;
constexpr size_t WS_WINE = 4 * MiB, WS_WOUTE = 12 * MiB, WS_WINO = 16 * MiB, WS_WOUTO = 29 * MiB, WS_WGU = 33 * MiB, WS_WDN = 77 * MiB;
constexpr size_t WS_X = 100 * MiB, WS_XB = 166 * MiB, WS_PROJ = 199 * MiB, WS_ACT = 411 * MiB, WS_HFF = 444 * MiB, WS_KVB = 534 * MiB, WS_KIH = 543 * MiB;
constexpr size_t WS_QE = 546 * MiB, WS_KET = 563 * MiB, WS_VT = 582 * MiB, WS_ATT = 619 * MiB, WS_EBL = 629 * MiB, WS_O = 630 * MiB, WS_SSP = 696 * MiB, WS_KEB = 706 * MiB, WS_SST = 723 * MiB, WS_END = 724 * MiB;
static_assert(WS_X + (size_t)MP * DM * 4 <= WS_XB && WS_XB + (size_t)MP * DM * 2 <= WS_PROJ && WS_PROJ + (size_t)MP * PLD * 4 <= WS_ACT, "ws map");
static_assert(WS_ACT + (size_t)MP * DM * 2 <= WS_HFF && WS_HFF + (size_t)MP * DFF * 2 <= WS_KVB && WS_KVB + (size_t)MP * 256 * 2 <= WS_KIH && WS_KIH + (size_t)MP * 64 * 2 <= WS_QE, "ws map");
static_assert(WS_QE + (size_t)MP * 512 * 2 <= WS_KET && WS_KET + (size_t)NCHUNK * 4 * 128 * 64 * 2 <= WS_VT && WS_VT + (size_t)NCHUNK * 4 * 256 * 64 * 2 <= WS_ATT, "ws map");
static_assert(WS_ATT + (size_t)NCHUNK * 4 * 64 * 64 * 2 <= WS_EBL && WS_EBL + (size_t)NCHUNK * 512 * 4 <= WS_O && WS_O + (size_t)MP * DM * 4 <= WS_SSP && WS_SSP + (size_t)9 * MP * 16 * 4 <= WS_KEB && WS_KEB + (size_t)MP * 512 * 2 <= WS_SST && WS_SST + (size_t)9 * 160 * 64 * 4 <= WS_END, "ws map");
static_assert(WS_WINE + 2 * (size_t)NE * DM * 2 <= WS_WOUTE && WS_WINO + 2 * (size_t)NO * DM * 2 <= WS_WOUTO && WS_WGU + 4 * (size_t)NGU * DM * 2 <= WS_WDN && WS_WDN + 4 * (size_t)DM * DFF * 2 <= WS_X, "ws map");
constexpr int CW_BAR = 1024;
constexpr int CW_QUEUE = 8192;
constexpr int CW_SS = 16384;
static_assert((CW_SS + 9 * MP) * 4 <= (int)CTL_BYTES, "ctl");

constexpr size_t O_YP = 0, O_YS = O_YP + (size_t)NBATCH * SEQ * DM, O_KP = O_YS + (size_t)DBATCH * DSEQ * DM, O_VP = O_KP + (size_t)2 * NBATCH * LP * 128,
                 O_KIP = O_VP + (size_t)2 * NBATCH * LP * 128, O_KS = O_KIP + (size_t)2 * NBATCH * LP * 64, O_VS = O_KS + (size_t)2 * DBATCH * DSEQ * 128,
                 O_KIS = O_VS + (size_t)2 * DBATCH * DSEQ * 128, O_PP = O_KIS + (size_t)2 * DBATCH * DSEQ * 64, O_PS = O_PP + (size_t)2 * NBATCH * 15 * 512,
                 O_GP = O_PS + (size_t)2 * DBATCH * 15 * 512, O_GS = O_GP + (size_t)2 * NBATCH * 4 * 128 * 256, O_END = O_GS + (size_t)2 * DBATCH * 4 * 128 * 256;

constexpr int LDS_MISC = 159744, LDS_BYTES = 160000;

__device__ __forceinline__ unsigned cvt_pk_bf16(float lo, float hi) { unsigned r; asm volatile("v_cvt_pk_bf16_f32 %0, %1, %2" : "=v"(r) : "v"(lo), "v"(hi)); return r; }
__device__ __forceinline__ float bf_lo(unsigned u) { return __builtin_bit_cast(float, u << 16); }
__device__ __forceinline__ float bf_hi(unsigned u) { return __builtin_bit_cast(float, u & 0xffff0000u); }
__device__ __forceinline__ float wave_sum(float v) {
#pragma unroll
    for (int o = 1; o < 64; o <<= 1) v += __shfl_xor(v, o);
    return v;
}
__device__ __forceinline__ int prow(int b, int p) { return p < NMETA ? ROW_META + p : b * SEQ + p - NMETA; }
__device__ __forceinline__ unsigned mbcnt64(unsigned long long m) { return __builtin_amdgcn_mbcnt_hi((unsigned)(m >> 32), __builtin_amdgcn_mbcnt_lo((unsigned)m, 0u)); }
__device__ __forceinline__ float row_rstd(const float* ssp, int row) {
    const f32x4 a = *(const f32x4*)(ssp + (size_t)row * 16), b = *(const f32x4*)(ssp + (size_t)row * 16 + 4), c = *(const f32x4*)(ssp + (size_t)row * 16 + 8), d = *(const f32x4*)(ssp + (size_t)row * 16 + 12);
    const float s = (((a[0] + a[1]) + (a[2] + a[3])) + ((b[0] + b[1]) + (b[2] + b[3]))) + (((c[0] + c[1]) + (c[2] + c[3])) + ((d[0] + d[1]) + (d[2] + d[3])));
    return rsqrtf(s * (1.f / DM) + EPS);
}
__device__ __forceinline__ float tail_rstd(const float* sst, int trow) {
    const float* p = sst + (size_t)trow * 64; float s = 0.f;
#pragma unroll
    for (int i = 0; i < 16; ++i) { const f32x4 a = *(const f32x4*)(p + 4 * i); s += (a[0] + a[1]) + (a[2] + a[3]); }
    return rsqrtf(s * (1.f / DM) + EPS);
}
__device__ __forceinline__ float tail_rstd_batched(const float* sst, int trow) {
    const float* p = sst + (size_t)trow * 64; float s = 0.f; f32x4 a[16];
#pragma unroll
    for (int i = 0; i < 16; ++i) a[i] = *(const f32x4*)(p + 4 * i);
    __builtin_amdgcn_sched_barrier(0);
#pragma unroll
    for (int i = 0; i < 16; ++i) s += (a[i][0] + a[i][1]) + (a[i][2] + a[i][3]);
    return rsqrtf(s * (1.f / DM) + EPS);
}
__device__ __forceinline__ float silu_f(float x) { return x * __builtin_amdgcn_rcpf(1.f + __expf(-x)); }

#define XB_TMO      128
#define XB_XCNT(j)  (256  + 64 * (j))
#define XB_XSUB(j)  (1280 + 64 * (j))
#define XB_XGEN(j)  (2304 + 64 * (j))
#define XB_TOP      3328
#define XB_TOPGEN   3392
#define XCD_BAR_WORDS 3456
#define XB_SPIN_CAP (1u << 18)
__device__ __forceinline__ unsigned xb_ld(unsigned* p)              { return __hip_atomic_load(p, __ATOMIC_RELAXED, __HIP_MEMORY_SCOPE_AGENT); }
__device__ __forceinline__ unsigned xb_add(unsigned* p, unsigned v) { return __hip_atomic_fetch_add(p, v, __ATOMIC_RELAXED, __HIP_MEMORY_SCOPE_AGENT); }
__device__ __forceinline__ unsigned xb_xcc_id() { return (unsigned)__builtin_amdgcn_s_getreg((3 << 11) | 20) & 0xFu; }
#define XB_SPIN(cond, bar) do { unsigned _sp = 0; while (cond) { __builtin_amdgcn_s_sleep(1); \
    if ((++_sp & 255u) == 0u) { if (xb_ld(&(bar)[XB_TMO])) break; if (_sp > XB_SPIN_CAP) { atomicAdd(&(bar)[XB_TMO], 1u); break; } } } } while (0)
struct XcdBarrier { unsigned* bar; unsigned x; volatile LAS unsigned* st; };
__device__ __forceinline__ XcdBarrier xcd_barrier_post(unsigned* bar, volatile LAS unsigned* st) {
    XcdBarrier b; b.bar = bar; b.x = xb_xcc_id(); b.st = st;
    if (threadIdx.x == 0) (void)xb_add(&bar[XB_XCNT(b.x)], 1u);
    return b;
}
__device__ __forceinline__ void xcd_barrier_complete(unsigned* bar, unsigned x, unsigned& nloc, unsigned& nx) {
    const unsigned G = gridDim.x * gridDim.y * gridDim.z;
    unsigned sum, cnt, mine, sp = 0u;
    for (;;) {
        sum = 0u; cnt = 0u; mine = 0u;
#pragma unroll
        for (unsigned j = 0; j < 16; ++j) { const unsigned c = xb_ld(&bar[XB_XCNT(j)]); sum += c; cnt += (c > 0u) ? 1u : 0u; mine = (j == x) ? c : mine; }
        if (sum == G) break;
        __builtin_amdgcn_s_sleep(1);
        if ((++sp & 255u) == 0u) { if (xb_ld(&bar[XB_TMO])) break; if (sp > XB_SPIN_CAP) { atomicAdd(&bar[XB_TMO], 1u); break; } }
    }
    nloc = mine > 0u ? mine : 1u; nx = cnt > 0u ? cnt : 1u;
}
__device__ __forceinline__ void xcd_barrier(const XcdBarrier& b) {
    asm volatile("s_waitcnt vmcnt(0)" ::: "memory");
    __syncthreads();
    if (threadIdx.x == 0) {
        unsigned* bar = b.bar;
        __builtin_amdgcn_s_waitcnt(0);
        unsigned nloc = b.st[0], nx = b.st[1];
        if (nloc == 0u) { xcd_barrier_complete(bar, b.x, nloc, nx); b.st[0] = nloc; b.st[1] = nx; }
        const unsigned old = xb_add(&bar[XB_XSUB(b.x)], 1u);
        const unsigned gen = old / nloc;
        if (old + 1u == (gen + 1u) * nloc) {
            __builtin_amdgcn_fence(__ATOMIC_RELEASE, "agent");
            asm volatile("s_waitcnt vmcnt(0)" ::: "memory");
            const unsigned og = xb_add(&bar[XB_TOP], 1u);
            const unsigned tg = og / nx;
            if (og + 1u == (tg + 1u) * nx) xb_add(&bar[XB_TOPGEN], 1u);
            else XB_SPIN(xb_ld(&bar[XB_TOPGEN]) == tg, bar);
            __builtin_amdgcn_fence(__ATOMIC_ACQUIRE, "agent");
            xb_add(&bar[XB_XGEN(b.x)], 1u);
            asm volatile("s_waitcnt vmcnt(0)" ::: "memory");
        } else {
            XB_SPIN(xb_ld(&bar[XB_XGEN(b.x)]) == gen, bar);
            __builtin_amdgcn_fence(__ATOMIC_ACQUIRE, "agent");
            asm volatile("s_waitcnt vmcnt(0)" ::: "memory");
        }
    }
    __syncthreads();
}

__device__ __forceinline__ void proj_even_extras(int row, int col, const f32x4 v, bf16_t* kvb, _Float16* kih, float* out, int eidx) {
    size_t ooff; int width, oc;
    if (col < EV) { ooff = O_KP; width = 128; oc = col - EK; } else if (col < EKI) { ooff = O_VP; width = 128; oc = col - EV; } else { ooff = O_KIP; width = 64; oc = col - EKI; }
    if (col < EKI) { u32x2 w; w.x = cvt_pk_bf16(v[0], v[1]); w.y = cvt_pk_bf16(v[2], v[3]); *(u32x2*)(kvb + (size_t)row * 256 + (col - EK)) = w; }
    else { f16x4 h; h[0] = (_Float16)v[0]; h[1] = (_Float16)v[1]; h[2] = (_Float16)v[2]; h[3] = (_Float16)v[3]; *(f16x4*)(kih + (size_t)row * 64 + (col - EKI)) = h; }
    if (row < ROW_META) *(f32x4*)(out + ooff + ((size_t)(eidx * NBATCH + (row >> 11)) * LP + NMETA + (row & 2047)) * width + oc) = v;
    else if (row < ROW_SAMP) { for (int bb = 0; bb < NBATCH; ++bb) *(f32x4*)(out + ooff + ((size_t)(eidx * NBATCH + bb) * LP + (row - ROW_META)) * width + oc) = v; }
    else if (row < MREAL) { const size_t so = col < EV ? O_KS : col < EKI ? O_VS : O_KIS; *(f32x4*)(out + so + ((size_t)eidx * DBATCH * DSEQ + (row - ROW_SAMP)) * width + oc) = v; }
}

namespace pg8 {
constexpr int BM = 256, BK = 64, HALF = 128, HTB = HALF * BK * 2, STAGE_BYTES = 8 * HTB, NXCD = 8, WGM = 8;
__host__ __device__ __forceinline__ int lds_byte(int r, int c) { const int st = (r >> 4) * 2 + (c >> 5), rr = r & 15, cc = c & 31, ob = rr * 64 + cc * 2; return st * 1024 + (ob ^ (((ob >> 9) & 1) << 5)); }
__host__ __device__ __forceinline__ void stage_rc(int b, int& R, int& C) { const int st = b / 1024, sb = b % 1024, swz = sb ^ (((sb >> 9) & 1) << 5); R = (st >> 1) * 16 + swz / 64; C = (st & 1) * 32 + (swz % 64) / 2; }
__host__ __device__ __forceinline__ int perm32(int rho) { const int n = rho >> 4, i = rho & 15; return 8 * (i >> 2) + 4 * n + (i & 3); }
struct Unit { int pm, pn; };
struct Gemm { const bf16_t* A; const bf16_t* Bt; int M, N, K; };
struct StaticOrder {
    int nM, nN, nwg, G, c;
    __host__ __device__ void init(int M, int N, int G_, int c_) { nM = M / BM; nN = N / BM; nwg = nM * nN; G = G_; c = c_; }
    __host__ __device__ bool next(int i, Unit& u) const {
        const long L = (long)i * G + c; if (L >= nwg) return false;
        int wgid = (int)L; { const int q = nwg / NXCD, r = nwg % NXCD, xcd = wgid % NXCD, off = wgid / NXCD; wgid = (xcd < r ? xcd * (q + 1) : r * (q + 1) + (xcd - r) * q) + off; }
        const int nig = WGM * nN, gid = wgid / nig, fm = gid * WGM, gsz = (nM - fm) < WGM ? (nM - fm) : WGM;
        u.pm = fm + ((wgid % nig) % gsz); u.pn = (wgid % nig) / gsz; return true;
    }
    __device__ __forceinline__ void a_ready(const Unit&) const {}
    __device__ __forceinline__ void done(const Unit&) const {}
};

struct EpiProj {
    static constexpr bool PERM = true, AFTER_DRAIN = false;
    float* C; int ldc; const float* ss; int even; bf16_t* kvb; _Float16* kih; float* out; int eidx; const LAS float* rsl; int pm0; bf16_t* qb16; _Float16* qih;
    __device__ __forceinline__ void operator()(const f32x4 (&acc)[2][2][4][2], const Unit& u, int wr, int wc, int fr, int fq) const {
        const int row0 = u.pm * BM + wr * 64 + fr, col0 = u.pn * BM + wc * 32 + 8 * fq;
#pragma unroll
        for (int ai = 0; ai < 2; ++ai)
#pragma unroll
            for (int m = 0; m < 4; ++m) {
                const int row = row0 + ai * HALF + m * 16;
                const float rs = u.pm == pm0 ? rsl[row - pm0 * BM] : row_rstd(ss, row);
#pragma unroll
                for (int bj = 0; bj < 2; ++bj) {
                    const f32x4 v0 = acc[ai][bj][m][0] * rs, v1 = acc[ai][bj][m][1] * rs;
                    const int col = col0 + bj * HALF;
                    if (!even) { u32x4 w; w.x = cvt_pk_bf16(v0[0], v0[1]); w.y = cvt_pk_bf16(v0[2], v0[3]); w.z = cvt_pk_bf16(v1[0], v1[1]); w.w = cvt_pk_bf16(v1[2], v1[3]); *(u32x4*)((bf16_t*)C + (size_t)row * PLB + col) = w; }
                    else if (col < EQI) { u32x4 w; w.x = cvt_pk_bf16(v0[0], v0[1]); w.y = cvt_pk_bf16(v0[2], v0[3]); w.z = cvt_pk_bf16(v1[0], v1[1]); w.w = cvt_pk_bf16(v1[2], v1[3]); *(u32x4*)(qb16 + (size_t)row * 512 + col) = w; }
                    else if (col < EU) { f16x8 h; h[0] = (_Float16)v0[0]; h[1] = (_Float16)v0[1]; h[2] = (_Float16)v0[2]; h[3] = (_Float16)v0[3]; h[4] = (_Float16)v1[0]; h[5] = (_Float16)v1[1]; h[6] = (_Float16)v1[2]; h[7] = (_Float16)v1[3];
                        *(f16x8*)(qih + (size_t)row * 512 + (col - EQI)) = h; }
                    else {
                        float* rowp = C + (size_t)row * ldc + col;
                        *(f32x4*)rowp = v0; *(f32x4*)(rowp + 4) = v1;
                        if (col >= EK && col < EKI + 64) { proj_even_extras(row, col, v0, kvb, kih, out, eidx); proj_even_extras(row, col + 4, v1, kvb, kih, out, eidx); }
                    }
                }
            }
    }
};
struct EpiRes {
    static constexpr bool PERM = true, AFTER_DRAIN = false;
    bf16_t* XB; float* ssn; const float* Xf32;
    __device__ __forceinline__ void operator()(const f32x4 (&acc)[2][2][4][2], const Unit& u, int wr, int wc, int fr, int fq) const {
        const int row0 = u.pm * BM + wr * 64 + fr, col0 = u.pn * BM + wc * 32 + 8 * fq;
#pragma unroll
        for (int ai = 0; ai < 2; ++ai) {
            f32x4 xv[4][2][2];
            if (Xf32) {
#pragma unroll
                for (int m = 0; m < 4; ++m) { const float* rowp = Xf32 + (size_t)(row0 + ai * HALF + m * 16) * DM + col0;
#pragma unroll
                    for (int bj = 0; bj < 2; ++bj) { xv[m][bj][0] = *(const f32x4*)(rowp + bj * HALF); xv[m][bj][1] = *(const f32x4*)(rowp + bj * HALF + 4); } }
            } else {
                u32x4 xb[4][2];
#pragma unroll
                for (int m = 0; m < 4; ++m) { const bf16_t* rowb = XB + (size_t)(row0 + ai * HALF + m * 16) * DM + col0;
#pragma unroll
                    for (int bj = 0; bj < 2; ++bj) xb[m][bj] = *(const u32x4*)(rowb + bj * HALF); }
#pragma unroll
                for (int m = 0; m < 4; ++m)
#pragma unroll
                    for (int bj = 0; bj < 2; ++bj) { xv[m][bj][0] = (f32x4){bf_lo(xb[m][bj].x), bf_hi(xb[m][bj].x), bf_lo(xb[m][bj].y), bf_hi(xb[m][bj].y)};
                                                     xv[m][bj][1] = (f32x4){bf_lo(xb[m][bj].z), bf_hi(xb[m][bj].z), bf_lo(xb[m][bj].w), bf_hi(xb[m][bj].w)}; }
            }
#pragma unroll
            for (int m = 0; m < 4; ++m) {
                const int row = row0 + ai * HALF + m * 16;
                bf16_t* rowb = XB + (size_t)row * DM + col0;
                float sq = 0.f;
#pragma unroll
                for (int bj = 0; bj < 2; ++bj) {
                    const f32x4 x0 = xv[m][bj][0] + acc[ai][bj][m][0], x1 = xv[m][bj][1] + acc[ai][bj][m][1];
                    u32x4 w; w.x = cvt_pk_bf16(x0[0], x0[1]); w.y = cvt_pk_bf16(x0[2], x0[3]); w.z = cvt_pk_bf16(x1[0], x1[1]); w.w = cvt_pk_bf16(x1[2], x1[3]);
                    *(u32x4*)(rowb + bj * HALF) = w;
                    const float r0 = bf_lo(w.x), r1 = bf_hi(w.x), r2 = bf_lo(w.y), r3 = bf_hi(w.y), r4 = bf_lo(w.z), r5 = bf_hi(w.z), r6 = bf_lo(w.w), r7 = bf_hi(w.w);
                    sq += ((r0 * r0 + r1 * r1) + (r2 * r2 + r3 * r3)) + ((r4 * r4 + r5 * r5) + (r6 * r6 + r7 * r7));
                }
                sq += __shfl_xor(sq, 16); sq += __shfl_xor(sq, 32);
                if (fq == 0) ssn[(size_t)row * 16 + u.pn * 4 + wc] = sq;
            }
        }
    }
};
struct EpiGU {
    static constexpr bool PERM = true, AFTER_DRAIN = false;
    bf16_t* H; const float* ss; const LAS float* rsl; int pm0;
    __device__ __forceinline__ void operator()(const f32x4 (&acc)[2][2][4][2], const Unit& u, int wr, int wc, int fr, int fq) const {
        const int row0 = u.pm * BM + wr * 64 + fr, col0 = u.pn * HALF + wc * 32 + 8 * fq;
#pragma unroll
        for (int ai = 0; ai < 2; ++ai)
#pragma unroll
            for (int m = 0; m < 4; ++m) {
                const int row = row0 + ai * HALF + m * 16;
                const float rs = u.pm == pm0 ? rsl[row - pm0 * BM] : row_rstd(ss, row);
                float h[8];
#pragma unroll
                for (int n = 0; n < 2; ++n)
#pragma unroll
                    for (int i = 0; i < 4; ++i) { const float g = acc[ai][0][m][n][i] * rs, uu = acc[ai][1][m][n][i] * rs; h[n * 4 + i] = silu_f(g) * uu; }
                u32x4 w; w.x = cvt_pk_bf16(h[0], h[1]); w.y = cvt_pk_bf16(h[2], h[3]); w.z = cvt_pk_bf16(h[4], h[5]); w.w = cvt_pk_bf16(h[6], h[7]);
                *(u32x4*)(H + (size_t)row * DFF + col0) = w;
            }
    }
};

template <class Epi, class Sched>
__device__ __forceinline__ void gemm_phase(LAS unsigned char* lds, const Gemm g, const Sched& S, const Epi& E, const int tid) {
    const int wid = __builtin_amdgcn_readfirstlane(tid >> 6), lane = tid & 63, wr = wid >> 2, wc = wid & 3, fr = lane & 15, fq = lane >> 4;
    const int K = g.K, nt = K / BK;
    unsigned voffA[2], voffB[2];
#pragma unroll
    for (int i = 0; i < 2; ++i) { int R, C; stage_rc(tid * 16 + i * 8192, R, C); const int Rb = Epi::PERM ? ((R & ~31) + perm32(R & 31)) : R;
        voffA[i] = (unsigned)(R * K + C) * 2u; voffB[i] = (unsigned)(Rb * K + C) * 2u; }
    const size_t kstep = (size_t)(BK * 2);
    const size_t hstep = (size_t)HALF * K * 2;
    const size_t tstep = 2 * hstep;
    const unsigned ldsw = (unsigned)wid * 1024u;
    const int aoff = lds_byte(wr * 64 + fr, fq * 8), boff = lds_byte(wc * 32 + fr, fq * 8);
#define PG8_SA(b, h) (((b) * 2 + (h)) * HTB)
#define PG8_SB(b, h) ((4 + (b) * 2 + (h)) * HTB)
#define PG8_STAGE(bufoff, gbase, voff) do { _Pragma("unroll") for (int _i = 0; _i < 2; ++_i) \
        __builtin_amdgcn_global_load_lds((const unsigned*)((const char*)(gbase) + (voff)[_i]), (LAS unsigned*)(lds + (bufoff) + ldsw + _i * 8192), 16, 0, 0); } while (0)
#define PG8_LDA(dst, b, h) do { _Pragma("unroll") for (int m = 0; m < 4; ++m) _Pragma("unroll") for (int k = 0; k < 2; ++k) dst[m][k] = *(const LAS bf16x8*)(lds + PG8_SA(b, h) + aoff + m * 2048 + k * 1024); } while (0)
#define PG8_LDB(dst, b, h) do { _Pragma("unroll") for (int n = 0; n < 2; ++n) _Pragma("unroll") for (int k = 0; k < 2; ++k) dst[n][k] = *(const LAS bf16x8*)(lds + PG8_SB(b, h) + boff + n * 2048 + k * 1024); } while (0)
#define PG8_MMA(ai, bj, At, Bt) do { __builtin_amdgcn_s_setprio(1); _Pragma("unroll") for (int m = 0; m < 4; ++m) _Pragma("unroll") for (int n = 0; n < 2; ++n) _Pragma("unroll") for (int k = 0; k < 2; ++k) \
        acc[ai][bj][m][n] = __builtin_amdgcn_mfma_f32_16x16x32_bf16(Bt[n][k], At[m][k], acc[ai][bj][m][n], 0, 0, 0); __builtin_amdgcn_s_setprio(0); } while (0)
#define PG8_WAIT_V(n) asm volatile("s_waitcnt vmcnt(" #n ")" ::: "memory")
#define PG8_WAIT_L(n) asm volatile("s_waitcnt lgkmcnt(" #n ")" ::: "memory")
#define PG8_BAR __builtin_amdgcn_s_barrier()
#define PG8_SCHED __builtin_amdgcn_sched_barrier(0)
    Unit cur, nxt; int ui = 0;
    if (!S.next(0, cur)) return;
    f32x4 acc[2][2][4][2];
#pragma unroll
    for (int a = 0; a < 2; ++a)
#pragma unroll
        for (int b = 0; b < 2; ++b)
#pragma unroll
            for (int m = 0; m < 4; ++m)
#pragma unroll
                for (int n = 0; n < 2; ++n) acc[a][b][m][n] = (f32x4){0.f, 0.f, 0.f, 0.f};
    bf16x8 At[4][2], B0[2][2], B1[2][2];
    const char* cA = (const char*)g.A + (size_t)cur.pm * tstep; const char* cB = (const char*)g.Bt + (size_t)cur.pn * tstep;
    S.a_ready(cur);
    PG8_STAGE(PG8_SB(0, 0), cB, voffB); PG8_STAGE(PG8_SA(0, 0), cA, voffA); PG8_STAGE(PG8_SB(0, 1), cB + hstep, voffB); PG8_STAGE(PG8_SA(0, 1), cA + hstep, voffA);
    if (wr == 1) PG8_BAR;
    PG8_WAIT_V(4); PG8_BAR;
    PG8_STAGE(PG8_SB(1, 0), cB + kstep, voffB); PG8_STAGE(PG8_SA(1, 0), cA + kstep, voffA); PG8_STAGE(PG8_SB(1, 1), cB + hstep + kstep, voffB);
    PG8_WAIT_V(6); PG8_BAR;
    for (;;) {
        const bool has_next = S.next(ui + 1, nxt);
        const char* nA = has_next ? (const char*)g.A + (size_t)nxt.pm * tstep : cA; const char* nB = has_next ? (const char*)g.Bt + (size_t)nxt.pn * tstep : cB;
        for (int t = 0; t < nt; t += 2) {
            const bool last = (t == nt - 2);
            const char* a1 = cA + (size_t)(t + 1) * kstep;
            const char* a2 = last ? nA : cA + (size_t)(t + 2) * kstep; const char* b2 = last ? nB : cB + (size_t)(t + 2) * kstep;
            const char* a3 = a2 + kstep; const char* b3 = b2 + kstep;
            if (last && has_next) S.a_ready(nxt);
            PG8_LDB(B0, 0, 0); PG8_SCHED; PG8_LDA(At, 0, 0); PG8_STAGE(PG8_SA(1, 1), a1 + hstep, voffA);
            PG8_WAIT_L(8); PG8_BAR; PG8_WAIT_L(0); PG8_MMA(0, 0, At, B0); PG8_BAR; PG8_SCHED;
            PG8_LDB(B1, 0, 1); PG8_STAGE(PG8_SB(0, 0), b2, voffB);
            PG8_BAR; PG8_WAIT_L(0); PG8_MMA(0, 1, At, B1); PG8_BAR;
            PG8_LDA(At, 0, 1); PG8_STAGE(PG8_SA(0, 0), a2, voffA);
            PG8_BAR; PG8_WAIT_L(0); PG8_MMA(1, 0, At, B0); PG8_BAR; PG8_SCHED;
            PG8_STAGE(PG8_SB(0, 1), b2 + hstep, voffB);
            PG8_WAIT_V(6); PG8_BAR; PG8_MMA(1, 1, At, B1); PG8_BAR;
            PG8_LDB(B0, 1, 0); PG8_SCHED; PG8_LDA(At, 1, 0); PG8_STAGE(PG8_SA(0, 1), a2 + hstep, voffA);
            PG8_WAIT_L(8); PG8_BAR; PG8_WAIT_L(0); PG8_MMA(0, 0, At, B0); PG8_BAR; PG8_SCHED;
            PG8_LDB(B1, 1, 1); PG8_STAGE(PG8_SB(1, 0), b3, voffB);
            PG8_BAR; PG8_WAIT_L(0); PG8_MMA(0, 1, At, B1); PG8_BAR;
            PG8_LDA(At, 1, 1); PG8_STAGE(PG8_SA(1, 0), a3, voffA);
            PG8_BAR; PG8_WAIT_L(0); PG8_MMA(1, 0, At, B0); PG8_BAR; PG8_SCHED;
            PG8_STAGE(PG8_SB(1, 1), b3 + hstep, voffB);
            PG8_WAIT_V(6); PG8_BAR; PG8_MMA(1, 1, At, B1); PG8_BAR;
        }
        E(acc, cur, wr, wc, fr, fq); S.done(cur);
        if (!has_next) break;
#pragma unroll
        for (int a = 0; a < 2; ++a)
#pragma unroll
            for (int b = 0; b < 2; ++b)
#pragma unroll
                for (int m = 0; m < 4; ++m)
#pragma unroll
                    for (int n = 0; n < 2; ++n) acc[a][b][m][n] = (f32x4){0.f, 0.f, 0.f, 0.f};
        cur = nxt; cA = nA; cB = nB; ++ui;
    }
    PG8_WAIT_V(0);
    if (wr == 0) PG8_BAR;
    PG8_BAR;
#undef PG8_SA
#undef PG8_SB
#undef PG8_STAGE
#undef PG8_LDA
#undef PG8_LDB
#undef PG8_MMA
#undef PG8_WAIT_V
#undef PG8_WAIT_L
#undef PG8_BAR
#undef PG8_SCHED
}
}

struct Args { const float* in[24]; float* out; unsigned char* ws; int ph_lo, ph_hi; };
struct Frame {
    LAS unsigned char* lds;
    int tid, lane, wave, G, blk;
    const float* const* in;
    float* out; unsigned char* ws;
    unsigned* ctl;
};
#define IN_XP 0
#define IN_XS 1
#define IN_CK 2
#define IN_CV 3
#define IN_CKI 4
#define IN_SPOOL 5
#define IN_SGLA 6
#define IN_PT 7
#define IN_META 8
#define IN_NMIX 9
#define IN_NFFN 10
#define IN_NFIN 11
#define IN_WINE 12
#define IN_WOUTE 13
#define IN_POOLW 14
#define IN_POOLS 15
#define IN_WINO 16
#define IN_WGATE 17
#define IN_BGATE 18
#define IN_GNORM 19
#define IN_WOUTO 20
#define IN_FG 21
#define IN_FU 22
#define IN_FD 23

constexpr int TR0 = 16384, NTM = 10, TROWS = 160;
constexpr int SKL_PART = 0, SKL_GATE = 81920, SKL_RS = SKL_GATE + 10240, SKL_SQ = SKL_RS + 640, SKL_END = SKL_SQ + 2560;
static_assert(SKL_END <= LDS_MISC, "skinny lds");
enum { SKM_PROJ = 0, SKM_RES = 1, SKM_GU = 2 };
struct SkinnyEpi { float* C; int ldc; int even; bf16_t* kvb; _Float16* kih; float* out; int eidx; bf16_t* qb16; _Float16* qih;
                   bf16_t* XB; float* sst_next;
                   bf16_t* H; };
__device__ __forceinline__ void skinny_rstd_to_lds(const float* sst, LAS float* rs_l, int tid) {
    if (tid < TROWS) {
        rs_l[tid] = tail_rstd_batched(sst, tid);
    }
}
template <int MT, int NS>
__device__ __forceinline__ void skinny_load(const bf16_t* ap, const bf16_t* bp, int K, const int (&n0)[NS], int ks, bf16x8 (&Af)[MT], bf16x8 (&Bf)[NS]) {
#pragma unroll
    for (int ns = 0; ns < NS; ++ns) Bf[ns] = *(const bf16x8*)(bp + (size_t)n0[ns] * K + 32 * ks);
#pragma unroll
    for (int mt = 0; mt < MT; ++mt) Af[mt] = *(const bf16x8*)(ap + (size_t)(16 * mt) * K + 32 * ks);
}
template <int MT, int NS>
__device__ __forceinline__ void skinny_mma(const bf16x8 (&Af)[MT], const bf16x8 (&Bf)[NS], f32x4 (&acc)[MT][NS]) {
#pragma unroll
    for (int mt = 0; mt < MT; ++mt)
#pragma unroll
        for (int ns = 0; ns < NS; ++ns) acc[mt][ns] = __builtin_amdgcn_mfma_f32_16x16x32_bf16(Bf[ns], Af[mt], acc[mt][ns], 0, 0, 0);
}
template <int MT, int NS>
__device__ __forceinline__ void skinny_kloop(const bf16_t* A, const bf16_t* Bt, int K, int mt0, const int (&n0)[NS], int ks0, int ks1, int lane, f32x4 (&acc)[MT][NS]) {
    constexpr int KB = 4;
    const int fr = lane & 15, fq = lane >> 4;
    const bf16_t* ap = A + (size_t)(TR0 + 16 * mt0 + fr) * K + 8 * fq; const bf16_t* bp = Bt + (size_t)fr * K + 8 * fq;
#pragma unroll 1
    for (int ks = ks0; ks < ks1; ks += KB) {
        bf16x8 Af[KB][MT], Bf[KB][NS];
#pragma unroll
        for (int i = 0; i < KB; ++i) skinny_load<MT, NS>(ap, bp, K, n0, ks + i < ks1 ? ks + i : ks1 - 1, Af[i], Bf[i]);
        __builtin_amdgcn_sched_barrier(0);
#pragma unroll
        for (int i = 0; i < KB; ++i) if (ks + i < ks1) skinny_mma<MT, NS>(Af[i], Bf[i], acc);
        __builtin_amdgcn_sched_barrier(0);
    }
}
template <int MODE, int MT, int NS>
__device__ __forceinline__ void skinny_phase(Frame& F, const bf16_t* A, const bf16_t* Bt, int K, int nslices, const float* sst_in, const SkinnyEpi& E, int wg0 = 0) {
    static_assert(NTM % MT == 0 && MT * 64 <= 512 && 8 * MT * NS * 1024 <= SKL_GATE, "skinny tile");
    const int tid = F.tid, lane = F.lane, w = F.wave;
    LAS float* part = (LAS float*)(F.lds + SKL_PART); LAS float* rs_l = (LAS float*)(F.lds + SKL_RS); LAS float* sq_l = (LAS float*)(F.lds + SKL_SQ);
    __syncthreads();
    if (MODE != SKM_RES) skinny_rstd_to_lds(sst_in, rs_l, tid);
    const int ksteps = K / 32, kw = ksteps / 8, ks0 = w * kw, ks1 = ks0 + kw;
    constexpr int NMG = NTM / MT;
    const int nng = MODE == SKM_GU ? nslices : (nslices + NS - 1) / NS, nunits = nng * NMG;
    for (int u = F.blk - wg0; u >= 0 && u < nunits; u += F.G - wg0) {
        const int mg = u % NMG, ng = u / NMG, mt0 = mg * MT;
        int n0[NS]; int sl[NS];
#pragma unroll
        for (int ns = 0; ns < NS; ++ns) {
            if (MODE == SKM_GU) { sl[ns] = ng; n0[ns] = 256 * (ng >> 3) + 16 * (ng & 7) + 128 * ns; }
            else { const int sraw = ng * NS + ns; sl[ns] = sraw < nslices ? sraw : nslices - 1; n0[ns] = 16 * sl[ns]; }
        }
        f32x4 acc[MT][NS];
#pragma unroll
        for (int mt = 0; mt < MT; ++mt)
#pragma unroll
            for (int ns = 0; ns < NS; ++ns) acc[mt][ns] = (f32x4){0.f, 0.f, 0.f, 0.f};
        skinny_kloop<MT, NS>(A, Bt, K, mt0, n0, ks0, ks1, lane, acc);
        __syncthreads();
#pragma unroll
        for (int mt = 0; mt < MT; ++mt)
#pragma unroll
            for (int ns = 0; ns < NS; ++ns) *(LAS f32x4*)(part + (((w * MT + mt) * NS + ns) * 64 + lane) * 4) = acc[mt][ns];
        __syncthreads();
        if (tid < MT * 64) {
            const int mt = tid >> 6, ln = tid & 63, fr = ln & 15, fq = ln >> 4, trow = 16 * (mt0 + mt) + fr, row = TR0 + trow;
            f32x4 red[NS];
#pragma unroll
            for (int ns = 0; ns < NS; ++ns) {
                f32x4 sum = *(const LAS f32x4*)(part + (((0 * MT + mt) * NS + ns) * 64 + ln) * 4);
#pragma unroll
                for (int ww = 1; ww < 8; ++ww) sum += *(const LAS f32x4*)(part + (((ww * MT + mt) * NS + ns) * 64 + ln) * 4);
                red[ns] = sum;
            }
            if (MODE == SKM_PROJ) {
                const float rs = rs_l[trow];
#pragma unroll
                for (int ns = 0; ns < NS; ++ns) {
                    const int col = 16 * sl[ns] + 4 * fq; const f32x4 v = red[ns] * rs;
                    if (!E.even) { u32x2 wv; wv.x = cvt_pk_bf16(v[0], v[1]); wv.y = cvt_pk_bf16(v[2], v[3]); *(u32x2*)((bf16_t*)E.C + (size_t)row * PLB + col) = wv; }
                    else if (col < EQI) { u32x2 wv; wv.x = cvt_pk_bf16(v[0], v[1]); wv.y = cvt_pk_bf16(v[2], v[3]); *(u32x2*)(E.qb16 + (size_t)row * 512 + col) = wv; }
                    else if (col < EU) { f16x4 hq; hq[0] = (_Float16)v[0]; hq[1] = (_Float16)v[1]; hq[2] = (_Float16)v[2]; hq[3] = (_Float16)v[3]; *(f16x4*)(E.qih + (size_t)row * 512 + (col - EQI)) = hq; }
                    else *(f32x4*)(E.C + (size_t)row * E.ldc + col) = v;
                    if (E.even && col >= EK && col < EKI + 64) proj_even_extras(row, col, v, E.kvb, E.kih, E.out, E.eidx);
                }
            } else if (MODE == SKM_RES) {
#pragma unroll
                for (int ns = 0; ns < NS; ++ns) {
                    const int col = 16 * sl[ns] + 4 * fq;
                    const bool dup = (ng * NS + ns) >= nslices;
                    if (!dup) {
                        const u32x2 xb = *(const u32x2*)(E.XB + (size_t)row * DM + col);
                        const f32x4 x = (f32x4){bf_lo(xb.x), bf_hi(xb.x), bf_lo(xb.y), bf_hi(xb.y)} + red[ns];
                        u32x2 wv; wv.x = cvt_pk_bf16(x[0], x[1]); wv.y = cvt_pk_bf16(x[2], x[3]); *(u32x2*)(E.XB + (size_t)row * DM + col) = wv;
                        const float r0 = bf_lo(wv.x), r1 = bf_hi(wv.x), r2 = bf_lo(wv.y), r3 = bf_hi(wv.y);
                        sq_l[(ns * MT * 16 + mt * 16 + fr) * 4 + fq] = (r0 * r0 + r1 * r1) + (r2 * r2 + r3 * r3);
                    }
                }
            } else {
                const float rs = rs_l[trow]; const f32x4 g = red[0] * rs, uu = red[NS - 1] * rs;
                u32x2 wv; wv.x = cvt_pk_bf16(silu_f(g[0]) * uu[0], silu_f(g[1]) * uu[1]); wv.y = cvt_pk_bf16(silu_f(g[2]) * uu[2], silu_f(g[3]) * uu[3]);
                *(u32x2*)(E.H + (size_t)row * DFF + 16 * ng + 4 * fq) = wv;
            }
        }
        if (MODE == SKM_RES) {
            __syncthreads();
            if (tid < NS * MT * 16) {
                const int ns = tid / (MT * 16), r = tid % (MT * 16), sraw = ng * NS + ns;
                if (sraw < nslices) E.sst_next[(size_t)(16 * mt0 + r) * 64 + sraw] = (sq_l[tid * 4] + sq_l[tid * 4 + 1]) + (sq_l[tid * 4 + 2] + sq_l[tid * 4 + 3]);
            }
        }
    }
    __syncthreads();
}

constexpr int LDS_RSL = 131072;
static_assert(LDS_RSL + 1024 <= LDS_MISC, "gemm lds");
__device__ __forceinline__ int panel_rstd_to_lds(Frame& F, const float* ss, int M, int N) {
    pg8::StaticOrder S; S.init(M, N, F.G, F.blk); pg8::Unit u;
    int pm0 = -1;
    if (S.next(0, u)) pm0 = u.pm;
    __syncthreads();
    if (pm0 >= 0 && F.tid < 256) ((LAS float*)(F.lds + LDS_RSL))[F.tid] = row_rstd(ss, pm0 * 256 + F.tid);
    __syncthreads();
    return pm0;
}

__device__ __forceinline__ void tr_item(const float* W, int Nsrc, int c0, int nvalid, bf16_t* dst, int K, int k0, const float* gain, float scale, LAS float* scr, int lane) {
    const int nn = lane & 31, hi = lane >> 5, c = lane & 7;
    const float* wp = W + (size_t)(k0 + hi) * Nsrc + c0 + (nn < nvalid ? nn : 0);
    float v[32];
#pragma unroll
    for (int i = 0; i < 32; ++i) v[i] = wp[(size_t)(2 * i) * Nsrc];
    f32x4 g0 = (f32x4){1.f, 1.f, 1.f, 1.f}, g1 = g0;
    if (gain) { g0 = *(const f32x4*)(gain + k0 + 8 * c); g1 = *(const f32x4*)(gain + k0 + 8 * c + 4); }
    __builtin_amdgcn_sched_barrier(0);
#pragma unroll
    for (int i = 0; i < 32; ++i) scr[(2 * i + hi) * 33 + nn] = nn < nvalid ? v[i] * scale : 0.f;
    asm volatile("s_waitcnt lgkmcnt(0)" ::: "memory");
#pragma unroll
    for (int j = 0; j < 4; ++j) {
        const int n = (lane >> 3) + 8 * j; const LAS float* s = scr + (8 * c) * 33 + n;
        u32x4 o; o.x = cvt_pk_bf16(s[0 * 33] * g0[0], s[1 * 33] * g0[1]); o.y = cvt_pk_bf16(s[2 * 33] * g0[2], s[3 * 33] * g0[3]); o.z = cvt_pk_bf16(s[4 * 33] * g1[0], s[5 * 33] * g1[1]); o.w = cvt_pk_bf16(s[6 * 33] * g1[2], s[7 * 33] * g1[3]);
        *(u32x4*)(dst + (size_t)n * K + k0 + 8 * c) = o;
    }
    asm volatile("s_waitcnt lgkmcnt(0)" ::: "memory");
}

__device__ __forceinline__ void convert_weights(Frame& F, int part, int gw, int NGW, int fb, int nfb) {
    LAS float* scr = (LAS float*)(F.lds + F.wave * 16384);
    const int lane = F.lane;
    unsigned char* ws = F.ws;
    constexpr int I_WINE = (NE / 32) * 16, I_WINO = (NO / 32) * 16, I_WOE = 32 * 8, I_WOO = 32 * 16, I_GU = (NGU / 32) * 16, I_DN = 32 * (DFF / 64);
    constexpr int NITEMS = 2 * I_WINE + 2 * I_WINO + 2 * I_WOE + 2 * I_WOO + 4 * I_GU + 4 * I_DN;
#define CW_WANT(early) (part == 2 || (part == 0) == (early))
    for (int it = gw; it < NITEMS; it += NGW) {
        int r = it;
        if (r < 2 * I_WINE) {
            const int e = r / I_WINE; r %= I_WINE; if (!CW_WANT(e == 0)) continue; const int ch = r / 16, kb = r % 16, n0 = ch * 32;
            int src, nv = 32; float sc = 1.f;
            if (n0 < 512) { src = n0; sc = 0.125f; }
            else if (n0 < 1024) src = 768 + (n0 - 512);
            else if (n0 < 1536) src = 1352 + (n0 - 1024);
            else if (n0 < 1664) src = 512 + (n0 - 1536);
            else if (n0 < 1792) src = 640 + (n0 - 1664);
            else if (n0 < 1856) src = 1280 + (n0 - 1792);
            else if (n0 == 1856) { src = 1344; nv = 8; }
            else { src = 0; nv = 0; }
            tr_item(F.in[IN_WINE] + (size_t)e * DM * EIN, EIN, src, nv, (bf16_t*)(ws + WS_WINE) + ((size_t)e * NE + n0) * DM, DM, kb * 64, F.in[IN_NMIX] + (2 * e) * DM, sc, scr, lane);
            continue;
        }
        r -= 2 * I_WINE;
        if (r < 2 * I_WINO) {
            const int o = r / I_WINO; r %= I_WINO; if (!CW_WANT(o == 0)) continue; const int ch = r / 16, kb = r % 16, n0 = ch * 32;
            int nv = 32; float sc = 1.f;
            if (n0 < 512) sc = 0.08838834764831845f;
            if (n0 == 3072) nv = 16; else if (n0 > 3072) nv = 0;
            tr_item(F.in[IN_WINO] + (size_t)o * DM * OIN, OIN, nv ? n0 : 0, nv, (bf16_t*)(ws + WS_WINO) + ((size_t)o * NO + n0) * DM, DM, kb * 64, F.in[IN_NMIX] + (2 * o + 1) * DM, sc, scr, lane);
            continue;
        }
        r -= 2 * I_WINO;
        if (r < 2 * I_WOE) {
            const int e = r / I_WOE; r %= I_WOE; if (!CW_WANT(e == 0)) continue; const int ch = r / 8, kb = r % 8, n0 = ch * 32;
            tr_item(F.in[IN_WOUTE] + (size_t)e * DM * DM, DM, n0, 32, (bf16_t*)(ws + WS_WOUTE) + ((size_t)e * DM + n0) * DM, DM, kb * 64, nullptr, 1.f, scr, lane);
            continue;
        }
        r -= 2 * I_WOE;
        if (r < 2 * I_WOO) {
            const int o = r / I_WOO; r %= I_WOO; if (!CW_WANT(false)) continue; const int ch = r / 16, kb = r % 16, n0 = ch * 32;
            tr_item(F.in[IN_WOUTO] + (size_t)o * DM * DM, DM, n0, 32, (bf16_t*)(ws + WS_WOUTO) + ((size_t)o * DM + n0) * DM, DM, kb * 64, nullptr, 1.f, scr, lane);
            continue;
        }
        r -= 2 * I_WOO;
        if (r < 4 * I_GU) {
            const int l = r / I_GU; r %= I_GU; if (!CW_WANT(l == 0)) continue; const int ch = r / 16, kb = r % 16, n0 = ch * 32, tile = n0 >> 8, within = n0 & 255;
            const float* W = (within < 128 ? F.in[IN_FG] : F.in[IN_FU]) + (size_t)l * DM * DFF;
            tr_item(W, DFF, tile * 128 + (within & 127), 32, (bf16_t*)(ws + WS_WGU) + ((size_t)l * NGU + n0) * DM, DM, kb * 64, F.in[IN_NFFN] + l * DM, 1.f, scr, lane);
            continue;
        }
        r -= 4 * I_GU;
        {
            const int l = r / I_DN; r %= I_DN; if (!CW_WANT(l == 0)) continue; const int ch = r / (DFF / 64), kb = r % (DFF / 64), n0 = ch * 32;
            tr_item(F.in[IN_FD] + (size_t)l * DFF * DM, DM, n0, 32, (bf16_t*)(ws + WS_WDN) + ((size_t)l * DM + n0) * DFF, DFF, kb * 64, nullptr, 1.f, scr, lane);
        }
    }
    LAS float* pwl = (LAS float*)(F.lds + 131072); LAS float* psl = pwl + 1024;
    for (int it = fb; it < 256; it += nfb) {
        const int e = it >> 7, g = (it >> 5) & 3, cb = (it >> 1) & 15, nb = it & 1, n = nb * 512 + F.tid;
        if (!CW_WANT(e == 0)) continue;
        const float* pw = F.in[IN_POOLW] + ((size_t)(e * 4 + g) * 128 + cb * 8) * 128;
        const float* ps = F.in[IN_POOLS] + e * 512 + g * 128;
        const float* wo = F.in[IN_WOUTE] + ((size_t)e * DM + 512 + g * 128) * DM + n;
        __syncthreads();
        pwl[F.tid] = pw[F.tid]; pwl[512 + F.tid] = pw[512 + F.tid]; if (F.tid < 128) psl[F.tid] = ps[F.tid];
        __syncthreads();
        float a[8];
#pragma unroll
        for (int c = 0; c < 8; ++c) a[c] = 0.f;
#pragma unroll 1
        for (int j0 = 0; j0 < 128; j0 += 32) {
            float wv[32];
#pragma unroll
            for (int jj = 0; jj < 32; ++jj) wv[jj] = wo[(size_t)(j0 + jj) * DM];
            __builtin_amdgcn_sched_barrier(0);
#pragma unroll
            for (int jj = 0; jj < 32; ++jj) {
                const float x = wv[jj] * psl[j0 + jj];
#pragma unroll
                for (int c = 0; c < 8; ++c) a[c] += pwl[c * 128 + j0 + jj] * x;
            }
        }
        u32x4 o; o.x = cvt_pk_bf16(a[0], a[1]); o.y = cvt_pk_bf16(a[2], a[3]); o.z = cvt_pk_bf16(a[4], a[5]); o.w = cvt_pk_bf16(a[6], a[7]);
        *(u32x4*)((bf16_t*)(ws + WS_WOUTE) + ((size_t)e * DM + n) * DM + 512 + g * 128 + cb * 8) = o;
    }
#undef CW_WANT
}
__device__ __forceinline__ void p0_prologue(Frame& F) {
    const int gw = F.blk * 8 + F.wave, NGW = F.G * 8, lane = F.lane;
    unsigned char* ws = F.ws;
    convert_weights(F, F.G > 128 ? 0 : 2, gw, NGW, F.blk, F.G);
    bf16_t* XB = (bf16_t*)(ws + WS_XB); float* ss0 = (float*)(ws + WS_SSP); float* sst0 = (float*)(ws + WS_SST);
    bf16_t* ACT = (bf16_t*)(ws + WS_ACT);
    for (int row0 = gw; row0 < MP; row0 += 4 * NGW) {
        f32x4 v[4][4];
#pragma unroll
        for (int i = 0; i < 4; ++i) {
            const int row = row0 + i * NGW;
            const float* src = nullptr;
            if (row < ROW_META) src = F.in[IN_XP] + (size_t)row * DM;
            else if (row < ROW_SAMP) src = F.in[IN_META] + (size_t)(row - ROW_META) * DM;
            else if (row < MREAL) src = F.in[IN_XS] + (size_t)(row - ROW_SAMP) * DM;
#pragma unroll
            for (int j = 0; j < 4; ++j) { v[i][j] = (f32x4){0.f, 0.f, 0.f, 0.f}; if (src) v[i][j] = *(const f32x4*)(src + 256 * j + 4 * lane); }
        }
        __builtin_amdgcn_sched_barrier(0);
#pragma unroll
        for (int i = 0; i < 4; ++i) {
            const int row = row0 + i * NGW;
            if (row >= MP) continue;
            float sq = 0.f;
#pragma unroll
            for (int j = 0; j < 4; ++j) {
                u32x2 w; w.x = cvt_pk_bf16(v[i][j][0], v[i][j][1]); w.y = cvt_pk_bf16(v[i][j][2], v[i][j][3]);
                *(u32x2*)(XB + (size_t)row * DM + 256 * j + 4 * lane) = w;
                if (row >= MREAL) *(u32x2*)(ACT + (size_t)row * DM + 256 * j + 4 * lane) = (u32x2){0u, 0u};
                sq += (v[i][j][0] * v[i][j][0] + v[i][j][1] * v[i][j][1]) + (v[i][j][2] * v[i][j][2] + v[i][j][3] * v[i][j][3]);
            }
            sq = wave_sum(sq);
            if (row < TR0) { if (lane < 16) ss0[(size_t)row * 16 + lane] = lane == 0 ? sq : 0.f; }
            else if (row < TR0 + TROWS) sst0[(size_t)(row - TR0) * 64 + lane] = lane == 0 ? sq : 0.f;
        }
    }
}

__device__ __forceinline__ unsigned f2key(float s) {
    const _Float16 h = (_Float16)s; const unsigned b = __builtin_bit_cast(unsigned short, h);
    return (b & 0x8000u) ? (~b & 0xffffu) : (b | 0x8000u);
}
template <int NREG>
__device__ __forceinline__ int select_topk(const LAS u16* row, int nvis, LAS u16* list, int lane) {
    if (nvis <= 256) { for (int j = lane; j < nvis; j += 64) list[j] = (u16)j; return nvis; }
    const LAS unsigned* r32 = (const LAS unsigned*)row;
    const int nsteps = (nvis + 127) >> 7;
    unsigned T = 0u; int cgt = 0;
    if constexpr (NREG > 0) {
        unsigned kr[NREG];
#pragma unroll
        for (int s = 0; s < NREG; ++s) kr[s] = s < nsteps ? r32[s * 64 + lane] : 0u;
        for (int bit = 15; bit >= 0; --bit) {
            const unsigned cand = T | (1u << bit), ch = cand << 16;
            int cnt = 0;
#pragma unroll
            for (int s = 0; s < NREG; ++s) cnt += __popcll(__ballot((kr[s] << 16) >= ch)) + __popcll(__ballot(kr[s] >= ch));
            if (cnt >= 256) T = cand;
        }
        { const unsigned ch = (T << 16) | 0xffffu;
#pragma unroll
          for (int s = 0; s < NREG; ++s) cgt += __popcll(__ballot(((kr[s] << 16) | 0xffffu) > ch)) + __popcll(__ballot((kr[s] | 0xffffu) > ch)); }
        const int need = 256 - cgt;
        int base = 0, tbase = 0;
#pragma unroll
        for (int s = 0; s < NREG; ++s) {
            const unsigned k2 = kr[s]; const unsigned lo = k2 & 0xffffu, hi = k2 >> 16;
            const bool tl = (lo == T), th = (hi == T);
            const unsigned long long btl = __ballot(tl), bth = __ballot(th);
            const int rl = tbase + (int)mbcnt64(btl) + (int)mbcnt64(bth), rh = rl + (tl ? 1 : 0);
            const bool sl = (lo > T) || (tl && rl < need), sh = (hi > T) || (th && rh < need);
            const unsigned long long bsl = __ballot(sl), bsh = __ballot(sh);
            const int ol = base + (int)mbcnt64(bsl) + (int)mbcnt64(bsh), oh = ol + (sl ? 1 : 0);
            const int pos = 2 * (s * 64 + lane);
            if (sl && ol < 256) list[ol] = (u16)pos;
            if (sh && oh < 256) list[oh] = (u16)(pos + 1);
            base += __popcll(bsl) + __popcll(bsh); tbase += __popcll(btl) + __popcll(bth);
        }
        return base < 256 ? base : 256;
    } else {
        for (int bit = 15; bit >= 0; --bit) {
            const unsigned cand = T | (1u << bit), ch = cand << 16;
            int cnt = 0;
#pragma unroll 5
            for (int s = 0; s < nsteps; ++s) { const unsigned k2 = r32[s * 64 + lane]; cnt += __popcll(__ballot((k2 << 16) >= ch)) + __popcll(__ballot(k2 >= ch)); }
            if (cnt >= 256) T = cand;
        }
#pragma unroll 5
        for (int s = 0; s < nsteps; ++s) { const unsigned k2 = r32[s * 64 + lane]; cgt += __popcll(__ballot((k2 & 0xffffu) > T)) + __popcll(__ballot((k2 >> 16) > T)); }
        const int need = 256 - cgt;
        int base = 0, tbase = 0;
#pragma unroll 5
        for (int s = 0; s < nsteps; ++s) {
            const unsigned k2 = r32[s * 64 + lane]; const unsigned lo = k2 & 0xffffu, hi = k2 >> 16;
            const bool tl = (lo == T), th = (hi == T);
            const unsigned long long btl = __ballot(tl), bth = __ballot(th);
            const int rl = tbase + (int)mbcnt64(btl) + (int)mbcnt64(bth), rh = rl + (tl ? 1 : 0);
            const bool sl = (lo > T) || (tl && rl < need), sh = (hi > T) || (th && rh < need);
            const unsigned long long bsl = __ballot(sl), bsh = __ballot(sh);
            const int ol = base + (int)mbcnt64(bsl) + (int)mbcnt64(bsh), oh = ol + (sl ? 1 : 0);
            const int pos = 2 * (s * 64 + lane);
            if (sl && ol < 256) list[ol] = (u16)pos;
            if (sh && oh < 256) list[oh] = (u16)(pos + 1);
            base += __popcll(bsl) + __popcll(bsh); tbase += __popcll(btl) + __popcll(bth);
        }
        return base < 256 ? base : 256;
    }
}

constexpr int MASK_WORDS = 68;
template <int NREG>
__device__ __forceinline__ void select_mask(const LAS u16* row, int nvis, LAS unsigned* mask, int lane) {
    if (nvis <= 256) {
        for (int j = lane; j < MASK_WORDS; j += 64) mask[j] = (32 * j + 32 <= nvis) ? 0xffffffffu : (32 * j < nvis ? ((1u << (nvis - 32 * j)) - 1u) : 0u);
        return;
    }
    for (int j = lane; j < MASK_WORDS; j += 64) mask[j] = 0u;
    const LAS unsigned* r32 = (const LAS unsigned*)row;
    const int nsteps = (nvis + 127) >> 7;
    unsigned T = 0u; int cgt = 0;
    unsigned kr[NREG];
#pragma unroll
    for (int s = 0; s < NREG; ++s) kr[s] = s < nsteps ? r32[s * 64 + lane] : 0u;
    for (int bit = 15; bit >= 0; --bit) {
        const unsigned cand = T | (1u << bit), ch = cand << 16;
        int cnt = 0;
#pragma unroll
        for (int s = 0; s < NREG; ++s) cnt += __popcll(__ballot((kr[s] << 16) >= ch)) + __popcll(__ballot(kr[s] >= ch));
        if (cnt >= 256) T = cand;
    }
    { const unsigned ch = (T << 16) | 0xffffu;
#pragma unroll
      for (int s = 0; s < NREG; ++s) cgt += __popcll(__ballot(((kr[s] << 16) | 0xffffu) > ch)) + __popcll(__ballot((kr[s] | 0xffffu) > ch)); }
    const int need = 256 - cgt;
    int tbase = 0;
#pragma unroll
    for (int s = 0; s < NREG; ++s) {
        const unsigned k2 = kr[s]; const unsigned lo = k2 & 0xffffu, hi = k2 >> 16;
        const bool tl = (lo == T), th = (hi == T);
        const unsigned long long btl = __ballot(tl), bth = __ballot(th);
        const int rl = tbase + (int)mbcnt64(btl) + (int)mbcnt64(bth), rh = rl + (tl ? 1 : 0);
        const bool sl = (lo > T) || (tl && rl < need), sh = (hi > T) || (th && rh < need);
        const int pos = 2 * (s * 64 + lane);
        const unsigned bits = (sl ? 1u : 0u) | (sh ? 2u : 0u);
        if (bits) (void)__hip_atomic_fetch_or(mask + (pos >> 5), bits << (pos & 31), __ATOMIC_RELAXED, __HIP_MEMORY_SCOPE_WORKGROUP);
        tbase += __popcll(btl) + __popcll(bth);
    }
}

template <int NR>
__device__ __forceinline__ void select_topk_pair(const LAS u16* row, int nvis, LAS u16* list, volatile LAS int* xch, int lane, int w) {
    const int half = w & 1, s0 = NR * half;
    const LAS unsigned* r32 = (const LAS unsigned*)row + s0 * 64 + lane;
    unsigned T = 0u;
    for (int bit = 15; bit >= 0; --bit) {
        const unsigned cand = T | (1u << bit), ch = cand << 16;
        int cnt = 0;
#pragma unroll 11
        for (int s = 0; s < NR; ++s) { const unsigned kv = r32[s * 64]; cnt += __popcll(__ballot((kv << 16) >= ch)) + __popcll(__ballot(kv >= ch)); }
        if (lane == 0) xch[(bit & 1) * 8 + w] = cnt;
        __syncthreads();
        if (cnt + xch[(bit & 1) * 8 + (w ^ 1)] >= 256) T = cand;
    }
    int cgt = 0, cti = 0;
#pragma unroll 11
    for (int s = 0; s < NR; ++s) { const unsigned kv = r32[s * 64]; const unsigned lo = kv & 0xffffu, hi = kv >> 16;
        cgt += __popcll(__ballot(lo > T)) + __popcll(__ballot(hi > T)); cti += __popcll(__ballot(lo == T)) + __popcll(__ballot(hi == T)); }
    if (lane == 0) { xch[16 + 2 * w] = cgt; xch[16 + 2 * w + 1] = cti; }
    __syncthreads();
    const int cgt_p = xch[16 + 2 * (w ^ 1)], cti_p = xch[16 + 2 * (w ^ 1) + 1];
    const int need = 256 - (cgt + cgt_p);
    int base = half ? cgt_p + (cti_p < need ? cti_p : need) : 0, tbase = half ? cti_p : 0;
#pragma unroll 3
    for (int s = 0; s < NR; ++s) {
        const unsigned k2 = r32[s * 64]; const unsigned lo = k2 & 0xffffu, hi = k2 >> 16;
        const bool tl = (lo == T), th = (hi == T);
        const unsigned long long btl = __ballot(tl), bth = __ballot(th);
        const int rl = tbase + (int)mbcnt64(btl) + (int)mbcnt64(bth), rh = rl + (tl ? 1 : 0);
        const bool sl = (lo > T) || (tl && rl < need), sh = (hi > T) || (th && rh < need);
        const unsigned long long bsl = __ballot(sl), bsh = __ballot(sh);
        const int ol = base + (int)mbcnt64(bsl) + (int)mbcnt64(bsh), oh = ol + (sl ? 1 : 0);
        const int pos = 2 * ((s0 + s) * 64 + lane);
        if (sl && ol < 256) list[ol] = (u16)pos;
        if (sh && oh < 256) list[oh] = (u16)(pos + 1);
        base += __popcll(bsl) + __popcll(bsh); tbase += __popcll(btl) + __popcll(bth);
    }
}

struct SrcPrompt {
    const bf16_t* kvb; int b;
    __device__ __forceinline__ void kfrag(int pos, int kq, bf16x8 (&B)[4]) const {
        const bf16_t* p = kvb + (size_t)prow(b, pos) * 256 + 32 * kq;
#pragma unroll
        for (int s = 0; s < 4; ++s) B[s] = *(const bf16x8*)(p + 8 * s);
    }
    typedef unsigned vraw;
    __device__ __forceinline__ vraw vload(int pos, int lane) const { return *(const unsigned*)(kvb + (size_t)prow(b, pos) * 256 + 128 + 2 * lane); }
    __device__ __forceinline__ f32x2 vcvt(vraw u) const { return (f32x2){bf_lo(u), bf_hi(u)}; }
};
struct SrcSample {
    const float* ck; const float* cv; const LAS int* pt; const float* proj; int db;
    __device__ __forceinline__ const float* krow(int pos) const { return pos < PAST ? ck + ((size_t)pt[pos >> 7] * PAGE + (pos & 127)) * 128 : proj + (size_t)(ROW_SAMP + db * DSEQ + (pos - PAST)) * PLD + EK; }
    __device__ __forceinline__ const float* vrow(int pos) const { return pos < PAST ? cv + ((size_t)pt[pos >> 7] * PAGE + (pos & 127)) * 128 : proj + (size_t)(ROW_SAMP + db * DSEQ + (pos - PAST)) * PLD + EV; }
    __device__ __forceinline__ void kfrag(int pos, int kq, bf16x8 (&B)[4]) const {
        const float* p = krow(pos) + 32 * kq;
        f32x4 a[8];
#pragma unroll
        for (int s = 0; s < 8; ++s) a[s] = *(const f32x4*)(p + 4 * s);
#pragma unroll
        for (int s = 0; s < 4; ++s) {
            u32x4 w; w.x = cvt_pk_bf16(a[2 * s][0], a[2 * s][1]); w.y = cvt_pk_bf16(a[2 * s][2], a[2 * s][3]); w.z = cvt_pk_bf16(a[2 * s + 1][0], a[2 * s + 1][1]); w.w = cvt_pk_bf16(a[2 * s + 1][2], a[2 * s + 1][3]);
            B[s] = __builtin_bit_cast(bf16x8, w);
        }
    }
    typedef f32x2 vraw;
    __device__ __forceinline__ vraw vload(int pos, int lane) const { return *(const f32x2*)(vrow(pos) + 2 * lane); }
    __device__ __forceinline__ f32x2 vcvt(vraw u) const { return u; }
};

template <class Src, int QKB>
__device__ __forceinline__ void attn_half(const Src& S, const bf16_t* qb16, int qrow, const LAS u16* list, LAS float* pb, LAS float* stat, int lane, f32x2 (&o)[4]) {
    const int m = lane & 15, kq = lane >> 4;
    bf16x8 A[4];
    {
        const bool valid = (m < 8) && ((kq >> 1) == (m >> 2));
        const bf16_t* qp = qb16 + (size_t)qrow * 512 + (m & 7) * 64 + 32 * (kq & 1);
#pragma unroll
        for (int s = 0; s < 4; ++s) {
            u32x4 w = (u32x4){0u, 0u, 0u, 0u};
            if (valid) w = *(const u32x4*)(qp + 8 * s);
            A[s] = __builtin_bit_cast(bf16x8, w);
        }
    }
    f32x4 lg[8];
#pragma unroll
    for (int tb = 0; tb < 8; tb += QKB) {
        bf16x8 B[QKB][4];
#pragma unroll
        for (int t = 0; t < QKB; ++t) S.kfrag((int)list[16 * (tb + t) + m], kq, B[t]);
#pragma unroll
        for (int t = 0; t < QKB; ++t) {
            f32x4 acc = (f32x4){0.f, 0.f, 0.f, 0.f};
#pragma unroll
            for (int s = 0; s < 4; ++s) acc = __builtin_amdgcn_mfma_f32_16x16x32_bf16(A[s], B[t][s], acc, 0, 0, 0);
            lg[tb + t] = acc;
        }
    }
    f32x4 mx = lg[0];
#pragma unroll
    for (int t = 1; t < 8; ++t) { mx[0] = fmaxf(mx[0], lg[t][0]); mx[1] = fmaxf(mx[1], lg[t][1]); mx[2] = fmaxf(mx[2], lg[t][2]); mx[3] = fmaxf(mx[3], lg[t][3]); }
#pragma unroll
    for (int of = 1; of < 16; of <<= 1) {
#pragma unroll
        for (int r = 0; r < 4; ++r) mx[r] = fmaxf(mx[r], __shfl_xor(mx[r], of));
    }
    f32x4 sm = (f32x4){0.f, 0.f, 0.f, 0.f};
#pragma unroll
    for (int t = 0; t < 8; ++t) {
#pragma unroll
        for (int r = 0; r < 4; ++r) { const float e = __expf(lg[t][r] - mx[r]); lg[t][r] = e; sm[r] += e; }
    }
#pragma unroll
    for (int of = 1; of < 16; of <<= 1) {
#pragma unroll
        for (int r = 0; r < 4; ++r) sm[r] += __shfl_xor(sm[r], of);
    }
    f32x4 inv; inv[0] = 1.f / sm[0]; inv[1] = 1.f / sm[1]; inv[2] = 1.f / sm[2]; inv[3] = 1.f / sm[3];
    if (kq < 2) {
#pragma unroll
        for (int t = 0; t < 8; ++t) *(LAS f32x4*)(pb + (16 * t + m) * 8 + 4 * kq) = lg[t] * inv;
        if (m == 0) { *(LAS f32x4*)(stat + 4 * kq) = mx; *(LAS f32x4*)(stat + 8 + 4 * kq) = sm; }
    }
    asm volatile("s_waitcnt lgkmcnt(0)" ::: "memory");
    const int kvh = lane >> 5;
    o[0] = (f32x2){0.f, 0.f}; o[1] = o[0]; o[2] = o[0]; o[3] = o[0];
    const LAS u32x4* l4 = (const LAS u32x4*)list;
    for (int kb = 0; kb < 128; kb += 8) {
        const u32x4 pa = l4[(kb >> 3)];
        typename Src::vraw vr[8];
#pragma unroll
        for (int j = 0; j < 8; ++j) {
            const unsigned wv = pa[j >> 1];
            const int pos = (j & 1) ? (int)(wv >> 16) : (int)(wv & 0xffffu);
            vr[j] = S.vload(pos, lane);
        }
#pragma unroll
        for (int j = 0; j < 8; ++j) {
            const f32x4 p = *(const LAS f32x4*)(pb + (kb + j) * 8 + 4 * kvh);
            const f32x2 v = S.vcvt(vr[j]);
            o[0] += v * p[0]; o[1] += v * p[1]; o[2] += v * p[2]; o[3] += v * p[3];
        }
    }
}

constexpr int LDS_STG = 139264 + 8704;
static_assert(LDS_STG + 64 * 144 <= LDS_MISC, "dsa lds");
constexpr int SK_PITCH = 2176, SKS_PITCH = 8704, LDS_LIST = 139264, LDS_NSEL = LDS_LIST + 32 * 512, LDS_PBS = 4 * SKS_PITCH * 2;
static_assert(LDS_NSEL + 128 <= LDS_MISC && LDS_PBS + 4 * 8192 <= LDS_LIST, "dsa lds");

__device__ __forceinline__ void idx_afrag(const _Float16* qih, const int (&qrows)[4], int lane, f16x8 (&A)[4]) {
    const int m = lane & 31, hh = lane >> 5, q4 = 2 * (m >> 4) + ((m >> 2) & 1), head = 4 * ((m >> 3) & 1) + (m & 3);
    const int qr = q4 == 0 ? qrows[0] : q4 == 1 ? qrows[1] : q4 == 2 ? qrows[2] : qrows[3];
    const _Float16* p = qih + (size_t)qr * 512 + head * 64 + 32 * hh;
#pragma unroll
    for (int s = 0; s < 4; ++s) A[s] = *(const f16x8*)(p + 8 * s);
}
__device__ __forceinline__ void idx_score(const f32x16& acc, const float (&wa)[8], const float (&wb)[8], float& sa, float& sb) {
    sa = 0.f; sb = 0.f;
#pragma unroll
    for (int r = 0; r < 8; ++r) { sa += __builtin_amdgcn_fmed3f(acc[r], 0.f, __builtin_inff()) * wa[r]; sb += __builtin_amdgcn_fmed3f(acc[8 + r], 0.f, __builtin_inff()) * wb[r]; }
}

__device__ __forceinline__ void dsa_prompt_unit(Frame& F, int b, int p0, int nq) {
    const float* proj = (const float*)(F.ws + WS_PROJ);
    const _Float16* kih = (const _Float16*)(F.ws + WS_KIH);
    bf16_t* act = (bf16_t*)(F.ws + WS_ACT);
    LAS u16* sk = (LAS u16*)F.lds; LAS unsigned* masks = (LAS unsigned*)(F.lds + LDS_LIST);
    const int lane = F.lane, w = F.wave, Lk = p0 + nq, ntiles = (Lk + 31) >> 5;
    const bool active = 4 * w < nq;
    {
        LAS unsigned char* stg = F.lds + LDS_STG;
        const int hh = lane >> 5, n = lane & 31;
        const int skey = F.tid >> 3, schunk = F.tid & 7;
        const int nblocks = (Lk + 63) >> 6;
        f16x8 A[4]; float wa[8], wb[8];
        const int qpa = p0 + 4 * w + hh, qpb = qpa + 2;
        if (active) {
            int qrows[4];
#pragma unroll
            for (int i = 0; i < 4; ++i) qrows[i] = prow(b, p0 + 4 * w + i);
            idx_afrag((const _Float16*)(F.ws + WS_KEB), qrows, lane, A);
            const float* pa = proj + (size_t)prow(b, qpa) * PLD + EWI; const float* pbq = proj + (size_t)prow(b, qpb) * PLD + EWI;
#pragma unroll
            for (int r = 0; r < 8; ++r) { wa[r] = pa[r]; wb[r] = pbq[r]; }
        } else {
#pragma unroll
            for (int s = 0; s < 4; ++s) A[s] = (f16x8){0, 0, 0, 0, 0, 0, 0, 0};
#pragma unroll
            for (int r = 0; r < 8; ++r) { wa[r] = 0.f; wb[r] = 0.f; }
        }
        LAS u16* ra = sk + (4 * w + hh) * SK_PITCH; LAS u16* rb = sk + (4 * w + 2 + hh) * SK_PITCH;
#define SC_LOADBLK(g, i) do { const int pp_ = 64 * (i) + skey, pos_ = pp_ < LP ? pp_ : LP - 1; g = *(const u32x4*)(kih + (size_t)prow(b, pos_) * 64 + 8 * schunk); } while (0)
#define SC_STEP(g, i) do { if ((i) < nblocks) { \
            __syncthreads(); *(LAS u32x4*)(stg + skey * 144 + 16 * schunk) = g; __syncthreads(); \
            SC_LOADBLK(g, (i) + 3); \
            if (active) { _Pragma("unroll") for (int tl = 0; tl < 2; ++tl) { \
                const int pos = 64 * (i) + 32 * tl + n; f32x16 acc; \
                _Pragma("unroll") for (int r = 0; r < 16; ++r) acc[r] = 0.f; \
                _Pragma("unroll") for (int s2 = 0; s2 < 4; ++s2) acc = __builtin_amdgcn_mfma_f32_32x32x16_f16(A[s2], *(const LAS f16x8*)(stg + (32 * tl + n) * 144 + 64 * hh + 16 * s2), acc, 0, 0, 0); \
                float sa, sb; idx_score(acc, wa, wb, sa, sb); \
                if (pos < 32 * ntiles) { ra[pos] = (u16)(pos <= qpa ? f2key(sa) : 0u); rb[pos] = (u16)(pos <= qpb ? f2key(sb) : 0u); } } } } } while (0)
        u32x4 gk0, gk1, gk2;
        SC_LOADBLK(gk0, 0); SC_LOADBLK(gk1, 1); SC_LOADBLK(gk2, 2);
        for (int blkk = 0; blkk < nblocks; blkk += 3) { SC_STEP(gk0, blkk); SC_STEP(gk1, blkk + 1); SC_STEP(gk2, blkk + 2); }
#undef SC_STEP
#undef SC_LOADBLK
    }
    if (active) {
        for (int i = 0; i < 4; ++i) { LAS u16* r = sk + (4 * w + i) * SK_PITCH; for (int j = 32 * ntiles + lane; j < ((Lk + 127) & ~127); j += 64) r[j] = 0; }
        asm volatile("s_waitcnt lgkmcnt(0)" ::: "memory");
        for (int i = 0; i < 4; ++i) {
            const int q = 4 * w + i;
            { const int nv = p0 + q + 1, nst = (nv + 127) >> 7;
              if (nst <= 5) select_mask<5>(sk + q * SK_PITCH, nv, masks + q * MASK_WORDS, lane);
              else if (nst <= 9) select_mask<9>(sk + q * SK_PITCH, nv, masks + q * MASK_WORDS, lane);
              else if (nst <= 13) select_mask<13>(sk + q * SK_PITCH, nv, masks + q * MASK_WORDS, lane);
              else select_mask<17>(sk + q * SK_PITCH, nv, masks + q * MASK_WORDS, lane); }
        }
    }
    __syncthreads();
    {
        const bf16_t* kvb = (const bf16_t*)(F.ws + WS_KVB);
        const int kvh = w >> 2, rb = w & 3, n = lane & 31, hi = lane >> 5;
        const bool act_w = 8 * rb < nq;
        const int qpos = p0 + 8 * rb + (n >> 2), head = 4 * kvh + (n & 3);
        const int qrow = prow(b, act_w ? qpos : p0);
        bf16x8 qf[4];
        { const bf16_t* qp = (const bf16_t*)(F.ws + WS_QE) + (size_t)qrow * 512 + head * 64 + 32 * hi;
#pragma unroll
          for (int s = 0; s < 4; ++s) qf[s] = *(const bf16x8*)(qp + 8 * s); }
        const int skey = F.tid >> 4, sc = F.tid & 15;
        const unsigned kdst = (unsigned)((sc >> 3) * 4608 + skey * 144 + 16 * (sc & 7));
        const unsigned vdst = (unsigned)(9216 + (sc >> 3) * 4096 + ((sc & 7) >> 2) * 2048 + skey * 64 + 16 * (sc & 3));
        constexpr int KVBUF = 17408;
#define FL_COMPUTE \
            if (act_w) { \
                f32x16 sc16; \
_Pragma("unroll") \
                for (int r = 0; r < 16; ++r) sc16[r] = 0.f; \
_Pragma("unroll") \
                for (int s = 0; s < 4; ++s) sc16 = __builtin_amdgcn_mfma_f32_32x32x16_bf16(*(const LAS bf16x8*)(kbase + boff + 16 * s), qf[s], sc16, 0, 0, 0); \
                const unsigned mw = mrow[t] >> (4 * hi); \
                float tmax = -1e30f; \
_Pragma("unroll") \
                for (int r = 0; r < 16; ++r) { const bool on = (mw >> ((r & 3) + 8 * (r >> 2))) & 1u; sc16[r] = on ? sc16[r] : -1e30f; tmax = fmaxf(tmax, sc16[r]); } \
                { auto rr = __builtin_amdgcn_permlane32_swap(__float_as_uint(tmax), __float_as_uint(tmax), false, false); tmax = fmaxf(__uint_as_float(rr[0]), __uint_as_float(rr[1])); } \
                const float m_new = fmaxf(m_run, tmax), alpha = __expf(m_run - m_new); \
                m_run = m_new; \
                float psum = 0.f; \
_Pragma("unroll") \
                for (int r = 0; r < 16; ++r) { const bool on = (mw >> ((r & 3) + 8 * (r >> 2))) & 1u; const float p = on ? __expf(sc16[r] - m_new) : 0.f; sc16[r] = p; psum += p; } \
                l_run = l_run * alpha + psum; \
_Pragma("unroll") \
                for (int r = 0; r < 16; ++r) { o0[r] *= alpha; o1[r] *= alpha; } \
                bf16x8 pw[2]; \
_Pragma("unroll") \
                for (int ks = 0; ks < 2; ++ks) { u32x4 wv; wv.x = cvt_pk_bf16(sc16[8 * ks], sc16[8 * ks + 1]); wv.y = cvt_pk_bf16(sc16[8 * ks + 2], sc16[8 * ks + 3]); wv.z = cvt_pk_bf16(sc16[8 * ks + 4], sc16[8 * ks + 5]); wv.w = cvt_pk_bf16(sc16[8 * ks + 6], sc16[8 * ks + 7]); pw[ks] = __builtin_bit_cast(bf16x8, wv); } \
_Pragma("unroll") \
                for (int ks = 0; ks < 2; ++ks) { \
_Pragma("unroll") \
                    for (int dh = 0; dh < 2; ++dh) { \
                        typedef short v4i16_t __attribute__((ext_vector_type(4))); \
                        const LAS unsigned char* vp = vbase + boff + dh * 2048 + ks * 1024; \
                        const v4i16_t lo = __builtin_amdgcn_ds_read_tr16_b64_v4i16((LAS v4i16_t*)vp), hi4 = __builtin_amdgcn_ds_read_tr16_b64_v4i16((LAS v4i16_t*)(vp + 512)); \
                        const bf16x8 vf = (bf16x8){lo[0], lo[1], lo[2], lo[3], hi4[0], hi4[1], hi4[2], hi4[3]}; \
                        if (dh == 0) o0 = __builtin_amdgcn_mfma_f32_32x32x16_bf16(vf, pw[ks], o0, 0, 0, 0); else o1 = __builtin_amdgcn_mfma_f32_32x32x16_bf16(vf, pw[ks], o1, 0, 0, 0); \
                    } \
                } \
            }
#define FL_LOAD(gk_, gv_, i) do { const int pp_ = 32 * (i) + skey, pos_ = pp_ < LP ? pp_ : LP - 1; const bf16_t* src_ = kvb + (size_t)prow(b, pos_) * 256 + 8 * sc; gk_ = *(const u32x4*)src_; gv_ = *(const u32x4*)(src_ + 128); } while (0)
        u32x4 gkA, gvA, gkB, gvB, gkC, gvC;
        FL_LOAD(gkA, gvA, 0); FL_LOAD(gkB, gvB, 1); FL_LOAD(gkC, gvC, 2);
        *(LAS u32x4*)(F.lds + kdst) = gkA; *(LAS u32x4*)(F.lds + vdst) = gvA;
        FL_LOAD(gkA, gvA, 3);
        __syncthreads();
        const LAS unsigned char* kbase = F.lds + kvh * 4608 + n * 144 + 64 * hi;
        const LAS unsigned char* vbase = F.lds + 9216 + kvh * 4096 + (4 * hi + ((lane & 15) >> 2)) * 64 + ((lane >> 4) & 1) * 32 + (lane & 3) * 8;
        const LAS unsigned* mrow = masks + (8 * rb + (n >> 2)) * MASK_WORDS;
        float m_run = -1e30f, l_run = 0.f;
        f32x16 o0, o1;
#pragma unroll
        for (int r = 0; r < 16; ++r) { o0[r] = 0.f; o1[r] = 0.f; }
#define FL_STEP(tt_, gk_, gv_) do { if ((tt_) < ntiles) { const int t = (tt_); const int boff = (t & 1) * KVBUF; \
            FL_COMPUTE \
            if (t + 1 < ntiles) { const int nb = ((t + 1) & 1) * KVBUF; *(LAS u32x4*)(F.lds + nb + kdst) = gk_; *(LAS u32x4*)(F.lds + nb + vdst) = gv_; FL_LOAD(gk_, gv_, t + 4); } \
            __syncthreads(); } } while (0)
        for (int t3 = 0; t3 < ntiles; t3 += 3) { FL_STEP(t3, gkB, gvB); FL_STEP(t3 + 1, gkC, gvC); FL_STEP(t3 + 2, gkA, gvA); }
#undef FL_STEP
#undef FL_COMPUTE
#undef FL_LOAD
        if (act_w) {
            { auto rr = __builtin_amdgcn_permlane32_swap(__float_as_uint(l_run), __float_as_uint(l_run), false, false); l_run = __uint_as_float(rr[0]) + __uint_as_float(rr[1]); }
            const float inv = 1.f / l_run;
            bf16_t* ap = act + (size_t)qrow * DM + head * 64 + 4 * hi;
#pragma unroll
            for (int g4 = 0; g4 < 4; ++g4) {
                u32x2 w0; w0.x = cvt_pk_bf16(o0[4 * g4] * inv, o0[4 * g4 + 1] * inv); w0.y = cvt_pk_bf16(o0[4 * g4 + 2] * inv, o0[4 * g4 + 3] * inv);
                u32x2 w1; w1.x = cvt_pk_bf16(o1[4 * g4] * inv, o1[4 * g4 + 1] * inv); w1.y = cvt_pk_bf16(o1[4 * g4 + 2] * inv, o1[4 * g4 + 3] * inv);
                *(u32x2*)(ap + 8 * g4) = w0; *(u32x2*)(ap + 32 + 8 * g4) = w1;
            }
        }
    }
    __syncthreads();
}

constexpr int LDS_PTS = LDS_NSEL + 128;
constexpr int LDS_STAT = LDS_PBS + 8 * 4096, LDS_OPART = LDS_STAT + 512, LDS_XCH = LDS_OPART + 8192;
static_assert(LDS_XCH + 128 <= LDS_LIST, "dsa lds");
static_assert(LDS_PTS + 256 <= LDS_MISC, "dsa lds");
__device__ __forceinline__ const float* samp_kiptr(const float* cki, const LAS int* pts, const float* proj, int db, int pos, int hh) {
    const int posc = pos < PAST + DSEQ ? pos : PAST + DSEQ - 1;
    return posc < PAST ? cki + ((size_t)pts[posc >> 7] * PAGE + (posc & 127)) * 64 + 32 * hh
                       : proj + (size_t)(ROW_SAMP + db * DSEQ + (posc - PAST)) * PLD + EKI + 32 * hh;
}
__device__ __forceinline__ void dsa_sample_unit(Frame& F, int e, int db) {
    const float* proj = (const float*)(F.ws + WS_PROJ);
    bf16_t* act = (bf16_t*)(F.ws + WS_ACT);
    const float* cki = F.in[IN_CKI] + (size_t)e * NPOOLPG * PAGE * 64;
    LAS u16* sk = (LAS u16*)F.lds; LAS u16* lists = (LAS u16*)(F.lds + LDS_LIST); LAS int* pts = (LAS int*)(F.lds + LDS_PTS);
    const int lane = F.lane, w = F.wave, hh = lane >> 5, n = lane & 31;
    if (F.tid < NPAGES) pts[F.tid] = ((const int*)F.in[IN_PT])[db * NPAGES + F.tid];
    int qrows[4];
#pragma unroll
    for (int i = 0; i < 4; ++i) qrows[i] = ROW_SAMP + db * DSEQ + i;
    f16x8 A[4]; idx_afrag((const _Float16*)(F.ws + WS_KEB), qrows, lane, A);
    float wa[8], wb[8];
    const int qpa = PAST + hh, qpb = qpa + 2;
    { const float* pa = proj + (size_t)(ROW_SAMP + db * DSEQ + hh) * PLD + EWI; const float* pbq = proj + (size_t)(ROW_SAMP + db * DSEQ + 2 + hh) * PLD + EWI;
#pragma unroll
      for (int r = 0; r < 8; ++r) { wa[r] = pa[r]; wb[r] = pbq[r]; } }
    LAS u16* ra = sk + hh * SKS_PITCH; LAS u16* rb = sk + (2 + hh) * SKS_PITCH;
    constexpr int NT = (PAST + DSEQ + 31) / 32;
    for (int q = 0; q < 4; ++q) for (int c = 32 * NT + F.tid; c < SKS_PITCH; c += 512) sk[q * SKS_PITCH + c] = 0;
    __syncthreads();
#define SS_LOAD(buf_, t_) do { const float* kp_ = samp_kiptr(cki, pts, proj, db, 32 * (t_) + n, hh); _Pragma("unroll") for (int s2 = 0; s2 < 8; ++s2) buf_[s2] = *(const f32x4*)(kp_ + 4 * s2); } while (0)
#define SS_STEP(buf_, t_) do { if ((t_) < NT) { const int pos = 32 * (t_) + n; f32x16 acc; \
        _Pragma("unroll") for (int r = 0; r < 16; ++r) acc[r] = 0.f; \
        _Pragma("unroll") for (int s2 = 0; s2 < 4; ++s2) { const f32x4 a = buf_[2 * s2], c = buf_[2 * s2 + 1]; \
            f16x8 h; h[0] = (_Float16)a[0]; h[1] = (_Float16)a[1]; h[2] = (_Float16)a[2]; h[3] = (_Float16)a[3]; h[4] = (_Float16)c[0]; h[5] = (_Float16)c[1]; h[6] = (_Float16)c[2]; h[7] = (_Float16)c[3]; \
            acc = __builtin_amdgcn_mfma_f32_32x32x16_f16(A[s2], h, acc, 0, 0, 0); } \
        SS_LOAD(buf_, (t_) + 16); \
        float sa, sb; idx_score(acc, wa, wb, sa, sb); \
        ra[pos] = (u16)(pos <= qpa ? f2key(sa) : 0u); rb[pos] = (u16)(pos <= qpb ? f2key(sb) : 0u); } } while (0)
    f32x4 r0s[8], r1s[8];
    SS_LOAD(r0s, w); SS_LOAD(r1s, w + 8);
    for (int t = w; t < NT; t += 16) { SS_STEP(r0s, t); SS_STEP(r1s, t + 8); }
#undef SS_STEP
#undef SS_LOAD
    __syncthreads();
    {
        const int q = w >> 1, half = w & 1;
        volatile LAS int* xch = (volatile LAS int*)(F.lds + LDS_XCH);
        select_topk_pair<33>(sk + q * SKS_PITCH, PAST + q + 1, lists + q * 256, xch, lane, w);
        __syncthreads();
        SrcSample S; S.ck = F.in[IN_CK] + (size_t)e * NPOOLPG * PAGE * 128; S.cv = F.in[IN_CV] + (size_t)e * NPOOLPG * PAGE * 128; S.pt = pts; S.proj = proj; S.db = db;
        LAS float* stat = (LAS float*)(F.lds + LDS_STAT) + w * 16; LAS float* opart = (LAS float*)(F.lds + LDS_OPART) + q * 512;
        f32x2 o[4];
        const int qrow = ROW_SAMP + db * DSEQ + q;
        attn_half<SrcSample, 1>(S, (const bf16_t*)(F.ws + WS_QE), qrow, lists + q * 256 + 128 * half, (LAS float*)(F.lds + LDS_PBS + w * 4096), stat, lane, o);
        if (half) { *(LAS f32x4*)(opart + lane * 8) = (f32x4){o[0][0], o[0][1], o[1][0], o[1][1]}; *(LAS f32x4*)(opart + lane * 8 + 4) = (f32x4){o[2][0], o[2][1], o[3][0], o[3][1]}; }
        __syncthreads();
        if (!half) {
            const int kvh = lane >> 5;
            const LAS float* st0 = (const LAS float*)(F.lds + LDS_STAT) + w * 16; const LAS float* st1 = st0 + 16;
            const f32x4 m0 = *(const LAS f32x4*)(st0 + 4 * kvh), l0 = *(const LAS f32x4*)(st0 + 8 + 4 * kvh), m1 = *(const LAS f32x4*)(st1 + 4 * kvh), l1 = *(const LAS f32x4*)(st1 + 8 + 4 * kvh);
            const f32x4 pa = *(const LAS f32x4*)(opart + lane * 8), pc = *(const LAS f32x4*)(opart + lane * 8 + 4);
            const f32x2 op[4] = {(f32x2){pa[0], pa[1]}, (f32x2){pa[2], pa[3]}, (f32x2){pc[0], pc[1]}, (f32x2){pc[2], pc[3]}};
            bf16_t* ap = act + (size_t)qrow * DM + (4 * kvh) * 64 + 2 * (lane & 31);
#pragma unroll
            for (int j = 0; j < 4; ++j) {
                const float M = fmaxf(m0[j], m1[j]), w0 = l0[j] * __expf(m0[j] - M), w1 = l1[j] * __expf(m1[j] - M), inv = 1.f / (w0 + w1);
                const f32x2 r = (o[j] * w0 + op[j] * w1) * inv;
                *(unsigned*)(ap + 64 * j) = cvt_pk_bf16(r[0], r[1]);
            }
        }
    }
    __syncthreads();
}

template <int W>
__device__ __forceinline__ void pool_diff_group(Frame& F, const float* proj, const float* spool, bf16_t* act, int g) {
    const int gt = F.blk * 512 + F.tid, NT = F.G * 512;
    for (int idx = gt; idx < (MREAL - ROW_META) * 32; idx += NT) {
        const int row = ROW_META + (idx >> 5), c = 128 * g + 4 * (idx & 31);
        f32x4 v[W]; float cnt;
        if (row < ROW_SAMP) {
            int b = 0, p;
            if (row < ROW_META) { b = row >> 11; p = NMETA + (row & 2047); } else p = row - ROW_META;
            const int nw = W < p + 1 ? W : p + 1;
#pragma unroll
            for (int j = 0; j < W; ++j) { const int pj = p - j > 0 ? p - j : 0; v[j] = *(const f32x4*)(proj + (size_t)prow(b, pj) * PLD + EU + c); }
#pragma unroll
            for (int j = 1; j < W; ++j) if (j >= nw) v[j] = (f32x4){0.f, 0.f, 0.f, 0.f};
            cnt = (float)nw;
        } else {
            const int db = (row - ROW_SAMP) >> 2, t = (row - ROW_SAMP) & 3;
#pragma unroll
            for (int j = 0; j < W; ++j) {
                const int i = 15 + t - j;
                const float* src = i < 15 ? spool + ((size_t)db * 15 + i) * 512 + c : proj + (size_t)(ROW_SAMP + db * DSEQ + (i - 15)) * PLD + EU + c;
                v[j] = *(const f32x4*)src;
            }
            cnt = (float)W;
        }
        f32x4 sum = v[0];
#pragma unroll
        for (int j = 1; j < W; ++j) sum += v[j];
        const f32x4 d = sum / cnt - v[0];
        u32x2 wv; wv.x = cvt_pk_bf16(d[0], d[1]); wv.y = cvt_pk_bf16(d[2], d[3]);
        *(u32x2*)(act + (size_t)row * DM + 512 + c) = wv;
    }
}

template <int W>
__device__ __forceinline__ void pool_diff_item(const float* proj, bf16_t* act, int b, int blk16, int c) {
    const int p0 = NMETA + 16 * blk16;
    f32x4 v[16 + W - 1];
#pragma unroll
    for (int i = 0; i < 16 + W - 1; ++i) v[i] = *(const f32x4*)(proj + (size_t)prow(b, p0 - (W - 1) + i) * PLD + EU + c);
    const float inv = 1.f / (float)W;
#pragma unroll
    for (int r = 0; r < 16; ++r) {
        f32x4 sum = v[r + W - 1];
#pragma unroll
        for (int j = 1; j < W; ++j) sum += v[r + W - 1 - j];
        const f32x4 d = sum * inv - v[r + W - 1];
        u32x2 wv; wv.x = cvt_pk_bf16(d[0], d[1]); wv.y = cvt_pk_bf16(d[2], d[3]);
        *(u32x2*)(act + (size_t)(b * SEQ + 16 * blk16 + r) * DM + 512 + c) = wv;
    }
}
__device__ __forceinline__ void pool_diff_blocks(Frame& F, const float* proj, bf16_t* act) {
    const int gt = F.blk * 512 + F.tid, NT = F.G * 512;
    for (int idx = gt; idx < NBATCH * 128 * 128; idx += NT) {
        const int cq = idx & 31, g = (idx >> 6) & 3, blk16 = ((idx >> 8) & 63) * 2 + ((idx >> 5) & 1), b = idx >> 14, c = 128 * g + 4 * cq;
        if (g == 0) pool_diff_item<2>(proj, act, b, blk16, c); else if (g == 1) pool_diff_item<4>(proj, act, b, blk16, c);
        else if (g == 2) pool_diff_item<8>(proj, act, b, blk16, c); else pool_diff_item<16>(proj, act, b, blk16, c);
    }
}

__device__ __forceinline__ void even_mixer_phase(Frame& F, int e, int l) {
    const float* proj = (const float*)(F.ws + WS_PROJ);
    bf16_t* act = (bf16_t*)(F.ws + WS_ACT);
    const float* spool = F.in[IN_SPOOL] + (size_t)e * DBATCH * 15 * 512;
    const int gt = F.blk * 512 + F.tid, NT = F.G * 512;
    pool_diff_group<2>(F, proj, spool, act, 0); pool_diff_group<4>(F, proj, spool, act, 1); pool_diff_group<8>(F, proj, spool, act, 2); pool_diff_group<16>(F, proj, spool, act, 3);
    pool_diff_blocks(F, proj, act);
    float* out = F.out;
    for (int idx = gt; idx < NBATCH * 15 * 128; idx += NT) {
        const int bj = idx >> 7, cq = idx & 127, b = bj / 15, j = bj % 15;
        *(f32x4*)(out + O_PP + ((size_t)(e * NBATCH + b) * 15 + j) * 512 + 4 * cq) = *(const f32x4*)(proj + (size_t)prow(b, LP - 15 + j) * PLD + EU + 4 * cq);
    }
    for (int idx = gt; idx < DBATCH * 15 * 128; idx += NT) {
        const int bj = idx >> 7, cq = idx & 127, db = bj / 15, j = bj % 15, i = DSEQ + j;
        const f32x4 v = i < 15 ? *(const f32x4*)(spool + ((size_t)db * 15 + i) * 512 + 4 * cq) : *(const f32x4*)(proj + (size_t)(ROW_SAMP + db * DSEQ + (i - 15)) * PLD + EU + 4 * cq);
        *(f32x4*)(out + O_PS + ((size_t)(e * DBATCH + db) * 15 + j) * 512 + 4 * cq) = v;
    }
    volatile LAS int* bc = (volatile LAS int*)(F.lds + LDS_MISC + 16);
    unsigned* qh = F.ctl + CW_QUEUE + 64 * l;
    for (;;) {
        __syncthreads();
        if (F.tid == 0) *bc = (int)__hip_atomic_fetch_add(qh, 1u, __ATOMIC_RELAXED, __HIP_MEMORY_SCOPE_AGENT);
        __syncthreads();
        const int u = *bc;
        if (u >= 32 + 512 + 1) break;
#ifdef NO_SAMPLE
        if (u < 32) {}
#else
        if (u < 32) dsa_sample_unit(F, e, u);
#endif
#ifdef NO_PROMPT
        else {}
        if (0) {}
#endif
        else if (u < 544) { const int v = u - 32, qb = 63 - (v >> 3), b = v & 7; dsa_prompt_unit(F, b, NMETA + 32 * qb, 32); }
        else dsa_prompt_unit(F, 0, 0, 16);
    }
}

__device__ __forceinline__ void chunk_info(int ci, int& r0, int& T) {
    if (ci == 0) { r0 = ROW_META; T = NMETA; } else if (ci <= 256) { r0 = (ci - 1) * 64; T = 64; } else { r0 = ROW_SAMP + (ci - 257) * DSEQ; T = DSEQ; }
}
constexpr int QES_PITCH = 520;
__device__ __forceinline__ void gla_prep_unit(Frame& F, int o, int ci, const float* ssl, const float* sstl) {
    const float* proj = (const float*)(F.ws + WS_PROJ);
    bf16_t* QE = (bf16_t*)(F.ws + WS_QE); bf16_t* KET = (bf16_t*)(F.ws + WS_KET); bf16_t* VT = (bf16_t*)(F.ws + WS_VT); bf16_t* ATT = (bf16_t*)(F.ws + WS_ATT);
    float* EBL = (float*)(F.ws + WS_EBL); bf16_t* KEB = (bf16_t*)(F.ws + WS_KEB);
    LAS bf16_t* qes = (LAS bf16_t*)F.lds; LAS bf16_t* kes = (LAS bf16_t*)(F.lds + 64 * QES_PITCH * 2); LAS float* gds = (LAS float*)(F.lds + 2 * 64 * QES_PITCH * 2);
    int r0, T; chunk_info(ci, r0, T);
    const int tid = F.tid, col = tid, h = col >> 7, d = col & 127;
    __syncthreads();
    {
        const bf16_t* XBp = (const bf16_t*)(F.ws + WS_XB); const bf16_t* WGD = (const bf16_t*)(F.ws + WS_WINO) + ((size_t)o * NO + OGD) * DM;
        LAS float* part = (LAS float*)F.lds; LAS float* rsg = (LAS float*)(F.lds + 32768);
        const int lane = F.lane, w = F.wave, m = lane & 15, kq = lane >> 4;
        bf16x8 Af[4][4], Bf[4];
#pragma unroll
        for (int ks = 0; ks < 4; ++ks) Bf[ks] = *(const bf16x8*)(WGD + (size_t)m * DM + 128 * w + 32 * ks + 8 * kq);
#pragma unroll
        for (int tt = 0; tt < 4; ++tt)
#pragma unroll
            for (int ks = 0; ks < 4; ++ks) Af[tt][ks] = *(const bf16x8*)(XBp + (size_t)(r0 + (16 * tt < T ? 16 * tt : 0) + m) * DM + 128 * w + 32 * ks + 8 * kq);
        float rs_mine = 0.f;
        if (tid < 64) { const int row = r0 + (tid < T ? tid : T - 1); rs_mine = row < TR0 ? row_rstd(ssl, row) : tail_rstd_batched(sstl, row - TR0); }
        __builtin_amdgcn_sched_barrier(0);
#pragma unroll
        for (int tt = 0; tt < 4; ++tt) {
            f32x4 acc = (f32x4){0.f, 0.f, 0.f, 0.f};
#pragma unroll
            for (int ks = 0; ks < 4; ++ks) acc = __builtin_amdgcn_mfma_f32_16x16x32_bf16(Af[tt][ks], Bf[ks], acc, 0, 0, 0);
            *(LAS f32x4*)(part + ((w * 4 + tt) * 64 + lane) * 4) = acc;
        }
        if (tid < 64) rsg[tid] = rs_mine;
        __syncthreads();
        if (tid < 256) {
            const int tt = tid >> 6, ln = tid & 63, r = ln & 15, g = ln >> 4;
            f32x4 sum = *(const LAS f32x4*)(part + ((0 * 4 + tt) * 64 + ln) * 4);
#pragma unroll
            for (int ww = 1; ww < 8; ++ww) sum += *(const LAS f32x4*)(part + ((ww * 4 + tt) * 64 + ln) * 4);
#pragma unroll
            for (int j = 0; j < 4; ++j) {
                const int t = 16 * tt + 4 * g + j;
                gds[t * 16 + r] = t < T ? sum[j] * rsg[t] : 0.f;
            }
        }
    }
    float wg[16];
#pragma unroll
    for (int r = 0; r < 16; ++r) wg[r] = F.in[IN_WGATE][((size_t)o * 16 + r) * 512 + col];
    const float bgc = F.in[IN_BGATE][o * 512 + col];
    __syncthreads();
    float bcum = 0.f;
#define PREP_LOAD(qv, kv, va, vb, t0_) do { _Pragma("unroll") for (int u = 0; u < 8; ++u) { \
        const int tc = ((t0_) + u) < T ? ((t0_) + u) : (T - 1); const bf16_t* pr = (const bf16_t*)proj + (size_t)(r0 + tc) * PLB; \
        qv[u] = bf_lo((unsigned)pr[OQ + col]); kv[u] = bf_lo((unsigned)pr[OKK + col]); va[u] = bf_lo((unsigned)pr[OV + col]); vb[u] = bf_lo((unsigned)pr[OV + 512 + col]); } } while (0)
#define PREP_BLOCK(qv, kv, va, vb, t0_) do { const int tb0 = (t0_); unsigned kp[4], v0p[4], v1p[4], qkp[8]; \
        if (tb0 < T) { float ke8[8], v08[8], v18[8]; \
            _Pragma("unroll") for (int u = 0; u < 8; ++u) { const int t = tb0 + u; float qe = 0.f, ke = 0.f, v0 = 0.f, v1 = 0.f; \
                if (t < T) { \
                    const f32x4 g0 = *(const LAS f32x4*)(gds + t * 16), g1 = *(const LAS f32x4*)(gds + t * 16 + 4), g2 = *(const LAS f32x4*)(gds + t * 16 + 8), g3 = *(const LAS f32x4*)(gds + t * 16 + 12); \
                    float x = bgc; \
                    _Pragma("unroll") for (int r = 0; r < 4; ++r) { x += g0[r] * wg[r]; x += g1[r] * wg[4 + r]; x += g2[r] * wg[8 + r]; x += g3[r] * wg[12 + r]; } \
                    const float la = (fminf(x, 0.f) - __logf(1.f + __expf(-fabsf(x)))) * (1.f / 16.f); \
                    bcum += la; const float eb = __expf(bcum); \
                    qe = qv[u] * eb; ke = kv[u] * __builtin_amdgcn_rcpf(eb); v0 = va[u]; v1 = vb[u]; } \
                qkp[u] = cvt_pk_bf16(qe, ke); ke8[u] = ke; v08[u] = v0; v18[u] = v1; } \
            _Pragma("unroll") for (int u = 0; u < 4; ++u) { kp[u] = cvt_pk_bf16(ke8[2 * u], ke8[2 * u + 1]); v0p[u] = cvt_pk_bf16(v08[2 * u], v08[2 * u + 1]); v1p[u] = cvt_pk_bf16(v18[2 * u], v18[2 * u + 1]); } \
            _Pragma("unroll") for (int u = 0; u < 8; ++u) { if (tb0 + u < T) { QE[(size_t)(r0 + tb0 + u) * 512 + col] = (bf16_t)(qkp[u] & 0xffffu); KEB[(size_t)(r0 + tb0 + u) * 512 + col] = (bf16_t)(qkp[u] >> 16); } } \
        } else { _Pragma("unroll") for (int u = 0; u < 4; ++u) { kp[u] = 0u; v0p[u] = 0u; v1p[u] = 0u; } } \
        *(u32x4*)(KET + (((size_t)ci * 4 + h) * 128 + d) * 64 + tb0) = (u32x4){kp[0], kp[1], kp[2], kp[3]}; \
        *(u32x4*)(VT + (((size_t)ci * 4 + (col >> 8)) * 256 + (col & 255)) * 64 + tb0) = (u32x4){v0p[0], v0p[1], v0p[2], v0p[3]}; \
        *(u32x4*)(VT + (((size_t)ci * 4 + 2 + (col >> 8)) * 256 + (col & 255)) * 64 + tb0) = (u32x4){v1p[0], v1p[1], v1p[2], v1p[3]}; } while (0)
    {
        float qa[8], ka[8], vaa[8], vba[8], qb[8], kb[8], vab[8], vbb[8];
        PREP_LOAD(qa, ka, vaa, vba, 0);
        for (int t0 = 0; t0 < 64; t0 += 16) {
            if (t0 + 8 < T) PREP_LOAD(qb, kb, vab, vbb, t0 + 8);
            PREP_BLOCK(qa, ka, vaa, vba, t0);
            if (t0 + 16 < T) PREP_LOAD(qa, ka, vaa, vba, t0 + 16);
            PREP_BLOCK(qb, kb, vab, vbb, t0 + 8);
        }
    }
#undef PREP_BLOCK
#undef PREP_LOAD
    EBL[(size_t)ci * 512 + col] = __expf(bcum);
    __syncthreads();
    {
        const int w = F.wave, lane = F.lane, hd = w >> 1, th = w & 1, m = lane & 15, kq = lane >> 4;
        bf16x8 A[2][4], B[4][4];
        const bool live0 = 32 * th < T, live1 = 32 * th + 16 < T;
        if (live0) {
#pragma unroll
            for (int ks = 0; ks < 4; ++ks) A[0][ks] = *(const bf16x8*)(QE + (size_t)(r0 + 32 * th + m) * 512 + hd * 128 + 32 * ks + 8 * kq);
#pragma unroll
            for (int st = 0; st < 4; ++st)
#pragma unroll
                for (int ks = 0; ks < 4; ++ks) B[st][ks] = *(const bf16x8*)(KEB + (size_t)(r0 + 16 * st + m) * 512 + hd * 128 + 32 * ks + 8 * kq);
        }
        if (live1) {
#pragma unroll
            for (int ks = 0; ks < 4; ++ks) A[1][ks] = *(const bf16x8*)(QE + (size_t)(r0 + 32 * th + 16 + m) * 512 + hd * 128 + 32 * ks + 8 * kq);
        }
        f32x4 acc[2][4];
#pragma unroll
        for (int tt = 0; tt < 2; ++tt)
#pragma unroll
            for (int st = 0; st < 4; ++st) acc[tt][st] = (f32x4){0.f, 0.f, 0.f, 0.f};
        if (live0) {
#pragma unroll
            for (int st = 0; st < 4; ++st)
#pragma unroll
                for (int ks = 0; ks < 4; ++ks) acc[0][st] = __builtin_amdgcn_mfma_f32_16x16x32_bf16(A[0][ks], B[st][ks], acc[0][st], 0, 0, 0);
        }
        if (live1) {
#pragma unroll
            for (int st = 0; st < 4; ++st)
#pragma unroll
                for (int ks = 0; ks < 4; ++ks) acc[1][st] = __builtin_amdgcn_mfma_f32_16x16x32_bf16(A[1][ks], B[st][ks], acc[1][st], 0, 0, 0);
        }
#pragma unroll
        for (int tt = 0; tt < 2; ++tt) {
            const int trow = 16 * (2 * th + tt);
#pragma unroll
            for (int st = 0; st < 4; ++st) {
                const int s_ = 16 * st + m;
#pragma unroll
                for (int r = 0; r < 4; ++r) { const int t = trow + 4 * kq + r; const float v = (s_ <= t && t < T) ? acc[tt][st][r] : 0.f;
                    ATT[(((size_t)ci * 4 + hd) * 64 + t) * 64 + s_] = (bf16_t)(cvt_pk_bf16(v, 0.f) & 0xffffu); }
            }
        }
    }
}

__device__ __forceinline__ void gla_scan_chunk(Frame& F, int ci, int h, int et, f32x4 (&S)[8], int lane) {
    const bf16_t* QE = (const bf16_t*)(F.ws + WS_QE); const bf16_t* KET = (const bf16_t*)(F.ws + WS_KET); const bf16_t* VT = (const bf16_t*)(F.ws + WS_VT); const bf16_t* ATT = (const bf16_t*)(F.ws + WS_ATT);
    const float* EBL = (const float*)(F.ws + WS_EBL); bf16_t* O = (bf16_t*)(F.ws + WS_O);
    int r0, T; chunk_info(ci, r0, T);
    const int m = lane & 15, g = lane >> 4;
    bf16x8 Bv[2], At0[2], Ka[8][2]; u32x2 Q0[4][2];
#pragma unroll
    for (int ks = 0; ks < 2; ++ks) Bv[ks] = *(const bf16x8*)(VT + (((size_t)ci * 4 + h) * 256 + 16 * et + m) * 64 + 32 * ks + 8 * g);
#pragma unroll
    for (int ks = 0; ks < 2; ++ks) At0[ks] = *(const bf16x8*)(ATT + (((size_t)ci * 4 + h) * 64 + m) * 64 + 8 * g + 32 * ks);
#pragma unroll
    for (int kk = 0; kk < 4; ++kk) { const bf16_t* qp = QE + (size_t)(r0 + m) * 512 + h * 128 + 4 * g; Q0[kk][0] = *(const u32x2*)(qp + 32 * kk); Q0[kk][1] = *(const u32x2*)(qp + 32 * kk + 16); }
#pragma unroll
    for (int dt = 0; dt < 8; ++dt) {
        const bf16_t* kp = KET + (((size_t)ci * 4 + h) * 128 + 16 * dt + m) * 64 + 8 * g;
        Ka[dt][0] = *(const bf16x8*)kp; Ka[dt][1] = *(const bf16x8*)(kp + 32);
    }
    __builtin_amdgcn_sched_barrier(0);
    bf16x8 Bs[4];
#pragma unroll
    for (int kk = 0; kk < 4; ++kk) { u32x4 w; w.x = cvt_pk_bf16(S[2 * kk][0], S[2 * kk][1]); w.y = cvt_pk_bf16(S[2 * kk][2], S[2 * kk][3]); w.z = cvt_pk_bf16(S[2 * kk + 1][0], S[2 * kk + 1][1]); w.w = cvt_pk_bf16(S[2 * kk + 1][2], S[2 * kk + 1][3]);
        Bs[kk] = __builtin_bit_cast(bf16x8, w); }
    {
        f32x4 acc = (f32x4){0.f, 0.f, 0.f, 0.f};
#pragma unroll
        for (int ks = 0; ks < 2; ++ks) acc = __builtin_amdgcn_mfma_f32_16x16x32_bf16(At0[ks], Bv[ks], acc, 0, 0, 0);
#pragma unroll
        for (int kk = 0; kk < 4; ++kk) {
            const u32x4 w = (u32x4){Q0[kk][0].x, Q0[kk][0].y, Q0[kk][1].x, Q0[kk][1].y};
            acc = __builtin_amdgcn_mfma_f32_16x16x32_bf16(__builtin_bit_cast(bf16x8, w), Bs[kk], acc, 0, 0, 0);
        }
#pragma unroll
        for (int r = 0; r < 4; ++r) { const int t = 4 * g + r; if (t < T) O[(size_t)(r0 + t) * DM + h * 256 + 16 * et + m] = (bf16_t)(cvt_pk_bf16(acc[r], 0.f) & 0xffffu); }
    }
#pragma unroll 1
    for (int tt = 1; 16 * tt < T; ++tt) {
        f32x4 acc = (f32x4){0.f, 0.f, 0.f, 0.f};
        const bf16_t* ap = ATT + (((size_t)ci * 4 + h) * 64 + 16 * tt + m) * 64 + 8 * g;
#pragma unroll
        for (int ks = 0; ks < 2; ++ks) acc = __builtin_amdgcn_mfma_f32_16x16x32_bf16(*(const bf16x8*)(ap + 32 * ks), Bv[ks], acc, 0, 0, 0);
        const bf16_t* qp = QE + (size_t)(r0 + 16 * tt + m) * 512 + h * 128 + 4 * g;
#pragma unroll
        for (int kk = 0; kk < 4; ++kk) {
            const u32x2 a0 = *(const u32x2*)(qp + 32 * kk), a1 = *(const u32x2*)(qp + 32 * kk + 16);
            const u32x4 w = (u32x4){a0.x, a0.y, a1.x, a1.y};
            acc = __builtin_amdgcn_mfma_f32_16x16x32_bf16(__builtin_bit_cast(bf16x8, w), Bs[kk], acc, 0, 0, 0);
        }
#pragma unroll
        for (int r = 0; r < 4; ++r) { const int t = 16 * tt + 4 * g + r; if (t < T) O[(size_t)(r0 + t) * DM + h * 256 + 16 * et + m] = (bf16_t)(cvt_pk_bf16(acc[r], 0.f) & 0xffffu); }
    }
#pragma unroll
    for (int dt = 0; dt < 8; ++dt) {
        f32x4 U = S[dt];
#pragma unroll
        for (int ks = 0; ks < 2; ++ks) U = __builtin_amdgcn_mfma_f32_16x16x32_bf16(Ka[dt][ks], Bv[ks], U, 0, 0, 0);
        S[dt] = U * *(const f32x4*)(EBL + (size_t)ci * 512 + h * 128 + 16 * dt + 4 * g);
    }
}
constexpr int SC_ATT = 0, SC_QE = 9216, SC_KET = SC_QE + 17408, SC_EBL = SC_KET + 18432, SC_BUF = SC_EBL + 512;
static_assert(2 * SC_BUF <= LDS_MISC, "scan lds");
struct ScanStage { u32x4 att, ke0, ke1, qe0, qe1, eb; };
__device__ __forceinline__ void scan_stage_load(Frame& F, int ci, int h, ScanStage& st) {
    const bf16_t* QE = (const bf16_t*)(F.ws + WS_QE); const bf16_t* KET = (const bf16_t*)(F.ws + WS_KET); const bf16_t* ATT = (const bf16_t*)(F.ws + WS_ATT); const float* EBL = (const float*)(F.ws + WS_EBL);
    int r0, T; chunk_info(ci, r0, T);
    const int i = F.tid;
    st.att = *(const u32x4*)(ATT + (((size_t)ci * 4 + h) * 64 + (i >> 3)) * 64 + 8 * (i & 7));
    st.ke0 = *(const u32x4*)(KET + (((size_t)ci * 4 + h) * 128 + (i >> 3)) * 64 + 8 * (i & 7));
    st.ke1 = *(const u32x4*)(KET + (((size_t)ci * 4 + h) * 128 + 64 + (i >> 3)) * 64 + 8 * (i & 7));
    st.qe0 = *(const u32x4*)(QE + (size_t)(r0 + (i >> 4)) * 512 + h * 128 + 8 * (i & 15));
    st.qe1 = *(const u32x4*)(QE + (size_t)(r0 + 32 + (i >> 4)) * 512 + h * 128 + 8 * (i & 15));
    st.eb = *(const u32x4*)(EBL + (size_t)ci * 512 + h * 128 + 4 * (i & 31));
}
__device__ __forceinline__ void scan_stage_store(Frame& F, int buf, const ScanStage& st) {
    LAS unsigned char* base = F.lds + buf * SC_BUF; const int i = F.tid;
    *(LAS u32x4*)(base + SC_ATT + (i >> 3) * 144 + 16 * (i & 7)) = st.att;
    *(LAS u32x4*)(base + SC_KET + (i >> 3) * 144 + 16 * (i & 7)) = st.ke0;
    *(LAS u32x4*)(base + SC_KET + (64 + (i >> 3)) * 144 + 16 * (i & 7)) = st.ke1;
    *(LAS u32x4*)(base + SC_QE + (i >> 4) * 272 + 16 * (i & 15)) = st.qe0;
    *(LAS u32x4*)(base + SC_QE + (32 + (i >> 4)) * 272 + 16 * (i & 15)) = st.qe1;
    *(LAS u32x4*)(base + SC_EBL + 16 * (i & 31)) = st.eb;
}
__device__ __forceinline__ void scan_load_bv(Frame& F, int ci, int h, int et, int lane, bf16x8 (&Bv)[2]) {
    const bf16_t* VT = (const bf16_t*)(F.ws + WS_VT); const int m = lane & 15, g = lane >> 4;
#pragma unroll
    for (int ks = 0; ks < 2; ++ks) Bv[ks] = *(const bf16x8*)(VT + (((size_t)ci * 4 + h) * 256 + 16 * et + m) * 64 + 32 * ks + 8 * g);
}
__device__ __forceinline__ void gla_scan_prompt_step(Frame& F, int b, int h, int et, int c, f32x4 (&S)[8], ScanStage& st, const bf16x8 (&Bv)[2], bf16x8 (&Bn)[2]) {
    bf16_t* O = (bf16_t*)(F.ws + WS_O);
    const int lane = F.lane, m = lane & 15, g = lane >> 4;
    const int ci = c == 0 ? 0 : b * 32 + c, cn = b * 32 + c + 1, buf = c & 1;
    int r0, T; chunk_info(ci, r0, T);
    if (c + 1 < 33) { scan_stage_load(F, cn, h, st); scan_load_bv(F, cn, h, et, lane, Bn); }
    const LAS unsigned char* base = F.lds + buf * SC_BUF;
    bf16x8 Bs[4];
#pragma unroll
    for (int kk = 0; kk < 4; ++kk) { u32x4 wv; wv.x = cvt_pk_bf16(S[2 * kk][0], S[2 * kk][1]); wv.y = cvt_pk_bf16(S[2 * kk][2], S[2 * kk][3]); wv.z = cvt_pk_bf16(S[2 * kk + 1][0], S[2 * kk + 1][1]); wv.w = cvt_pk_bf16(S[2 * kk + 1][2], S[2 * kk + 1][3]);
        Bs[kk] = __builtin_bit_cast(bf16x8, wv); }
    {
        const int tt0 = 2 * (F.wave >> 2);
        bf16x8 Aa[2][2], Aq[2][4];
#pragma unroll
        for (int ti = 0; ti < 2; ++ti) {
            const int tt = tt0 + ti;
#pragma unroll
            for (int ks = 0; ks < 2; ++ks) Aa[ti][ks] = *(const LAS bf16x8*)(base + SC_ATT + (16 * tt + m) * 144 + 64 * ks + 16 * g);
#pragma unroll
            for (int kk = 0; kk < 4; ++kk) { const u32x2 a0 = *(const LAS u32x2*)(base + SC_QE + (16 * tt + m) * 272 + 64 * kk + 8 * g), a1 = *(const LAS u32x2*)(base + SC_QE + (16 * tt + m) * 272 + 64 * kk + 32 + 8 * g);
                const u32x4 wv = (u32x4){a0.x, a0.y, a1.x, a1.y}; Aq[ti][kk] = __builtin_bit_cast(bf16x8, wv); }
        }
        __builtin_amdgcn_sched_barrier(0);
        f32x4 acc[2], acc2[2];
#pragma unroll
        for (int ti = 0; ti < 2; ++ti) { acc[ti] = (f32x4){0.f, 0.f, 0.f, 0.f}; acc2[ti] = (f32x4){0.f, 0.f, 0.f, 0.f}; }
#pragma unroll
        for (int ks = 0; ks < 2; ++ks) {
#pragma unroll
            for (int ti = 0; ti < 2; ++ti) acc[ti] = __builtin_amdgcn_mfma_f32_16x16x32_bf16(Aa[ti][ks], Bv[ks], acc[ti], 0, 0, 0);
            if (ks == 0) {
#pragma unroll
                for (int ti = 0; ti < 2; ++ti) acc2[ti] = __builtin_amdgcn_mfma_f32_16x16x32_bf16(Aq[ti][0], Bs[0], acc2[ti], 0, 0, 0);
            } else {
#pragma unroll
                for (int ti = 0; ti < 2; ++ti) acc2[ti] = __builtin_amdgcn_mfma_f32_16x16x32_bf16(Aq[ti][2], Bs[2], acc2[ti], 0, 0, 0);
            }
        }
#pragma unroll
        for (int kk = 1; kk < 4; kk += 2) {
#pragma unroll
            for (int ti = 0; ti < 2; ++ti) acc[ti] = __builtin_amdgcn_mfma_f32_16x16x32_bf16(Aq[ti][kk], Bs[kk], acc[ti], 0, 0, 0);
        }
#pragma unroll
        for (int ti = 0; ti < 2; ++ti) {
            const int tt = tt0 + ti;
            const f32x4 a = acc[ti] + acc2[ti];
            bf16_t* op = O + (size_t)(r0 + 16 * tt + 4 * g) * DM + h * 256 + 16 * et + m;
            const unsigned p01 = cvt_pk_bf16(a[0], a[1]), p23 = cvt_pk_bf16(a[2], a[3]);
            if (16 * tt + 4 * g + 0 < T) op[0] = (bf16_t)(p01 & 0xffffu);
            if (16 * tt + 4 * g + 1 < T) op[(size_t)DM] = (bf16_t)(p01 >> 16);
            if (16 * tt + 4 * g + 2 < T) op[(size_t)2 * DM] = (bf16_t)(p23 & 0xffffu);
            if (16 * tt + 4 * g + 3 < T) op[(size_t)3 * DM] = (bf16_t)(p23 >> 16);
        }
    }
#pragma unroll
    for (int hf = 0; hf < 2; ++hf) {
        bf16x8 Ak[4][2]; f32x4 ebv[4];
#pragma unroll
        for (int d4 = 0; d4 < 4; ++d4) {
            const int dt = 4 * hf + d4;
#pragma unroll
            for (int ks = 0; ks < 2; ++ks) Ak[d4][ks] = *(const LAS bf16x8*)(base + SC_KET + (16 * dt + m) * 144 + 64 * ks + 16 * g);
            ebv[d4] = *(const LAS f32x4*)(base + SC_EBL + (16 * dt + 4 * g) * 4);
        }
        __builtin_amdgcn_sched_barrier(0);
#pragma unroll
        for (int ks = 0; ks < 2; ++ks)
#pragma unroll
            for (int d4 = 0; d4 < 4; ++d4) S[4 * hf + d4] = __builtin_amdgcn_mfma_f32_16x16x32_bf16(Ak[d4][ks], Bv[ks], S[4 * hf + d4], 0, 0, 0);
#pragma unroll
        for (int d4 = 0; d4 < 4; ++d4) S[4 * hf + d4] = S[4 * hf + d4] * ebv[d4];
        __builtin_amdgcn_sched_barrier(0);
    }
    if (c + 1 < 33) scan_stage_store(F, buf ^ 1, st);
    asm volatile("s_waitcnt lgkmcnt(0)\n\ts_barrier" ::: "memory");
}
__device__ __forceinline__ void gla_scan_prompt_unit(Frame& F, int o, int b, int h, int hf) {
    const int lane = F.lane, w = F.wave, m = lane & 15, g = lane >> 4, et = 4 * hf + (w & 3);
    f32x4 S[8];
#pragma unroll
    for (int dt = 0; dt < 8; ++dt) S[dt] = (f32x4){0.f, 0.f, 0.f, 0.f};
    ScanStage st; bf16x8 Ba[2], Bb[2];
    __syncthreads();
    scan_stage_load(F, 0, h, st); scan_load_bv(F, 0, h, et, lane, Ba);
    scan_stage_store(F, 0, st);
    __syncthreads();
    for (int c = 0; c < 33; c += 2) {
        gla_scan_prompt_step(F, b, h, et, c, S, st, Ba, Bb);
        if (c + 1 < 33) gla_scan_prompt_step(F, b, h, et, c + 1, S, st, Bb, Ba);
    }
    float* dst = F.out + O_GP + (((size_t)(o * NBATCH + b) * 4 + h) * 128 + 4 * g) * 256 + 16 * et + m;
    if (w < 4) {
#pragma unroll
        for (int dt = 0; dt < 8; ++dt) {
#pragma unroll
            for (int r = 0; r < 4; ++r) dst[r * 256] = S[dt][r];
            dst += 16 * 256;
        }
    }
}
__device__ __forceinline__ void gla_scan_phase(Frame& F, int o, bool late_convert) {
    const int lane = F.lane, w = F.wave, m = lane & 15, g = lane >> 4;
    const int npw = F.G > 128 ? 128 : F.G;
    if (F.blk < npw) {
        if (npw == 128) {
            const int xcd = F.blk & 7, slot = F.blk >> 3, grp = xcd * 4 + (slot >> 2);
            gla_scan_prompt_unit(F, o, grp >> 2, grp & 3, slot & 3);
        } else { for (int pu = F.blk; pu < 128; pu += npw) gla_scan_prompt_unit(F, o, pu >> 4, (pu >> 2) & 3, pu & 3); }
    }
    if (late_convert && F.G > 128 && F.blk >= 128) convert_weights(F, 1, (F.blk - 128) * 8 + w, (F.G - 128) * 8, F.blk - 128, F.G - 128);
    if (F.G <= 128 || F.blk >= 128) {
        const int first = F.G > 128 ? (F.blk - 128) * 8 + w : F.blk * 8 + w, stride = F.G > 128 ? (F.G - 128) * 8 : F.G * 8;
        f32x4 S[8];
        for (int su = first; su < 2048; su += stride) {
            const int db = su >> 6, h = (su >> 4) & 3, et = su & 15;
            const float* src = F.in[IN_SGLA] + (((size_t)(o * DBATCH + db) * 4 + h) * 128) * 256 + 16 * et + m;
#pragma unroll
            for (int dt = 0; dt < 8; ++dt)
#pragma unroll
                for (int r = 0; r < 4; ++r) S[dt][r] = src[(size_t)(16 * dt + 4 * g + r) * 256];
            gla_scan_chunk(F, 257 + db, h, et, S, lane);
            float* dst = F.out + O_GS + (((size_t)(o * DBATCH + db) * 4 + h) * 128) * 256 + 16 * et + m;
#pragma unroll
            for (int dt = 0; dt < 8; ++dt)
#pragma unroll
                for (int r = 0; r < 4; ++r) dst[(size_t)(16 * dt + 4 * g + r) * 256] = S[dt][r];
        }
    }
}
__device__ __forceinline__ void gla_post_phase(Frame& F, int o) {
    const float* proj = (const float*)(F.ws + WS_PROJ); const bf16_t* O = (const bf16_t*)(F.ws + WS_O); bf16_t* act = (bf16_t*)(F.ws + WS_ACT);
    const int lane = F.lane;
    const f32x4 gn = *(const f32x4*)(F.in[IN_GNORM] + o * 256 + 4 * lane);
    for (int row = F.blk * 8 + F.wave; row < MREAL; row += F.G * 8) {
        f32x4 v[4], gg[4]; float sq[4];
#pragma unroll
        for (int h = 0; h < 4; ++h) { { const u32x2 ob = *(const u32x2*)(O + (size_t)row * DM + h * 256 + 4 * lane); v[h] = (f32x4){bf_lo(ob.x), bf_hi(ob.x), bf_lo(ob.y), bf_hi(ob.y)}; } { const u32x2 gb = *(const u32x2*)((const bf16_t*)proj + (size_t)row * PLB + OG + h * 256 + 4 * lane); gg[h] = (f32x4){bf_lo(gb.x), bf_hi(gb.x), bf_lo(gb.y), bf_hi(gb.y)}; } }
#pragma unroll
        for (int h = 0; h < 4; ++h) sq[h] = (v[h][0] * v[h][0] + v[h][1] * v[h][1]) + (v[h][2] * v[h][2] + v[h][3] * v[h][3]);
#pragma unroll
        for (int o2 = 1; o2 < 64; o2 <<= 1) {
#pragma unroll
            for (int h = 0; h < 4; ++h) sq[h] += __shfl_xor(sq[h], o2);
        }
#pragma unroll
        for (int h = 0; h < 4; ++h) {
            const float rs = rsqrtf(sq[h] * (1.f / 256.f) + EPS);
            f32x4 y;
#pragma unroll
            for (int i = 0; i < 4; ++i) y[i] = v[h][i] * rs * gn[i] * silu_f(gg[h][i]);
            u32x2 wv; wv.x = cvt_pk_bf16(y[0], y[1]); wv.y = cvt_pk_bf16(y[2], y[3]);
            *(u32x2*)(act + (size_t)row * DM + h * 256 + 4 * lane) = wv;
        }
    }
}
__device__ __forceinline__ void final_phase(Frame& F) {
    const bf16_t* XBf = (const bf16_t*)(F.ws + WS_XB); const float* ssf = (const float*)(F.ws + WS_SSP) + (size_t)8 * MP * 16;
    const int lane = F.lane;
    for (int row = F.blk * 8 + F.wave; row < MREAL; row += F.G * 8) {
        float* dst;
        if (row < ROW_META) dst = F.out + O_YP + (size_t)row * DM; else if (row >= ROW_SAMP) dst = F.out + O_YS + (size_t)(row - ROW_SAMP) * DM; else continue;
        float rs;
        if (row < TR0) rs = row_rstd(ssf, row);
        else { const float* p = (const float*)(F.ws + WS_SST) + ((size_t)8 * TROWS + (row - TR0)) * 64; float sacc = 0.f;
#pragma unroll
            for (int i = 0; i < 16; ++i) { const f32x4 a = *(const f32x4*)(p + 4 * i); sacc += (a[0] + a[1]) + (a[2] + a[3]); }
            rs = rsqrtf(sacc * (1.f / DM) + EPS); }
#pragma unroll
        for (int j = 0; j < 4; ++j) {
            const u32x2 xb = *(const u32x2*)(XBf + (size_t)row * DM + 256 * j + 4 * lane); const f32x4 v = (f32x4){bf_lo(xb.x), bf_hi(xb.x), bf_lo(xb.y), bf_hi(xb.y)}, gn = *(const f32x4*)(F.in[IN_NFIN] + 256 * j + 4 * lane);
            *(f32x4*)(dst + 256 * j + 4 * lane) = v * rs * gn;
        }
    }
}

constexpr int NPHASE = 30;
__global__ void __launch_bounds__(512, 2) mega_fwd(Args args) {
    extern __shared__ __attribute__((aligned(16))) unsigned char lds_raw[];
    volatile LAS unsigned* misc = (volatile LAS unsigned*)((LAS unsigned char*)lds_raw + LDS_MISC);
    if (threadIdx.x < 8) misc[threadIdx.x] = 0u;
    __syncthreads();
    const int lo = args.ph_lo, hi = args.ph_hi;
    const bool multi = (hi - lo) > 1;
    XcdBarrier bar; bar.bar = (unsigned*)(args.ws + WS_CTL) + CW_BAR; bar.x = 0; bar.st = misc;
    if (multi) bar = xcd_barrier_post((unsigned*)(args.ws + WS_CTL) + CW_BAR, misc);
#ifndef PH_MASK
#define PH_MASK 0xffu
#endif
#ifndef DUP_MASK
#define DUP_MASK 0u
#endif
#define IN(k) (lo <= (k) && (k) < hi)
#define SEAM(k) do { if (IN((k) + 1)) xcd_barrier(bar); } while (0)
#define PHASE_FRAME() Frame F; { int tid_l = threadIdx.x; asm volatile("" : "+v"(tid_l)); size_t zoff = 0; asm volatile("" : "+s"(zoff)); unsigned char* ws_l = args.ws + zoff; \
    F.lds = (LAS unsigned char*)lds_raw; F.tid = tid_l; F.lane = tid_l & 63; F.wave = __builtin_amdgcn_readfirstlane(tid_l >> 6); F.G = gridDim.x; F.blk = blockIdx.x; \
    F.in = args.in; F.out = args.out; F.ws = ws_l; F.ctl = (unsigned*)(ws_l + WS_CTL); } unsigned char* ws = F.ws; float* ssb = (float*)(F.ws + WS_SSP); float* sstb = (float*)(F.ws + WS_SST); (void)ssb; (void)sstb; (void)ws
    if ((PH_MASK & 1u) && IN(0)) { PHASE_FRAME(); p0_prologue(F); if (DUP_MASK & 1u) { xcd_barrier(bar); p0_prologue(F); } SEAM(0); }
    for (int l = 0; l < 4; ++l) {
        const int base = 1 + 7 * l, odd = l & 1, eo = l >> 1;
        if ((PH_MASK & 2u) && IN(base + 0)) {
            PHASE_FRAME();
            pg8::Gemm g{(const bf16_t*)(ws + WS_XB), odd ? (const bf16_t*)(ws + WS_WINO) + (size_t)eo * NO * DM : (const bf16_t*)(ws + WS_WINE) + (size_t)eo * NE * DM, TR0, odd ? 3072 : NE, DM};
            pg8::StaticOrder S; S.init(g.M, g.N, F.G, F.blk);
            const int pm0 = panel_rstd_to_lds(F, ssb + (size_t)l * MP * 16, g.M, g.N);
            pg8::EpiProj E{(float*)(ws + WS_PROJ), PLD, ssb + (size_t)l * MP * 16, odd ? 0 : 1, (bf16_t*)(ws + WS_KVB), (_Float16*)(ws + WS_KIH), F.out, eo, (const LAS float*)(F.lds + LDS_RSL), pm0, (bf16_t*)(ws + WS_QE), (_Float16*)(ws + WS_KEB)};
            pg8::gemm_phase(F.lds, g, S, E, F.tid);
            { SkinnyEpi K{}; K.C = (float*)(ws + WS_PROJ); K.ldc = PLD; K.even = odd ? 0 : 1; K.kvb = (bf16_t*)(ws + WS_KVB); K.kih = (_Float16*)(ws + WS_KIH); K.out = F.out; K.eidx = eo; K.qb16 = (bf16_t*)(ws + WS_QE); K.qih = (_Float16*)(ws + WS_KEB);
              if (odd) skinny_phase<SKM_PROJ, 2, 4>(F, g.A, g.Bt, DM, 192, sstb + (size_t)l * TROWS * 64, K); else skinny_phase<SKM_PROJ, 2, 3>(F, g.A, g.Bt, DM, 117, sstb + (size_t)l * TROWS * 64, K); }
            SEAM(base + 0);
        }
        if (!odd) {
            if ((PH_MASK & 4u) && IN(base + 1)) { PHASE_FRAME(); even_mixer_phase(F, eo, l); if (DUP_MASK & 2u) { xcd_barrier(bar); even_mixer_phase(F, eo, l + 4); } SEAM(base + 3); }
        } else {
            if ((PH_MASK & 8u) && IN(base + 1)) { PHASE_FRAME(); for (int ci = F.blk; ci < NCHUNK; ci += F.G) gla_prep_unit(F, eo, ci, ssb + (size_t)l * MP * 16, sstb + (size_t)l * TROWS * 64); if (DUP_MASK & 4u) { xcd_barrier(bar); for (int ci = F.blk; ci < NCHUNK; ci += F.G) gla_prep_unit(F, eo, ci, ssb + (size_t)l * MP * 16, sstb + (size_t)l * TROWS * 64); } SEAM(base + 1); }
            if ((PH_MASK & 16u) && IN(base + 2)) { PHASE_FRAME(); gla_scan_phase(F, eo, l == 1); if (DUP_MASK & 8u) { xcd_barrier(bar); gla_scan_phase(F, eo, false); } SEAM(base + 2); }
            if ((PH_MASK & 32u) && IN(base + 3)) { PHASE_FRAME(); gla_post_phase(F, eo); if (DUP_MASK & 16u) { xcd_barrier(bar); gla_post_phase(F, eo); } SEAM(base + 3); }
        }
        if ((PH_MASK & 64u) && IN(base + 4)) {
            PHASE_FRAME();
            pg8::Gemm g{(const bf16_t*)(ws + WS_ACT), odd ? (const bf16_t*)(ws + WS_WOUTO) + (size_t)eo * DM * DM : (const bf16_t*)(ws + WS_WOUTE) + (size_t)eo * DM * DM, TR0, DM, DM};
            pg8::StaticOrder S; S.init(g.M, g.N, F.G, F.blk);
            pg8::EpiRes E{(bf16_t*)(ws + WS_XB), ssb + (size_t)(4 + l) * MP * 16, l == 0 ? F.in[IN_XP] : nullptr};
            pg8::gemm_phase(F.lds, g, S, E, F.tid);
            { SkinnyEpi K{}; K.XB = (bf16_t*)(ws + WS_XB); K.sst_next = sstb + (size_t)(4 + l) * TROWS * 64;
              skinny_phase<SKM_RES, 2, 2>(F, g.A, g.Bt, DM, 64, nullptr, K); }
            SEAM(base + 4);
        }
        if ((PH_MASK & 128u) && IN(base + 5)) {
            PHASE_FRAME();
            pg8::Gemm g{(const bf16_t*)(ws + WS_XB), (const bf16_t*)(ws + WS_WGU) + (size_t)l * NGU * DM, TR0, NGU, DM};
            pg8::StaticOrder S; S.init(g.M, g.N, F.G, F.blk);
            const int pm0 = panel_rstd_to_lds(F, ssb + (size_t)(4 + l) * MP * 16, g.M, g.N);
            pg8::EpiGU E{(bf16_t*)(ws + WS_HFF), ssb + (size_t)(4 + l) * MP * 16, (const LAS float*)(F.lds + LDS_RSL), pm0};
            pg8::gemm_phase(F.lds, g, S, E, F.tid);
            { SkinnyEpi K{}; K.H = (bf16_t*)(ws + WS_HFF);
              skinny_phase<SKM_GU, 5, 2>(F, g.A, g.Bt, DM, 176, sstb + (size_t)(4 + l) * TROWS * 64, K, F.G == 256 ? 128 : 0); }
            SEAM(base + 5);
        }
        if ((PH_MASK & 64u) && IN(base + 6)) {
            PHASE_FRAME();
            pg8::Gemm g{(const bf16_t*)(ws + WS_HFF), (const bf16_t*)(ws + WS_WDN) + (size_t)l * DM * DFF, TR0, DM, DFF};
            pg8::StaticOrder S; S.init(g.M, g.N, F.G, F.blk);
            pg8::EpiRes E{(bf16_t*)(ws + WS_XB), ssb + (size_t)(l < 3 ? (l + 1) : 8) * MP * 16, nullptr};
            pg8::gemm_phase(F.lds, g, S, E, F.tid);
            { SkinnyEpi K{}; K.XB = (bf16_t*)(ws + WS_XB); K.sst_next = sstb + (size_t)(l < 3 ? (l + 1) : 8) * TROWS * 64;
              skinny_phase<SKM_RES, 2, 2>(F, g.A, g.Bt, DFF, 64, nullptr, K); }
            SEAM(base + 6);
        }
    }
    if (IN(29)) { PHASE_FRAME(); final_phase(F); if (DUP_MASK & 32u) { xcd_barrier(bar); final_phase(F); } }
#undef IN
#undef SEAM
}

#ifdef DBG_COPY
__global__ void dbg_copy(const unsigned char* ws, float* out) {
    const bf16_t* src = (const bf16_t*)(ws + DBG_SRC);
    for (size_t i = (size_t)blockIdx.x * blockDim.x + threadIdx.x; i < (size_t)DBG_N; i += (size_t)gridDim.x * blockDim.x) out[i] = bf_lo((unsigned)src[i]);
}
#endif
#ifndef MK_ONE_LAUNCH
#define MK_ONE_LAUNCH 1
#endif
extern "C" void kernel_launch(void* const* d_in, const int* in_sizes, int n_in, void* d_out, int out_size, void* d_ws, size_t ws_size, hipStream_t stream) {
    static int grid = 0;
    if (grid == 0) {
        if (n_in != 24 || ws_size < WS_END || (size_t)out_size != O_END) { grid = -1; return; }
        int dev = 0, cus = 0;
        if (hipGetDevice(&dev) != hipSuccess || hipDeviceGetAttribute(&cus, hipDeviceAttributeMultiprocessorCount, dev) != hipSuccess) { grid = -1; return; }
        if (hipFuncSetAttribute((const void*)mega_fwd, hipFuncAttributeMaxDynamicSharedMemorySize, LDS_BYTES) != hipSuccess) { grid = -1; return; }
        int per_cu = 0;
        (void)hipOccupancyMaxActiveBlocksPerMultiprocessor(&per_cu, (const void*)mega_fwd, 512, LDS_BYTES);
        (void)hipGetLastError();
        grid = cus;
    }
    if (grid < 0) return;
    (void)hipMemsetAsync((char*)d_ws + WS_CTL, 0, CTL_BYTES, stream);
#ifdef DBG_FILL
    (void)hipMemsetAsync(d_out, 0, (size_t)out_size * 4, stream);
#endif
    Args a{};
    for (int i = 0; i < 24; ++i) a.in[i] = (const float*)d_in[i];
    a.out = (float*)d_out; a.ws = (unsigned char*)d_ws;
#if MK_ONE_LAUNCH
    a.ph_lo = 0; a.ph_hi = NPHASE;
    hipLaunchKernelGGL(mega_fwd, dim3(grid), dim3(512), LDS_BYTES, stream, a);
#else
#ifndef PH_LIMIT
#define PH_LIMIT NPHASE
#endif
    for (int p = 0; p < PH_LIMIT; ++p) {
        const int l = (p - 1) / 7, k = (p - 1) % 7;
        if (p >= 1 && p <= 28 && !(l & 1) && (k == 2 || k == 3)) continue;
        a.ph_lo = p; a.ph_hi = p + 1;
        hipLaunchKernelGGL(mega_fwd, dim3(grid), dim3(512), LDS_BYTES, stream, a);
    }
#ifdef DBG_COPY
    hipLaunchKernelGGL(dbg_copy, dim3(1024), dim3(256), 0, stream, (const unsigned char*)d_ws, (float*)d_out);
#endif
#endif
}
```
